# Optimizing an MI355X kernel written in HIP

```python
import math
import jax, jax.numpy as jnp
from jax import lax
import numpy as np

D_MODEL = 2048
BATCH = 2
SEQ = 16384
DEPTH = 2

CHUNK = 64
N_META = 16
MIX_WIDTH = D_MODEL
LRU_WIDTH = MIX_WIDTH // 2
LRU_BLOCKS = 8
LRU_BLOCK_W = LRU_WIDTH // LRU_BLOCKS
CONV_W = 4
LRU_C = 8.0
ATT_HEADS = 8
ATT_QK_DIM = (MIX_WIDTH - LRU_WIDTH) // (2 * ATT_HEADS)
ATT_V_DIM = 2 * ATT_QK_DIM
ATT_WIDTH = ATT_HEADS * ATT_V_DIM
QK_WIDTH = ATT_HEADS * 2 * ATT_QK_DIM
IN_PROJ_WIDTH = 2 * LRU_WIDTH + 2 * QK_WIDTH + ATT_WIDTH
Q_BLOCK = 128
N_GROUPS = 4
EXPERTS_PER_GROUP = 4
N_EXPERTS = N_GROUPS * EXPERTS_PER_GROUP
TOP_K_INNER = 2
D_EXPERT = 512
RMS_EPS = 1e-6

kernel_name = "hybrid_rglru_diffattn_hmoe_block"


def rmsnorm(x, g):
    xf = x.astype(jnp.float32)
    y = xf * lax.rsqrt(jnp.mean(xf * xf, axis=-1, keepdims=True) + RMS_EPS)
    return (y * g.astype(jnp.float32)).astype(x.dtype)


def chunk_id(pos):
    return jnp.where(pos < N_META, 0, 1 + (pos - N_META) // CHUNK)


def alibi_slopes(n_heads):
    return jnp.exp2(-8.0 * jnp.arange(1, n_heads + 1, dtype=jnp.float32) / n_heads)


def rg_lru_mixer(u, yg, conv_w, conv_b, wa, ba, wx, bx, lru_a_param):
    B, T, W = u.shape
    up = jnp.pad(u, ((0, 0), (CONV_W - 1, 0), (0, 0)))
    xc = conv_b
    for k in range(CONV_W):
        xc = xc + conv_w[k] * up[:, CONV_W - 1 - k: CONV_W - 1 - k + T]
    xh = xc.reshape(B, T, LRU_BLOCKS, LRU_BLOCK_W)
    r = jax.nn.sigmoid(jnp.einsum('btgi,gij->btgj', xh, wa).reshape(B, T, W) + ba)
    i = jax.nn.sigmoid(jnp.einsum('btgi,gij->btgj', xh, wx).reshape(B, T, W) + bx)
    log_a = (-LRU_C * r.astype(jnp.float32)) * jax.nn.softplus(-lru_a_param.astype(jnp.float32))
    a = jnp.exp(log_a)
    b = jnp.sqrt(-jnp.expm1(2.0 * log_a)) * (i * xc).astype(jnp.float32)

    def combine(left, right):
        a_l, b_l = left
        a_r, b_r = right
        return a_l * a_r, a_r * b_l + b_r

    _, h = lax.associative_scan(combine, (a, b), axis=1)
    return h.astype(u.dtype) * jax.nn.gelu(yg)


def diff_attention(q, k, v, lam, lam_init, subln_g):
    B, T, _ = q.shape
    H, Dh, Dv = ATT_HEADS, ATT_QK_DIM, ATT_V_DIM
    q = q.reshape(B, T, H, 2, Dh).transpose(0, 2, 3, 1, 4)
    k = k.reshape(B, T, H, 2, Dh).transpose(0, 2, 3, 1, 4)
    v = v.reshape(B, T, H, Dv).transpose(0, 2, 1, 3)
    n_blk = -(-T // Q_BLOCK)
    t_pad = n_blk * Q_BLOCK
    qp = jnp.pad(q, ((0, 0), (0, 0), (0, 0), (0, t_pad - T), (0, 0)))
    q_blocks = qp.reshape(B, H, 2, n_blk, Q_BLOCK, Dh).transpose(3, 0, 1, 2, 4, 5)
    pos_blocks = jnp.arange(t_pad).reshape(n_blk, Q_BLOCK)
    pos_k = jnp.arange(T)
    cid_k = chunk_id(pos_k)
    slopes = alibi_slopes(H)
    scale = Dh ** -0.5

    def block(args):
        q_blk, pos_q = args
        visible = chunk_id(pos_q)[:, None] >= cid_k[None, :]
        dist = jnp.abs(pos_q[:, None] - pos_k[None, :]).astype(jnp.float32)
        bias = jnp.where(visible[None], -slopes[:, None, None] * dist[None], -jnp.inf)
        s = jnp.einsum('bhmqd,bhmkd->bhmqk', q_blk, k).astype(jnp.float32) * scale + bias[None, :, None]
        p = jax.nn.softmax(s, axis=-1)
        a = (p[:, :, 0] - lam * p[:, :, 1]).astype(v.dtype)
        return jnp.einsum('bhqk,bhkd->bhqd', a, v)

    o = lax.map(block, (q_blocks, pos_blocks))
    o = o.transpose(1, 2, 0, 3, 4).reshape(B, H, t_pad, Dv)[:, :, :T]
    o = rmsnorm(o, subln_g) * (1.0 - lam_init)
    return o.transpose(0, 2, 1, 3).reshape(B, T, H * Dv)


def hier_moe(x, rg_w, rg_b, re_w, re_b, w_gate, w_up, w_down):
    shape = x.shape
    xt = x.reshape(-1, shape[-1])
    n = xt.shape[0]
    lg_g = (xt @ rg_w + rg_b).astype(jnp.float32)
    p_g = jax.nn.softmax(lg_g, axis=-1)
    _, g_idx = lax.top_k(lg_g, 1)
    g_prob = jnp.take_along_axis(p_g, g_idx, axis=1)
    lg_e = (xt @ re_w + re_b).astype(jnp.float32).reshape(n, N_GROUPS, EXPERTS_PER_GROUP)
    lg_in = jnp.take_along_axis(lg_e, g_idx[:, :, None], axis=1)[:, 0]
    top_v, top_i = lax.top_k(lg_in, TOP_K_INNER)
    p_in = jax.nn.softmax(top_v, axis=-1)
    w_in = jnp.sum(jax.nn.one_hot(top_i, EXPERTS_PER_GROUP, dtype=jnp.float32) * p_in[..., None], axis=1)
    gate = (jax.nn.one_hot(g_idx[:, 0], N_GROUPS, dtype=jnp.float32)[:, :, None]
            * w_in[:, None, :]).reshape(n, N_EXPERTS) * g_prob
    gate = gate.astype(xt.dtype)
    y = jnp.zeros_like(xt)
    for e in range(N_EXPERTS):
        he = jax.nn.silu(xt @ w_gate[e]) * (xt @ w_up[e])
        y = y + gate[:, e:e + 1] * (he @ w_down[e])
    return y.reshape(shape)


def setup_inputs(seed: int = 0) -> dict:
    key = jax.random.key(seed)
    ks = jax.random.split(key, 28)
    f32 = jnp.float32

    def nrm(k, shape, scale):
        return jax.random.normal(k, shape, f32) * scale

    rad = jax.random.uniform(ks[10], (DEPTH, LRU_WIDTH), f32, 0.9, 0.999)
    s = rad ** (1.0 / LRU_C)
    lru_a_param = jnp.log(s) - jnp.log1p(-s)
    return {
        "x": nrm(ks[0], (BATCH, SEQ, D_MODEL), 1.0),
        "meta_tokens": nrm(ks[1], (N_META, D_MODEL), 1.0),
        "norm1_g": 1.0 + nrm(ks[2], (DEPTH, D_MODEL), 0.02),
        "w_in": nrm(ks[3], (DEPTH, D_MODEL, IN_PROJ_WIDTH), D_MODEL ** -0.5),
        "conv_w": nrm(ks[4], (DEPTH, CONV_W, LRU_WIDTH), CONV_W ** -0.5),
        "conv_b": nrm(ks[5], (DEPTH, LRU_WIDTH), 0.02),
        "gate_a_w": nrm(ks[6], (DEPTH, LRU_BLOCKS, LRU_BLOCK_W, LRU_BLOCK_W), LRU_BLOCK_W ** -0.5),
        "gate_a_b": nrm(ks[7], (DEPTH, LRU_WIDTH), 0.02),
        "gate_x_w": nrm(ks[8], (DEPTH, LRU_BLOCKS, LRU_BLOCK_W, LRU_BLOCK_W), LRU_BLOCK_W ** -0.5),
        "gate_x_b": nrm(ks[9], (DEPTH, LRU_WIDTH), 0.02),
        "lru_a_param": lru_a_param,
        "lambda_q1": nrm(ks[11], (DEPTH, ATT_QK_DIM), 0.1),
        "lambda_k1": nrm(ks[12], (DEPTH, ATT_QK_DIM), 0.1),
        "lambda_q2": nrm(ks[13], (DEPTH, ATT_QK_DIM), 0.1),
        "lambda_k2": nrm(ks[14], (DEPTH, ATT_QK_DIM), 0.1),
        "subln_g": 1.0 + nrm(ks[15], (DEPTH, ATT_V_DIM), 0.02),
        "w_out": nrm(ks[16], (DEPTH, MIX_WIDTH, D_MODEL), MIX_WIDTH ** -0.5),
        "norm2_g": 1.0 + nrm(ks[17], (DEPTH, D_MODEL), 0.02),
        "router_g_w": nrm(ks[18], (DEPTH, D_MODEL, N_GROUPS), D_MODEL ** -0.5),
        "router_g_b": nrm(ks[19], (DEPTH, N_GROUPS), 0.01),
        "router_e_w": nrm(ks[20], (DEPTH, D_MODEL, N_EXPERTS), D_MODEL ** -0.5),
        "router_e_b": nrm(ks[21], (DEPTH, N_EXPERTS), 0.01),
        "exp_w_gate": nrm(ks[22], (DEPTH, N_EXPERTS, D_MODEL, D_EXPERT), D_MODEL ** -0.5),
        "exp_w_up": nrm(ks[23], (DEPTH, N_EXPERTS, D_MODEL, D_EXPERT), D_MODEL ** -0.5),
        "exp_w_down": nrm(ks[24], (DEPTH, N_EXPERTS, D_EXPERT, D_MODEL), D_EXPERT ** -0.5),
        "final_norm_g": 1.0 + nrm(ks[25], (D_MODEL,), 0.02),
    }


def reference(x, meta_tokens, norm1_g, w_in, conv_w, conv_b, gate_a_w, gate_a_b, gate_x_w, gate_x_b,
              lru_a_param, lambda_q1, lambda_k1, lambda_q2, lambda_k2, subln_g, w_out, norm2_g,
              router_g_w, router_g_b, router_e_w, router_e_b, exp_w_gate, exp_w_up, exp_w_down,
              final_norm_g):
    B = x.shape[0]
    meta = jnp.broadcast_to(meta_tokens[None].astype(x.dtype), (B, N_META, D_MODEL))
    h = jnp.concatenate([meta, x], axis=1)
    splits = [LRU_WIDTH, 2 * LRU_WIDTH, 2 * LRU_WIDTH + QK_WIDTH, 2 * LRU_WIDTH + 2 * QK_WIDTH]
    for l in range(DEPTH):
        lam_init = 0.8 - 0.6 * math.exp(-0.3 * l)
        hn = rmsnorm(h, norm1_g[l])
        proj = hn @ w_in[l]
        u, yg, q, k, v = jnp.split(proj, splits, axis=-1)
        lru_out = rg_lru_mixer(u, yg, conv_w[l], conv_b[l], gate_a_w[l], gate_a_b[l],
                               gate_x_w[l], gate_x_b[l], lru_a_param[l])
        lam = (jnp.exp(jnp.sum(lambda_q1[l].astype(jnp.float32) * lambda_k1[l].astype(jnp.float32)))
               - jnp.exp(jnp.sum(lambda_q2[l].astype(jnp.float32) * lambda_k2[l].astype(jnp.float32)))
               + lam_init)
        att_out = diff_attention(q, k, v, lam, lam_init, subln_g[l])
        h = h + jnp.concatenate([lru_out, att_out], axis=-1) @ w_out[l]
        h = h + hier_moe(rmsnorm(h, norm2_g[l]), router_g_w[l], router_g_b[l], router_e_w[l],
                         router_e_b[l], exp_w_gate[l], exp_w_up[l], exp_w_down[l])
    out = rmsnorm(h, final_norm_g)
    return out[:, N_META:]
```

```cpp
#include <hip/hip_runtime.h>
#include <cstdio>
#include <cstdint>

#ifndef MK_N_LAUNCHES
#define MK_N_LAUNCHES 1
#endif

#define LAS __attribute__((address_space(3)))
typedef unsigned short bf16_t;
typedef short bf16x8 __attribute__((ext_vector_type(8)));
typedef short s16x4 __attribute__((ext_vector_type(4)));
typedef float f32x2 __attribute__((ext_vector_type(2)));
typedef float f32x4 __attribute__((ext_vector_type(4)));
typedef float f32x16 __attribute__((ext_vector_type(16)));
typedef unsigned u32x2 __attribute__((ext_vector_type(2)));
typedef unsigned u32x4 __attribute__((ext_vector_type(4)));
typedef int i32x8 __attribute__((ext_vector_type(8)));
typedef int i32x4 __attribute__((ext_vector_type(4)));

constexpr int BATCH = 2, SEQ = 16384, NMETA = 16, TLEN = SEQ + NMETA, DM = 2048, NPROJ = 5120, DEPTH = 2;
constexpr int NREAL = BATCH * SEQ;
constexpr int NTOK = NREAL + BATCH * NMETA;
constexpr int RPAD = 33024, NPAN = RPAD / 256;
constexpr int LRUW = 1024, NEXP = 16, DEXP = 512, NHEAD = 8;
constexpr int XS_ROWS = 2 * NTOK + NEXP * 256;
constexpr int OFF_U = 0, OFF_YG = 1024, OFF_Q = 2048, OFF_K = 3072, OFF_V = 4096;
constexpr float RMS_EPS = 1e-6f;
constexpr float LOG2E = 1.4426950408889634f;
constexpr float QSCALE = 0.125f * LOG2E;

constexpr size_t MiB = 1u << 20;
constexpr size_t WS_CTL = 0, CTL_BYTES = 1 * MiB;
constexpr size_t WS_TOKINFO = 1 * MiB;
constexpr size_t WS_TOKSLOT = WS_TOKINFO + 640 * 1024;
constexpr size_t WS_HIST = WS_TOKSLOT + 320 * 1024;
constexpr size_t WS_LRUSUM = WS_HIST + 64 * 1024;
constexpr size_t WS_HMETA = WS_LRUSUM + 256 * 1024;
constexpr size_t WS_WR = WS_HMETA + 256 * 1024;
constexpr size_t WS_PB = WS_WR + 512 * 1024;
constexpr size_t WS_TOKMAP = WS_PB + 256 * 1024;
constexpr size_t WS_RSLOT = WS_TOKMAP + 288 * 1024;
constexpr size_t WS_RINV = WS_RSLOT + 288 * 1024;
constexpr size_t WS_WGATES = 4 * MiB;
constexpr size_t WS_WIN = 6 * MiB;
constexpr size_t WS_WOUT = 46 * MiB;
constexpr size_t WS_WGU = 62 * MiB;
constexpr size_t WS_WD = 190 * MiB;
constexpr size_t WS_XN = 254 * MiB;
constexpr size_t WS_MIX = 383 * MiB;
constexpr size_t WS_HE = 512 * MiB;
constexpr size_t WS_PROJ = 581 * MiB;
constexpr size_t WS_HB8 = 904 * MiB;
constexpr size_t WS_END = 970 * MiB;
static_assert(WS_WR + 2 * 32 * 2048 * 4 <= WS_PB && WS_PB + 3 * 16384 * 4 <= WS_TOKMAP && (size_t)XS_ROWS * 4 <= 288 * 1024 && WS_RINV + (size_t)RPAD * 4 <= WS_WGATES && WS_PROJ + (size_t)RPAD * NPROJ * 2 <= WS_HB8 && WS_HB8 + (size_t)RPAD * DM <= WS_END && WS_HE + (size_t)XS_ROWS * DEXP * 2 <= WS_PROJ, "ws map");
constexpr int PBL = 16384, PB_CW = 0, PB_CB = 4096, PB_BA = 5120, PB_BX = 6144, PB_SP8 = 7168, PB_SUBG = 8192, PB_RGB = 8320, PB_REB = 8324, PB_LAM = 8352, PB_FING = 2 * PBL;
constexpr int CW_BAR = 4096;
constexpr int CW_QUEUE = 8192;
constexpr int CW_CNT = 8192 + 256;
constexpr int CW_KMAX = 8192 + 512;

constexpr int RING_BYTES = 131072;
constexpr int LCTL_OFF = RING_BYTES;
constexpr int LIDX_OFF = LCTL_OFF + 1024;
constexpr int MAXGU = 12;
constexpr int LDS_BYTES = 147456;
static_assert(LIDX_OFF + MAXGU * 1024 <= LDS_BYTES, "LDS map");

__device__ __forceinline__ unsigned cvt_pk_bf16(float lo, float hi) { unsigned r; asm volatile("v_cvt_pk_bf16_f32 %0, %1, %2" : "=v"(r) : "v"(lo), "v"(hi)); return r; }
constexpr float HE_SCALE = 0.5f, Y8_INV = 1.0f / (64.0f * 0.5f);
constexpr float W8_SCALE = 64.0f, W8_INV = 1.0f / 64.0f;
__device__ __forceinline__ unsigned cvt4_fp8(float a, float b, float c, float d) { int w = __builtin_amdgcn_cvt_pk_fp8_f32(a, b, 0, false); w = __builtin_amdgcn_cvt_pk_fp8_f32(c, d, w, true); return (unsigned)w; }
__device__ __forceinline__ float bf_lo(unsigned u) { return __uint_as_float(u << 16); }
__device__ __forceinline__ float bf_hi(unsigned u) { return __uint_as_float(u & 0xffff0000u); }
__device__ __forceinline__ float shx1(float v) { return __int_as_float(__builtin_amdgcn_mov_dpp(__float_as_int(v), 0xB1, 0xf, 0xf, true)); }
__device__ __forceinline__ float shx2(float v) { return __int_as_float(__builtin_amdgcn_mov_dpp(__float_as_int(v), 0x4E, 0xf, 0xf, true)); }
template <int M> __device__ __forceinline__ float shxs(float v) { return __int_as_float(__builtin_amdgcn_ds_swizzle(__float_as_int(v), (M << 10) | 0x1f)); }
__device__ __forceinline__ float sum32(float v) { const auto r = __builtin_amdgcn_permlane32_swap(__float_as_int(v), __float_as_int(v), false, false); return __int_as_float(r[0]) + __int_as_float(r[1]); }
__device__ __forceinline__ float max32(float v) { const auto r = __builtin_amdgcn_permlane32_swap(__float_as_int(v), __float_as_int(v), false, false); return fmaxf(__int_as_float(r[0]), __int_as_float(r[1])); }
__device__ __forceinline__ float wave_sum(float v) { v += shx1(v); v += shx2(v); v += shxs<4>(v); v += shxs<8>(v); v += shxs<16>(v); return sum32(v); }
__device__ __forceinline__ int crow(int r, int hi) { return (r & 3) + 8 * (r >> 2) + 4 * hi; }
__device__ __forceinline__ int tok_row(int b, int pos) { return pos < NMETA ? NREAL + b * NMETA + pos : b * SEQ + pos - NMETA; }
#define LDS_WAIT() asm volatile("s_waitcnt lgkmcnt(0)" ::: "memory")
#define LDS_BARRIER() do { asm volatile("s_waitcnt lgkmcnt(0)" ::: "memory"); __builtin_amdgcn_s_barrier(); asm volatile("" ::: "memory"); } while (0)
__device__ __forceinline__ void lds_add(LAS unsigned* p, unsigned v) { (void)__hip_atomic_fetch_add(p, v, __ATOMIC_RELAXED, __HIP_MEMORY_SCOPE_WORKGROUP); }

#define XB_TMO      128
#define XB_XCNT(j)  (256  + 64 * (j))
#define XB_XSUB(j)  (1280 + 64 * (j))
#define XB_XGEN(j)  (2304 + 64 * (j))
#define XB_TOP      3328
#define XB_TOPGEN   3392
#define XCD_BAR_WORDS 3456
#define XB_SPIN_CAP (1u << 24)
__device__ __forceinline__ unsigned xb_ld(unsigned* p)              { return __hip_atomic_load(p, __ATOMIC_RELAXED, __HIP_MEMORY_SCOPE_AGENT); }
__device__ __forceinline__ unsigned xb_add(unsigned* p, unsigned v) { return __hip_atomic_fetch_add(p, v, __ATOMIC_RELAXED, __HIP_MEMORY_SCOPE_AGENT); }
__device__ __forceinline__ unsigned xb_xcc_id() { return (unsigned)__builtin_amdgcn_s_getreg((3 << 11) | 20) & 0xFu; }
#define XB_SPIN(cond, bar) do { unsigned _sp = 0; while (cond) { __builtin_amdgcn_s_sleep(1); \
    if ((++_sp & 255u) == 0u) { if (xb_ld(&(bar)[XB_TMO])) break; if (_sp > XB_SPIN_CAP) { atomicAdd(&(bar)[XB_TMO], 1u); break; } } } } while (0)
__device__ __forceinline__ int lane_now() { int l; asm volatile("v_mbcnt_lo_u32_b32 %0, -1, 0\n\tv_mbcnt_hi_u32_b32 %0, -1, %0" : "=v"(l)); return l; }
struct XcdBarrier { unsigned* bar; unsigned x; volatile LAS unsigned* st; int wid; };
__device__ __forceinline__ XcdBarrier xcd_barrier_post(unsigned* bar, volatile LAS unsigned* st, int wid) {
    XcdBarrier b; b.bar = bar; b.x = xb_xcc_id(); b.st = st; b.wid = wid;
    if (wid == 0 && lane_now() == 0) (void)xb_add(&bar[XB_XCNT(b.x)], 1u);
    return b;
}
__device__ __forceinline__ void xcd_barrier_complete(unsigned* bar, unsigned x, unsigned& nloc, unsigned& nx) {
    const unsigned G = gridDim.x * gridDim.y * gridDim.z;
    unsigned sum, cnt, mine, sp = 0u;
    for (;;) {
        sum = 0u; cnt = 0u; mine = 0u;
#pragma unroll
        for (unsigned j = 0; j < 16; ++j) { const unsigned c = xb_ld(&bar[XB_XCNT(j)]); sum += c; cnt += (c > 0u) ? 1u : 0u; mine = (j == x) ? c : mine; }
        if (sum == G) break;
        __builtin_amdgcn_s_sleep(1);
        if ((++sp & 255u) == 0u) { if (xb_ld(&bar[XB_TMO])) break; if (sp > XB_SPIN_CAP) { atomicAdd(&bar[XB_TMO], 1u); break; } }
    }
    nloc = mine > 0u ? mine : 1u; nx = cnt > 0u ? cnt : 1u;
}
__device__ __forceinline__ void xcd_barrier_census(const XcdBarrier& b) {
    if (b.wid == 0 && lane_now() == 0) { unsigned nloc, nx; xcd_barrier_complete(b.bar, b.x, nloc, nx); b.st[0] = nloc; b.st[1] = nx; }
    __syncthreads();
}
__device__ __forceinline__ void xcd_barrier(const XcdBarrier& b) {
    asm volatile("s_waitcnt vmcnt(0)" ::: "memory");
    __syncthreads();
    if (b.wid == 0 && lane_now() == 0) {
        unsigned* bar = b.bar;
        __builtin_amdgcn_s_waitcnt(0);
        const unsigned nloc = b.st[0], nx = b.st[1];
        const unsigned old = xb_add(&bar[XB_XSUB(b.x)], 1u);
        const unsigned gen = old / nloc;
        if (old + 1u == (gen + 1u) * nloc) {
            __builtin_amdgcn_fence(__ATOMIC_RELEASE, "agent");
            asm volatile("s_waitcnt vmcnt(0)" ::: "memory");
            const unsigned og = xb_add(&bar[XB_TOP], 1u);
            const unsigned tg = og / nx;
            if (og + 1u == (tg + 1u) * nx) xb_add(&bar[XB_TOPGEN], 1u);
            else XB_SPIN(xb_ld(&bar[XB_TOPGEN]) == tg, bar);
            __builtin_amdgcn_fence(__ATOMIC_ACQUIRE, "agent");
            xb_add(&bar[XB_XGEN(b.x)], 1u);
            asm volatile("s_waitcnt vmcnt(0)" ::: "memory");
        } else {
            XB_SPIN(xb_ld(&bar[XB_XGEN(b.x)]) == gen, bar);
            __builtin_amdgcn_fence(__ATOMIC_ACQUIRE, "agent");
            asm volatile("s_waitcnt vmcnt(0)" ::: "memory");
        }
    }
    __syncthreads();
}

namespace pg8 {
constexpr int BM = 256, BK = 64, HALF = 128, HTB = HALF * BK * 2, STAGE_BYTES = 8 * HTB, NXCD = 8, WGM = 8;
__host__ __device__ __forceinline__ int lds_byte(int r, int c) { const int st = (r >> 4) * 2 + (c >> 5), rr = r & 15, cc = c & 31, ob = rr * 64 + cc * 2; return st * 1024 + (ob ^ (((ob >> 9) & 1) << 5)); }
__host__ __device__ __forceinline__ void stage_rc(int b, int& R, int& C) { const int st = b / 1024, sb = b % 1024, swz = sb ^ (((sb >> 9) & 1) << 5); R = (st >> 1) * 16 + swz / 64; C = (st & 1) * 32 + (swz % 64) / 2; }
__host__ __device__ __forceinline__ int perm32(int rho) { const int n = rho >> 4, i = rho & 15; return 8 * (i >> 2) + 4 * n + (i & 3); }

struct Unit { const char* A; const char* B; int row0, col0; };

struct DenseOrder {
    const char* A; const char* Bt; size_t tstep; int nM, nN, nwg, G, c;
    __device__ void init(const void* A_, const void* Bt_, int M, int N, int K, int G_, int c_) { A = (const char*)A_; Bt = (const char*)Bt_; tstep = (size_t)BM * K * 2; nM = M / BM; nN = N / BM; nwg = nM * nN; G = G_; c = c_; }
    __device__ bool next(int i, Unit& u) const {
        const long L = (long)i * G + c; if (L >= nwg) return false;
        int wgid = (int)L; { const int q = nwg / NXCD, r = nwg % NXCD, xcd = wgid % NXCD, off = wgid / NXCD; wgid = (xcd < r ? xcd * (q + 1) : r * (q + 1) + (xcd - r) * q) + off; }
        const int nig = WGM * nN, gid = wgid / nig, fm = gid * WGM, gsz = (nM - fm) < WGM ? (nM - fm) : WGM;
        const int pm = fm + ((wgid % nig) % gsz), pn = (wgid % nig) / gsz;
        u.A = A + (size_t)pm * tstep; u.B = Bt + (size_t)pn * tstep; u.row0 = pm * BM; u.col0 = pn * BM; return true;
    }
};
struct MoeOrder {
    const char* A; const char* Bt; size_t rowbytes, ebytes, tstepB; int NT, G, c; const LAS int* pp; const LAS int* sb;
    __device__ bool next(int i, Unit& u) const {
        int pg, pn;
        if ((G & 7) == 0 && ((G >> 3) % NT) == 0) { const int x = c & 7, idx = c >> 3, ppr = (G >> 3) / NT; pn = idx % NT; pg = i * (8 * ppr) + x * ppr + idx / NT; }
        else { const long L = (long)i * G + c; pg = (int)(L / NT); pn = (int)(L % NT); }
        if (pg >= pp[16]) return false;
        int e = 0;
#pragma unroll
        for (int j = 1; j < 16; ++j) e += (pg >= pp[j]) ? 1 : 0;
        e = __builtin_amdgcn_readfirstlane(e);
        const int row0 = __builtin_amdgcn_readfirstlane(sb[e] + (pg - pp[e]) * BM);
        u.A = A + (size_t)row0 * rowbytes; u.B = Bt + (size_t)e * ebytes + (size_t)pn * tstepB; u.row0 = row0; u.col0 = pn * BM; return true;
    }
};

struct EpiBf16 {
    static constexpr bool PERM = true;
    bf16_t* O; int ldc; float sc;
    __device__ __forceinline__ void operator()(const f32x4 (&acc)[2][2][4][2], const Unit& u, int wr, int wc, int fr, int fq) const {
        const int row0 = u.row0 + wr * 64 + fr, col0 = u.col0 + wc * 32 + 8 * fq;
#pragma unroll
        for (int ai = 0; ai < 2; ++ai)
#pragma unroll
            for (int m = 0; m < 4; ++m) { bf16_t* rowp = O + (size_t)(row0 + ai * HALF + m * 16) * ldc + col0;
#pragma unroll
                for (int bj = 0; bj < 2; ++bj) { const f32x4 v0 = acc[ai][bj][m][0] * sc, v1 = acc[ai][bj][m][1] * sc;
                    u32x4 w; w.x = cvt_pk_bf16(v0[0], v0[1]); w.y = cvt_pk_bf16(v0[2], v0[3]); w.z = cvt_pk_bf16(v1[0], v1[1]); w.w = cvt_pk_bf16(v1[2], v1[3]);
                    *(u32x4*)(rowp + bj * HALF) = w; } }
    }
};
struct EpiY8 {
    static constexpr bool PERM = true;
    unsigned char* O;
    __device__ __forceinline__ void operator()(const f32x4 (&acc)[2][2][4][2], const Unit& u, int wr, int wc, int fr, int fq) const {
        const int row0 = u.row0 + wr * 64 + fr, col0 = u.col0 + wc * 32 + 8 * fq;
#pragma unroll
        for (int ai = 0; ai < 2; ++ai)
#pragma unroll
            for (int m = 0; m < 4; ++m) { unsigned char* rowp = O + (size_t)(row0 + ai * HALF + m * 16) * DM + col0;
#pragma unroll
                for (int bj = 0; bj < 2; ++bj) { const f32x4 v0 = acc[ai][bj][m][0], v1 = acc[ai][bj][m][1];
                    u32x2 w; w.x = cvt4_fp8(v0[0], v0[1], v0[2], v0[3]); w.y = cvt4_fp8(v1[0], v1[1], v1[2], v1[3]); *(u32x2*)(rowp + bj * HALF) = w; } }
    }
};
struct EpiSwiGLU {
    static constexpr bool PERM = true;
    unsigned char* O; const float* rs;
    __device__ __forceinline__ void operator()(const f32x4 (&acc)[2][2][4][2], const Unit& u, int wr, int wc, int fr, int fq) const {
        const int row0 = u.row0 + wr * 64 + fr, hid0 = (u.col0 + wc * 32 + 8 * fq) >> 1;
#pragma unroll
        for (int ai = 0; ai < 2; ++ai)
#pragma unroll
            for (int m = 0; m < 4; ++m) { unsigned char* rowp = O + (size_t)(row0 + ai * HALF + m * 16) * DEXP + hid0; const float rsv = rs[row0 + ai * HALF + m * 16] * W8_INV;
#pragma unroll
                for (int bj = 0; bj < 2; ++bj) { const f32x4 g = acc[ai][bj][m][0] * rsv, up = acc[ai][bj][m][1] * (rsv * HE_SCALE); float o[4];
#pragma unroll
                    for (int j = 0; j < 4; ++j) { const float s = g[j] / (1.0f + __expf(-g[j])); o[j] = s * up[j]; }
                    *(unsigned*)(rowp + bj * (HALF / 2)) = cvt4_fp8(o[0], o[1], o[2], o[3]); } }
    }
};
struct EpiResid {
    static constexpr bool PERM = true;
    bf16_t* hb; const float* rms; unsigned char* hb8;
    __device__ __forceinline__ void operator()(const f32x4 (&acc)[2][2][4][2], const Unit& u, int wr, int wc, int fr, int fq) const {
        const int row0 = u.row0 + wr * 64 + fr;
        const size_t off0 = (size_t)row0 * DM + (u.col0 + wc * 32 + 8 * fq);
        u32x4 q[2][4][2]; float sc[2][4];
#pragma unroll
        for (int ai = 0; ai < 2; ++ai)
#pragma unroll
            for (int m = 0; m < 4; ++m) { sc[ai][m] = rms[row0 + ai * HALF + m * 16];
#pragma unroll
                for (int bj = 0; bj < 2; ++bj) q[ai][m][bj] = *(const u32x4*)(hb + off0 + (size_t)(ai * HALF + m * 16) * DM + bj * HALF); }
#pragma unroll
        for (int ai = 0; ai < 2; ++ai)
#pragma unroll
            for (int m = 0; m < 4; ++m)
#pragma unroll
                for (int bj = 0; bj < 2; ++bj) { const u32x4 t = q[ai][m][bj]; const float r = sc[ai][m]; const size_t o = off0 + (size_t)(ai * HALF + m * 16) * DM + bj * HALF;
                    const f32x4 v0 = acc[ai][bj][m][0] + (f32x4){bf_lo(t.x), bf_hi(t.x), bf_lo(t.y), bf_hi(t.y)} * r, v1 = acc[ai][bj][m][1] + (f32x4){bf_lo(t.z), bf_hi(t.z), bf_lo(t.w), bf_hi(t.w)} * r;
                    u32x4 w; w.x = cvt_pk_bf16(v0[0], v0[1]); w.y = cvt_pk_bf16(v0[2], v0[3]); w.z = cvt_pk_bf16(v1[0], v1[1]); w.w = cvt_pk_bf16(v1[2], v1[3]);
                    *(u32x4*)(hb + o) = w;
                    u32x2 w8; w8.x = cvt4_fp8(v0[0], v0[1], v0[2], v0[3]); w8.y = cvt4_fp8(v1[0], v1[1], v1[2], v1[3]); *(u32x2*)(hb8 + o) = w8; }
    }
};

template <class Epi, class Sched, bool ALIGN_EPI = true, bool SP2 = true, bool GATHER = false, bool FP8 = false>
__device__ __forceinline__ void gemm_phase(LAS unsigned char* lds, const int wid, const int Kel, const Sched& S, const Epi& E, const char* Ab = nullptr, const LAS int* idx = nullptr) {
    static_assert(!GATHER || SP2, "gather needs the SP2 loop");
    const int lane = lane_now(), tid = (wid << 6) | lane, wr = wid >> 2, wc = wid & 3, fr = lane & 15, fq = lane >> 4;
    const int K = FP8 ? (Kel >> 1) : Kel;
    int nt = K / BK; asm volatile("" : "+s"(nt));
    unsigned voffA[2], voffB[2];
#pragma unroll
    for (int i = 0; i < 2; ++i) { int R, C; stage_rc(tid * 16 + i * 8192, R, C); const int Rb = Epi::PERM ? ((R & ~31) + perm32(R & 31)) : R;
        voffA[i] = (unsigned)(R * K + C) * 2u; voffB[i] = (unsigned)(Rb * K + C) * 2u; }
    unsigned goff[2][2];
#define PG8_GOFF(dst, unit_i) do { const int tz_ = (wid << 6) | lane_now(); _Pragma("unroll") for (int i_ = 0; i_ < 2; ++i_) { int R_, C_; stage_rc(tz_ * 16 + i_ * 8192, R_, C_); \
        _Pragma("unroll") for (int h_ = 0; h_ < 2; ++h_) dst[h_][i_] = (unsigned)idx[(unit_i) * 256 + 128 * h_ + R_] * (unsigned)(K * 2) + (unsigned)(C_ * 2); } } while (0)
    const size_t kstep = (size_t)(BK * 2);
    const size_t hstep = (size_t)HALF * K * 2;
    const unsigned ldsw = (unsigned)wid * 1024u;
    const int aoff = lds_byte(wr * 64 + fr, fq * 8), boff = lds_byte(wc * 32 + fr, fq * 8);
#define PG8_SA(b, h) (((b) * 2 + (h)) * HTB)
#define PG8_SB(b, h) ((4 + (b) * 2 + (h)) * HTB)
#define PG8_STAGE(bufoff, gbase, voff) do { _Pragma("unroll") for (int _i = 0; _i < 2; ++_i) \
        __builtin_amdgcn_global_load_lds((const unsigned*)((const char*)(gbase) + (voff)[_i]), (LAS unsigned*)(lds + (bufoff) + ldsw + _i * 8192), 16, 0, 0); } while (0)
#define PG8_LDA(dst, b, h) do { _Pragma("unroll") for (int m = 0; m < 4; ++m) _Pragma("unroll") for (int k = 0; k < 2; ++k) dst[m][k] = *(const LAS bf16x8*)(lds + PG8_SA(b, h) + aoff + m * 2048 + k * 1024); } while (0)
#define PG8_LDB(dst, b, h) do { _Pragma("unroll") for (int n = 0; n < 2; ++n) _Pragma("unroll") for (int k = 0; k < 2; ++k) dst[n][k] = *(const LAS bf16x8*)(lds + PG8_SB(b, h) + boff + n * 2048 + k * 1024); } while (0)
#define PG8_CAT(f) __builtin_shufflevector(__builtin_bit_cast(i32x4, f[0]), __builtin_bit_cast(i32x4, f[1]), 0, 1, 2, 3, 4, 5, 6, 7)
#define PG8_MMA(ai, bj, At, Bt) do { __builtin_amdgcn_s_setprio(1); _Pragma("unroll") for (int m = 0; m < 4; ++m) _Pragma("unroll") for (int n = 0; n < 2; ++n) { \
        if constexpr (FP8) acc[ai][bj][m][n] = __builtin_amdgcn_mfma_scale_f32_16x16x128_f8f6f4(PG8_CAT(Bt[n]), PG8_CAT(At[m]), acc[ai][bj][m][n], 0, 0, 0, 0, 0, 0); \
        else { _Pragma("unroll") for (int k = 0; k < 2; ++k) acc[ai][bj][m][n] = __builtin_amdgcn_mfma_f32_16x16x32_bf16(Bt[n][k], At[m][k], acc[ai][bj][m][n], 0, 0, 0); } } \
        __builtin_amdgcn_s_setprio(0); } while (0)
#define PG8_WAIT_V(n) asm volatile("s_waitcnt vmcnt(" #n ")" ::: "memory")
#define PG8_WAIT_L(n) asm volatile("s_waitcnt lgkmcnt(" #n ")" ::: "memory")
#define PG8_BAR __builtin_amdgcn_s_barrier()
#define PG8_SCHED __builtin_amdgcn_sched_barrier(0)
    Unit cur, nxt; int ui = 0;
    if (!S.next(0, cur)) return;
    f32x4 acc[2][2][4][2];
#pragma unroll
    for (int a = 0; a < 2; ++a)
#pragma unroll
        for (int b = 0; b < 2; ++b)
#pragma unroll
            for (int m = 0; m < 4; ++m)
#pragma unroll
                for (int n = 0; n < 2; ++n) acc[a][b][m][n] = (f32x4){0.f, 0.f, 0.f, 0.f};
    bf16x8 At[4][2], B0[2][2], B1[2][2];
    const char* cA = cur.A; const char* cB = cur.B;
    if constexpr (GATHER) {
        PG8_GOFF(goff, 0);
        PG8_STAGE(PG8_SB(0, 0), cB, voffB); PG8_STAGE(PG8_SB(0, 1), cB + hstep, voffB); PG8_STAGE(PG8_SA(0, 0), Ab, goff[0]); PG8_STAGE(PG8_SA(0, 1), Ab, goff[1]);
        if (wr == 1) PG8_BAR;
        PG8_WAIT_V(2); PG8_BAR;
        PG8_STAGE(PG8_SB(1, 0), cB + kstep, voffB); PG8_STAGE(PG8_SA(1, 0), Ab + kstep, goff[0]); PG8_STAGE(PG8_SB(1, 1), cB + hstep + kstep, voffB);
        PG8_WAIT_V(6); PG8_BAR;
    } else if constexpr (SP2) {
        PG8_STAGE(PG8_SB(0, 0), cB, voffB); PG8_STAGE(PG8_SB(0, 1), cB + hstep, voffB); PG8_STAGE(PG8_SA(0, 0), cA, voffA); PG8_STAGE(PG8_SA(0, 1), cA + hstep, voffA);
        if (wr == 1) PG8_BAR;
        PG8_WAIT_V(2); PG8_BAR;
        PG8_STAGE(PG8_SB(1, 0), cB + kstep, voffB); PG8_STAGE(PG8_SA(1, 0), cA + kstep, voffA); PG8_STAGE(PG8_SB(1, 1), cB + hstep + kstep, voffB);
        PG8_WAIT_V(6); PG8_BAR;
    } else {
        PG8_STAGE(PG8_SB(0, 0), cB, voffB); PG8_STAGE(PG8_SA(0, 0), cA, voffA); PG8_STAGE(PG8_SB(0, 1), cB + hstep, voffB); PG8_STAGE(PG8_SA(0, 1), cA + hstep, voffA);
        if (wr == 1) PG8_BAR;
        PG8_WAIT_V(4); PG8_BAR;
        PG8_STAGE(PG8_SB(1, 0), cB + kstep, voffB); PG8_STAGE(PG8_SA(1, 0), cA + kstep, voffA); PG8_STAGE(PG8_SB(1, 1), cB + hstep + kstep, voffB);
        PG8_WAIT_V(6); PG8_BAR;
    }
    for (;;) {
        const bool has_next = S.next(ui + 1, nxt);
        const char* nA = has_next ? nxt.A : cA; const char* nB = has_next ? nxt.B : cB;
#pragma unroll 1
        for (int t = 0; t < nt; t += 2) {
            const bool last = (t == nt - 2);
            asm volatile("" : "+v"(voffA[0]), "+v"(voffA[1]), "+v"(voffB[0]), "+v"(voffB[1]));
            const char* a1 = cA + (size_t)(t + 1) * kstep;
            const char* a2 = last ? nA : cA + (size_t)(t + 2) * kstep; const char* b2 = last ? nB : cB + (size_t)(t + 2) * kstep;
            const char* a3 = a2 + kstep; const char* b3 = b2 + kstep;
            if constexpr (GATHER) {
            const char* g1 = Ab + (size_t)(t + 1) * kstep; const char* g2 = last ? Ab : Ab + (size_t)(t + 2) * kstep; const char* g3 = g2 + kstep;
            PG8_LDB(B0, 0, 0); PG8_LDB(B1, 0, 1); PG8_SCHED; PG8_LDA(At, 0, 0); PG8_STAGE(PG8_SA(1, 1), g1, goff[1]);
            PG8_WAIT_V(8); PG8_WAIT_L(0); PG8_BAR; PG8_MMA(0, 0, At, B0); PG8_MMA(0, 1, At, B1); PG8_BAR; PG8_SCHED;
            if (last && has_next) PG8_GOFF(goff, ui + 1);
            PG8_LDA(At, 0, 1); PG8_STAGE(PG8_SB(0, 0), b2, voffB); PG8_STAGE(PG8_SB(0, 1), b2 + hstep, voffB); PG8_STAGE(PG8_SA(0, 0), g2, goff[0]);
            PG8_WAIT_V(8); PG8_WAIT_L(0); PG8_BAR; PG8_MMA(1, 0, At, B0); PG8_MMA(1, 1, At, B1); PG8_BAR; PG8_SCHED;
            PG8_LDB(B0, 1, 0); PG8_LDB(B1, 1, 1); PG8_SCHED; PG8_LDA(At, 1, 0); PG8_STAGE(PG8_SA(0, 1), g2, goff[1]);
            PG8_WAIT_V(8); PG8_WAIT_L(0); PG8_BAR; PG8_MMA(0, 0, At, B0); PG8_MMA(0, 1, At, B1); PG8_BAR; PG8_SCHED;
            PG8_LDA(At, 1, 1); PG8_STAGE(PG8_SB(1, 0), b3, voffB); PG8_STAGE(PG8_SB(1, 1), b3 + hstep, voffB); PG8_STAGE(PG8_SA(1, 0), g3, goff[0]);
            PG8_WAIT_V(8); PG8_WAIT_L(0); PG8_BAR; PG8_MMA(1, 0, At, B0); PG8_MMA(1, 1, At, B1); PG8_BAR; PG8_SCHED;
            } else if constexpr (SP2) {
            PG8_LDB(B0, 0, 0); PG8_LDB(B1, 0, 1); PG8_SCHED; PG8_LDA(At, 0, 0); PG8_STAGE(PG8_SA(1, 1), a1 + hstep, voffA);
            PG8_WAIT_V(8); PG8_WAIT_L(0); PG8_BAR; PG8_MMA(0, 0, At, B0); PG8_MMA(0, 1, At, B1); PG8_BAR; PG8_SCHED;
            PG8_LDA(At, 0, 1); PG8_STAGE(PG8_SB(0, 0), b2, voffB); PG8_STAGE(PG8_SB(0, 1), b2 + hstep, voffB); PG8_STAGE(PG8_SA(0, 0), a2, voffA);
            PG8_WAIT_V(8); PG8_WAIT_L(0); PG8_BAR; PG8_MMA(1, 0, At, B0); PG8_MMA(1, 1, At, B1); PG8_BAR; PG8_SCHED;
            PG8_LDB(B0, 1, 0); PG8_LDB(B1, 1, 1); PG8_SCHED; PG8_LDA(At, 1, 0); PG8_STAGE(PG8_SA(0, 1), a2 + hstep, voffA);
            PG8_WAIT_V(8); PG8_WAIT_L(0); PG8_BAR; PG8_MMA(0, 0, At, B0); PG8_MMA(0, 1, At, B1); PG8_BAR; PG8_SCHED;
            PG8_LDA(At, 1, 1); PG8_STAGE(PG8_SB(1, 0), b3, voffB); PG8_STAGE(PG8_SB(1, 1), b3 + hstep, voffB); PG8_STAGE(PG8_SA(1, 0), a3, voffA);
            PG8_WAIT_V(8); PG8_WAIT_L(0); PG8_BAR; PG8_MMA(1, 0, At, B0); PG8_MMA(1, 1, At, B1); PG8_BAR; PG8_SCHED;
            } else {
            PG8_LDB(B0, 0, 0); PG8_SCHED; PG8_LDA(At, 0, 0); PG8_STAGE(PG8_SA(1, 1), a1 + hstep, voffA);
            PG8_WAIT_L(8); PG8_BAR; PG8_WAIT_L(0); PG8_MMA(0, 0, At, B0); PG8_BAR; PG8_SCHED;
            PG8_LDB(B1, 0, 1); PG8_STAGE(PG8_SB(0, 0), b2, voffB);
            PG8_BAR; PG8_WAIT_L(0); PG8_MMA(0, 1, At, B1); PG8_BAR;
            PG8_LDA(At, 0, 1); PG8_STAGE(PG8_SA(0, 0), a2, voffA);
            PG8_BAR; PG8_WAIT_L(0); PG8_MMA(1, 0, At, B0); PG8_BAR; PG8_SCHED;
            PG8_STAGE(PG8_SB(0, 1), b2 + hstep, voffB);
            PG8_WAIT_V(6); PG8_BAR; PG8_MMA(1, 1, At, B1); PG8_BAR;
            PG8_LDB(B0, 1, 0); PG8_SCHED; PG8_LDA(At, 1, 0); PG8_STAGE(PG8_SA(0, 1), a2 + hstep, voffA);
            PG8_WAIT_L(8); PG8_BAR; PG8_WAIT_L(0); PG8_MMA(0, 0, At, B0); PG8_BAR; PG8_SCHED;
            PG8_LDB(B1, 1, 1); PG8_STAGE(PG8_SB(1, 0), b3, voffB);
            PG8_BAR; PG8_WAIT_L(0); PG8_MMA(0, 1, At, B1); PG8_BAR;
            PG8_LDA(At, 1, 1); PG8_STAGE(PG8_SA(1, 0), a3, voffA);
            PG8_BAR; PG8_WAIT_L(0); PG8_MMA(1, 0, At, B0); PG8_BAR; PG8_SCHED;
            PG8_STAGE(PG8_SB(1, 1), b3 + hstep, voffB);
            PG8_WAIT_V(6); PG8_BAR; PG8_MMA(1, 1, At, B1); PG8_BAR;
            }
        }
        if constexpr (ALIGN_EPI) { if (wr == 0) PG8_BAR; }
        { const int lz = lane_now(); E(acc, cur, wr, wc, lz & 15, lz >> 4); }
        if (!has_next) break;
#pragma unroll
        for (int a = 0; a < 2; ++a)
#pragma unroll
            for (int b = 0; b < 2; ++b)
#pragma unroll
                for (int m = 0; m < 4; ++m)
#pragma unroll
                    for (int n = 0; n < 2; ++n) acc[a][b][m][n] = (f32x4){0.f, 0.f, 0.f, 0.f};
        cur = nxt; cA = nA; cB = nB; ++ui;
        if constexpr (ALIGN_EPI) { if (wr == 1) PG8_BAR; }
    }
    PG8_WAIT_V(0);
    if constexpr (!ALIGN_EPI) { if (wr == 0) PG8_BAR; }
    PG8_BAR;
#undef PG8_GOFF
#undef PG8_CAT
#undef PG8_SA
#undef PG8_SB
#undef PG8_STAGE
#undef PG8_LDA
#undef PG8_LDB
#undef PG8_MMA
#undef PG8_WAIT_V
#undef PG8_WAIT_L
#undef PG8_BAR
#undef PG8_SCHED
}
}

struct Params {
    const float* in[26];
    float* out;
    unsigned char* ws;
    int ph_lo, ph_hi;
};
struct Frame {
    LAS unsigned char* lds;
    volatile LAS unsigned* LC;
    unsigned* ctl;
    unsigned char* ws;
    int G, bid, wid;
};
#define PHASE_IDS() int wid = F.wid; asm volatile("" : "+s"(wid)); const int lane = lane_now(); const int tid = (wid << 6) | lane; (void)tid

__device__ __forceinline__ void tr_item(const float* W, int K, int N, bf16_t* WT, int item, LAS float* scr, int lane, const float* gk, int qscale, int rowmap) {
    const int nblk = N / 32, kb = item / nblk, nb = item % nblk, k0 = 64 * kb, n0 = 32 * nb;
    float tv[32];
#pragma unroll
    for (int i = 0; i < 32; ++i) { const int kk = 2 * i + (lane >> 5); tv[i] = W[(size_t)(k0 + kk) * N + n0 + (lane & 31)]; }
#pragma unroll
    for (int i = 0; i < 32; ++i) { const int kk = 2 * i + (lane >> 5); const int n = n0 + (lane & 31);
        float v = tv[i]; if (gk) v *= gk[k0 + kk]; if (qscale && n >= OFF_Q && n < OFF_K) v *= QSCALE;
        scr[kk * 33 + (lane & 31)] = v; }
    LDS_WAIT(); asm volatile("" ::: "memory");
    const int c = lane & 7;
#pragma unroll
    for (int j = 0; j < 4; ++j) { const int n = (lane >> 3) + 8 * j; const LAS float* s = scr + (8 * c) * 33 + n;
        u32x4 o; o.x = cvt_pk_bf16(s[0 * 33], s[1 * 33]); o.y = cvt_pk_bf16(s[2 * 33], s[3 * 33]); o.z = cvt_pk_bf16(s[4 * 33], s[5 * 33]); o.w = cvt_pk_bf16(s[6 * 33], s[7 * 33]);
        const int ng = n0 + n; const int dr = rowmap == 0 ? ng : (8 * (ng >> 2) + (ng & 3) + (rowmap == 2 ? 4 : 0));
        *(u32x4*)(WT + (size_t)dr * K + k0 + 8 * c) = o; }
    LDS_WAIT(); asm volatile("" ::: "memory");
}
__device__ __forceinline__ void tr_item8(const float* W, int K, int N, unsigned char* WT, int item, LAS float* scr, int lane, const float* gk, int rowmap) {
    const int nblk = N / 32, kb = item / nblk, nb = item % nblk, k0 = 64 * kb, n0 = 32 * nb;
    float tv[32];
#pragma unroll
    for (int i = 0; i < 32; ++i) { const int kk = 2 * i + (lane >> 5); tv[i] = W[(size_t)(k0 + kk) * N + n0 + (lane & 31)]; }
#pragma unroll
    for (int i = 0; i < 32; ++i) { const int kk = 2 * i + (lane >> 5); float v = tv[i] * W8_SCALE; if (gk) v *= gk[k0 + kk]; scr[kk * 33 + (lane & 31)] = v; }
    LDS_WAIT(); asm volatile("" ::: "memory");
    const int c = lane & 3;
#pragma unroll
    for (int j = 0; j < 2; ++j) { const int n = (lane >> 2) + 16 * j; const LAS float* sp = scr + (16 * c) * 33 + n;
        u32x4 o; o.x = cvt4_fp8(sp[0 * 33], sp[1 * 33], sp[2 * 33], sp[3 * 33]); o.y = cvt4_fp8(sp[4 * 33], sp[5 * 33], sp[6 * 33], sp[7 * 33]);
        o.z = cvt4_fp8(sp[8 * 33], sp[9 * 33], sp[10 * 33], sp[11 * 33]); o.w = cvt4_fp8(sp[12 * 33], sp[13 * 33], sp[14 * 33], sp[15 * 33]);
        const int ng = n0 + n; const int dr = rowmap == 0 ? ng : (8 * (ng >> 2) + (ng & 3) + (rowmap == 2 ? 4 : 0));
        *(u32x4*)(WT + (size_t)dr * K + k0 + 16 * c) = o; }
    LDS_WAIT(); asm volatile("" ::: "memory");
}
__device__ __forceinline__ void norm_row_to_bf16(const float* xrow, bf16_t* orow, float* rinv, int lane) {
    const f32x4* xr = (const f32x4*)xrow + lane;
    f32x4 v[8]; float s = 0.f;
#pragma unroll
    for (int j = 0; j < 8; ++j) { v[j] = xr[64 * j]; s += (v[j].x * v[j].x + v[j].y * v[j].y) + (v[j].z * v[j].z + v[j].w * v[j].w); }
    const float rms = sqrtf(wave_sum(s) * (1.f / DM) + RMS_EPS), rstd = 1.0f / rms;
    if (lane == 0) *rinv = rms;
    u32x2* o8 = (u32x2*)orow + lane;
#pragma unroll
    for (int j = 0; j < 8; ++j) { u32x2 w; w.x = cvt_pk_bf16(v[j].x * rstd, v[j].y * rstd); w.y = cvt_pk_bf16(v[j].z * rstd, v[j].w * rstd); o8[64 * j] = w; }
}
__device__ __forceinline__ void norm_rows2_to_bf16(const float* xrow, bf16_t* orow, float* rinv, int lane) {
    const f32x4* xr = (const f32x4*)xrow + lane;
    f32x4 v[16]; float s0 = 0.f, s1 = 0.f;
#pragma unroll
    for (int j = 0; j < 16; ++j) v[j] = xr[64 * j];
#pragma unroll
    for (int j = 0; j < 8; ++j) { s0 += (v[j].x * v[j].x + v[j].y * v[j].y) + (v[j].z * v[j].z + v[j].w * v[j].w); s1 += (v[8 + j].x * v[8 + j].x + v[8 + j].y * v[8 + j].y) + (v[8 + j].z * v[8 + j].z + v[8 + j].w * v[8 + j].w); }
    const float q0 = sqrtf(wave_sum(s0) * (1.f / DM) + RMS_EPS), q1 = sqrtf(wave_sum(s1) * (1.f / DM) + RMS_EPS), r0 = 1.0f / q0, r1 = 1.0f / q1;
    if (lane == 0) { rinv[0] = q0; rinv[1] = q1; }
    u32x2* o8 = (u32x2*)orow + lane;
#pragma unroll
    for (int j = 0; j < 16; ++j) { const float r = j < 8 ? r0 : r1; u32x2 w; w.x = cvt_pk_bf16(v[j].x * r, v[j].y * r); w.y = cvt_pk_bf16(v[j].z * r, v[j].w * r); o8[64 * j] = w; }
}
__device__ __forceinline__ void p0_prologue(Frame& F, const Params& p) {
    PHASE_IDS();
    LAS float* scr = (LAS float*)(F.lds + wid * 16384);
    const int gw = F.bid * 8 + wid, NGW = F.G * 8;
    constexpr int I_IN = 32 * 160, I_OUT = 32 * 64, I_GU = 32 * 16, I_D = 8 * 64, I_G = 2 * 4;
    constexpr int N_IN = 2 * I_IN, N_OUT = 2 * I_OUT, N_GU = 2 * 16 * 2 * I_GU, N_D = 2 * 16 * I_D, N_G = 2 * 2 * 8 * I_G;
    constexpr int NITEMS = N_IN + N_OUT + N_GU + N_D + N_G;
    unsigned char* ws = F.ws;
    for (int it = gw; it < NITEMS; it += NGW) {
        int r = it;
        if (r < N_IN) { const int l = r / I_IN; tr_item(p.in[3] + (size_t)l * DM * NPROJ, DM, NPROJ, (bf16_t*)(ws + WS_WIN) + (size_t)l * NPROJ * DM, r % I_IN, scr, lane, p.in[2] + l * DM, 1, 0); continue; } r -= N_IN;
        if (r < N_OUT) { const int l = r / I_OUT; tr_item(p.in[16] + (size_t)l * DM * DM, DM, DM, (bf16_t*)(ws + WS_WOUT) + (size_t)l * DM * DM, r % I_OUT, scr, lane, nullptr, 0, 0); continue; } r -= N_OUT;
        if (r < N_GU) { const int le = r / (2 * I_GU), rr = r % (2 * I_GU), which = rr / I_GU; const int l = le >> 4;
            tr_item8(p.in[which ? 23 : 22] + (size_t)le * DM * DEXP, DM, DEXP, (unsigned char*)(ws + WS_WGU) + (size_t)le * 1024 * DM, rr % I_GU, scr, lane, p.in[17] + l * DM, which ? 2 : 1); continue; } r -= N_GU;
        if (r < N_D) { const int le = r / I_D; tr_item8(p.in[24] + (size_t)le * DEXP * DM, DEXP, DM, (unsigned char*)(ws + WS_WD) + (size_t)le * DM * DEXP, r % I_D, scr, lane, nullptr, 0); continue; } r -= N_D;
        { const int mi = r / I_G; const int l = mi >> 4, which = (mi >> 3) & 1, g = mi & 7;
          tr_item(p.in[which ? 8 : 6] + (size_t)(l * 8 + g) * 128 * 128, 128, 128, (bf16_t*)(ws + WS_WGATES) + (size_t)((l * 2 + which) * 8 + g) * 128 * 128, r % I_G, scr, lane, nullptr, 0, 0); }
    }
    bf16_t* wr = (bf16_t*)(ws + WS_WR);
    for (int i = F.bid * 512 + tid; i < 2 * 32 * DM; i += F.G * 512) { const int l = i / (32 * DM), o = (i / DM) % 32, k = i % DM;
        const float w0 = o < 4 ? p.in[18][((size_t)l * DM + k) * 4 + o] : o < 20 ? p.in[20][((size_t)l * DM + k) * 16 + (o - 4)] : 0.f;
        const float w = w0 * p.in[17][l * DM + k];
        const unsigned hb_ = cvt_pk_bf16(w, 0.f) & 0xffffu; const float whi = __uint_as_float(hb_ << 16);
        wr[((size_t)(l * 2 + 0) * 32 + o) * DM + k] = (bf16_t)hb_; wr[((size_t)(l * 2 + 1) * 32 + o) * DM + k] = (bf16_t)(cvt_pk_bf16(w - whi, 0.f) & 0xffffu); }
    { float* pb = (float*)(ws + WS_PB);
      for (int i = F.bid * 512 + tid; i < 2 * PBL + DM; i += F.G * 512) {
          if (i >= 2 * PBL) { pb[i] = p.in[25][i - 2 * PBL]; continue; }
          const int l = i / PBL, o = i % PBL; float v = 0.f;
          if (o < PB_CB) v = p.in[4][l * 4096 + o];
          else if (o < PB_BA) v = p.in[5][l * LRUW + o - PB_CB];
          else if (o < PB_BX) v = p.in[7][l * LRUW + o - PB_BA];
          else if (o < PB_SP8) v = p.in[9][l * LRUW + o - PB_BX];
          else if (o < PB_SUBG) v = -8.0f * log1pf(__expf(-p.in[10][l * LRUW + o - PB_SP8]));
          else if (o < PB_RGB) v = p.in[15][l * 128 + o - PB_SUBG];
          else if (o < PB_REB) v = p.in[19][l * 4 + o - PB_RGB];
          else if (o < PB_REB + 16) v = p.in[21][l * 16 + o - PB_REB];
          else if (o == PB_LAM || o == PB_LAM + 1) continue;
          pb[i] = v; }
      if (F.bid == 0 && wid < DEPTH) {
          const int l = wid; const float s1 = wave_sum(p.in[11][l * 64 + lane] * p.in[12][l * 64 + lane]), s2 = wave_sum(p.in[13][l * 64 + lane] * p.in[14][l * 64 + lane]);
          const float lam_init = 0.8f - 0.6f * expf(-0.3f * (float)l);
          if (lane == 0) { pb[l * PBL + PB_LAM] = expf(s1) - expf(s2) + lam_init; pb[l * PBL + PB_LAM + 1] = lam_init; } } }
    bf16_t* xn = (bf16_t*)(ws + WS_XN);
    for (int m = 2 * gw; m < NREAL; m += 2 * NGW) norm_rows2_to_bf16(p.in[0] + (size_t)m * DM, xn + (size_t)m * DM, (float*)(ws + WS_RINV) + m, lane);
    for (int m = NREAL + gw; m < RPAD; m += NGW) {
        if (m < NTOK) norm_row_to_bf16(p.in[1] + (size_t)((m - NREAL) & 15) * DM, xn + (size_t)m * DM, (float*)(ws + WS_RINV) + m, lane);
        else { u32x4* o = (u32x4*)(xn + (size_t)m * DM) + lane;
#pragma unroll
            for (int j = 0; j < 4; ++j) o[64 * j] = (u32x4){0u, 0u, 0u, 0u}; }
    }
}

__device__ __forceinline__ float sigmoidf_(float x) { return __builtin_amdgcn_rcpf(1.0f + __builtin_amdgcn_exp2f(-LOG2E * x)); }
__device__ __forceinline__ float gelu_tanh(float x) { const float z = 0.7978845608028654f * (x + 0.044715f * x * x * x); return x * sigmoidf_(2.0f * z); }
__device__ __forceinline__ float one_minus_exp(float x) {
    const float ser = -x * (1.0f + x * (0.5f + x * (0.16666667f + x * (0.041666668f + x * 0.0083333338f))));
    const float dir = 1.0f - __builtin_amdgcn_exp2f(LOG2E * x);
    return x > -0.25f ? ser : dir;
}
constexpr int LRU_XCB = 0;
constexpr int LRU_AS = 17408;
constexpr int LRU_BS = LRU_AS + 32768;
constexpr int LRU_XC = LRU_BS + 32768;
constexpr int LRU_SEG = LRU_XC + 32768;
template <int PASS>
__device__ __forceinline__ void lru_unit(Frame& F, const Params& p, int l, int unit) {
    const int b = unit >> 7, g = (unit >> 4) & 7, st = unit & 15;
    PHASE_IDS(); const int hi = lane >> 5, r32 = lane & 31;
    const bf16_t* proj = (const bf16_t*)(F.ws + WS_PROJ);
    bf16_t* mix = (bf16_t*)(F.ws + WS_MIX);
    float* lsum = (float*)(F.ws + WS_LRUSUM);
    LAS unsigned char* L = F.lds;
    const int cc = tid & 63, rg = wid;
    const float* pbl = (const float*)(F.ws + WS_PB) + l * PBL;
    const float* cw = pbl + PB_CW + g * 128 + 2 * cc; const float* cbp = pbl + PB_CB + g * 128 + 2 * cc;
    const f32x2 w0 = *(const f32x2*)(cw), w1 = *(const f32x2*)(cw + LRUW), w2 = *(const f32x2*)(cw + 2 * LRUW), w3 = *(const f32x2*)(cw + 3 * LRUW), cb = *(const f32x2*)cbp;
    const int tm = wid >> 2, tn = wid & 3; const int chl = tn * 32 + r32, chg = g * 128 + chl;
    const bf16_t* wat = (const bf16_t*)(F.ws + WS_WGATES) + (size_t)((l * 2 + 0) * 8 + g) * 128 * 128 + (size_t)chl * 128 + 8 * hi;
    const bf16_t* wxt = (const bf16_t*)(F.ws + WS_WGATES) + (size_t)((l * 2 + 1) * 8 + g) * 128 * 128 + (size_t)chl * 128 + 8 * hi;
    bf16x8 waf[8], wxf[8];
#pragma unroll
    for (int s = 0; s < 8; ++s) { waf[s] = *(const bf16x8*)(wat + 16 * s); wxf[s] = *(const bf16x8*)(wxt + 16 * s); }
    const float ba = pbl[PB_BA + chg], bx = pbl[PB_BX + chg];
    const float sp8 = pbl[PB_SP8 + chg];
    const int sc = tid & 127, sg = tid >> 7; const int scg = g * 128 + sc;
    float hstate = 0.f, pstate = 1.f;
    if (PASS == 2) {
#pragma unroll 1
        for (int s0 = 0; s0 < st; s0 += 8) { f32x2 ph[8];
#pragma unroll
            for (int j = 0; j < 8; ++j) ph[j] = *(const f32x2*)(lsum + ((size_t)(b * 16 + (s0 + j < st ? s0 + j : 0)) * LRUW + scg) * 2);
#pragma unroll
            for (int j = 0; j < 8; ++j) asm volatile("" : "+v"(ph[j]));
#pragma unroll
            for (int j = 0; j < 8; ++j) if (s0 + j < st) hstate = ph[j].x * hstate + ph[j].y; } }
    const int ntile = st == 0 ? 17 : 16;
    auto tile_pos0 = [&](int i) { return st == 0 ? (i == 0 ? 0 : NMETA + 64 * (i - 1)) : NMETA + 1024 * st + 64 * i; };
    auto load_u = [&](unsigned (&uu)[11], int i) {
        const int pos0 = tile_pos0(i), nv = (st == 0 && i == 0) ? 16 : 64;
#pragma unroll
        for (int k = 0; k < 11; ++k) { const int pos = pos0 + 8 * rg + k - 3;
            uu[k] = *(const unsigned*)(proj + (size_t)tok_row(b, pos < 0 ? 0 : pos) * NPROJ + OFF_U + g * 128 + 2 * cc); }
#pragma unroll
        for (int k = 0; k < 11; ++k) asm volatile("" : "+v"(uu[k]));
#pragma unroll
        for (int k = 0; k < 11; ++k) { const int rr = 8 * rg + k - 3; if (!(pos0 + rr >= 0 && rr < nv)) uu[k] = 0u; }
    };
    unsigned ucur[11]; load_u(ucur, 0);
#define LT(k) do { } while (0)
    for (int i = 0; i < ntile; ++i) {
        LT(0);
        const int pos0 = tile_pos0(i), nvalid = (st == 0 && i == 0) ? 16 : 64;
        unsigned short ygv[16];
        if (PASS == 2) {
#pragma unroll
            for (int k = 0; k < 16; ++k) { const int tt = 16 * sg + k; ygv[k] = proj[(size_t)tok_row(b, pos0 + tt) * NPROJ + OFF_YG + scg]; }
        }
        {
            float ux[11], uy[11];
#pragma unroll
            for (int k = 0; k < 11; ++k) { ux[k] = bf_lo(ucur[k]); uy[k] = bf_hi(ucur[k]); }
#pragma unroll
            for (int k = 0; k < 8; ++k) { const int rr = 8 * rg + k;
                const float xa = cb.x + w0.x * ux[k + 3] + w1.x * ux[k + 2] + w2.x * ux[k + 1] + w3.x * ux[k];
                const float xb = cb.y + w0.y * uy[k + 3] + w1.y * uy[k + 2] + w2.y * uy[k + 1] + w3.y * uy[k];
                *(LAS unsigned*)(L + LRU_XCB + rr * 272 + 4 * cc) = cvt_pk_bf16(xa, xb);
                *(LAS f32x2*)(L + LRU_XC + rr * 512 + 8 * cc) = (f32x2){xa, xb}; }
        }
        if (i + 1 < ntile) load_u(ucur, i + 1);
        LDS_BARRIER(); LT(1);
        {
            f32x16 aa = {}, ax = {};
#pragma unroll
            for (int s = 0; s < 8; ++s) { const bf16x8 af = *(const LAS bf16x8*)(L + LRU_XCB + (32 * tm + r32) * 272 + 32 * s + 16 * hi);
                aa = __builtin_amdgcn_mfma_f32_32x32x16_bf16(af, waf[s], aa, 0, 0, 0); ax = __builtin_amdgcn_mfma_f32_32x32x16_bf16(af, wxf[s], ax, 0, 0, 0); }
#pragma unroll
            for (int r = 0; r < 16; ++r) { const int tt = 32 * tm + crow(r, hi);
                const float ra = sigmoidf_(aa[r] + ba), ix = sigmoidf_(ax[r] + bx);
                const float xcv = *(const LAS float*)(L + LRU_XC + tt * 512 + 4 * chl);
                const float la = sp8 * ra; float a = __builtin_amdgcn_exp2f(LOG2E * la);
                float bb = __builtin_amdgcn_sqrtf(1.0f - __builtin_amdgcn_exp2f((2.0f * LOG2E) * la)) * (ix * xcv);
                if (nvalid < 64 && tt >= nvalid) { a = 1.f; bb = 0.f; }
                *(LAS float*)(L + LRU_AS + tt * 512 + 4 * chl) = a; *(LAS float*)(L + LRU_BS + tt * 512 + 4 * chl) = bb; }
        }
        LDS_BARRIER(); LT(2);
        float H = 0.f, P = 1.f;
#pragma unroll
        for (int k = 0; k < 16; ++k) { const int tt = 16 * sg + k; const float a = *(const LAS float*)(L + LRU_AS + tt * 512 + 4 * sc), bb = *(const LAS float*)(L + LRU_BS + tt * 512 + 4 * sc);
            H = a * H + bb; P *= a; }
        *(LAS f32x2*)(L + LRU_SEG + (sg * 128 + sc) * 8) = (f32x2){P, H};
        LDS_BARRIER(); LT(3);
        float cin = hstate;
#pragma unroll
        for (int s2 = 0; s2 < 4; ++s2) { const f32x2 ph = *(const LAS f32x2*)(L + LRU_SEG + (s2 * 128 + sc) * 8);
            if (s2 < sg) cin = ph.x * cin + ph.y;
            hstate = ph.x * hstate + ph.y; pstate *= ph.x; }
        if (PASS == 2) {
#pragma unroll
            for (int k = 0; k < 16; ++k) { const int tt = 16 * sg + k;
                const float a = *(const LAS float*)(L + LRU_AS + tt * 512 + 4 * sc), bb = *(const LAS float*)(L + LRU_BS + tt * 512 + 4 * sc);
                cin = a * cin + bb;
                if (tt < nvalid) { const float hv = cin; const float y = __uint_as_float((unsigned)ygv[k] << 16);
                    const float o = hv * gelu_tanh(y); mix[(size_t)tok_row(b, pos0 + tt) * DM + scg] = (bf16_t)(cvt_pk_bf16(o, 0.f) & 0xffffu); } }
        }
    }
#undef LT
    if (PASS == 1 && sg == 0) *(f32x2*)(lsum + ((size_t)(b * 16 + st) * LRUW + scg) * 2) = (f32x2){pstate, hstate};
    __syncthreads();
}


__device__ __forceinline__ void kmax_phase(Frame& F, int l) {
    PHASE_IDS();
    const bf16_t* proj = (const bf16_t*)(F.ws + WS_PROJ);
    const int gw = F.bid * 8 + wid, NGW = F.G * 8;
    for (int b = 0; b < BATCH; ++b) {
        float mx = 0.f;
        for (int i0 = gw; i0 < TLEN; i0 += 4 * NGW) {
            u32x4 a[4], c[4];
#pragma unroll
            for (int u = 0; u < 4; ++u) { const int i = min(i0 + u * NGW, TLEN - 1); const u32x4* kp = (const u32x4*)(proj + (size_t)tok_row(b, i) * NPROJ + OFF_K + lane * 16); a[u] = kp[0]; c[u] = kp[1]; }
#pragma unroll
            for (int u = 0; u < 4; ++u) { float s = 0.f;
#pragma unroll
                for (int j = 0; j < 4; ++j) { const unsigned x = a[u][j], y = c[u][j]; s += bf_lo(x) * bf_lo(x) + bf_hi(x) * bf_hi(x) + bf_lo(y) * bf_lo(y) + bf_hi(y) * bf_hi(y); }
                s += shx1(s); s += shx2(s);
                mx = fmaxf(mx, s); }
        }
        if ((lane & 3) == 0) atomicMax(F.ctl + CW_KMAX + l * 64 + b * 16 + (lane >> 2), __float_as_uint(mx));
    }
}
constexpr int AT_KSTR = 144, AT_VSTR = 320;
constexpr float ATT_THRESH = 24.0f;
constexpr int AD_K1 = 0, AD_K2 = 8192, AD_V = 16384, AD_SUB = 32768, AD_STAGE = 65536;
constexpr int AT_EX = 0, AT_OS = 65536, AT_OSTR = 272;
static_assert(2 * AD_STAGE <= RING_BYTES && AT_OS + 128 * AT_OSTR <= RING_BYTES, "attention LDS");
__device__ __forceinline__ s16x4 ds_tr16(const LAS unsigned char* p) { typedef short v4i16_t __attribute__((ext_vector_type(4))); return __builtin_bit_cast(s16x4, __builtin_amdgcn_ds_read_tr16_b64_v4i16((LAS v4i16_t*)p)); }

__device__ __forceinline__ void attn_unit(Frame& F, const Params& p, int l, int b, int h, int qb) {
    PHASE_IDS(); const int hi = lane >> 5, r32 = lane & 31, map = wid >> 2, qs = wid & 3;
    const bf16_t* proj = (const bf16_t*)(F.ws + WS_PROJ);
    bf16_t* mix = (bf16_t*)(F.ws + WS_MIX);
    LAS unsigned char* L = F.lds;
    const float slope2 = exp2f(-(float)(h + 1)) * LOG2E;
    const int qi = qs * 32 + r32;
    int qrow, qpos; if (qb >= 0) { qrow = b * SEQ + 128 * qb + qi; qpos = NMETA + 128 * qb + qi; } else { qrow = NREAL + b * NMETA + (qi & 15); qpos = qi & 15; }
    bf16x8 qf[4];
#pragma unroll
    for (int s = 0; s < 4; ++s) qf[s] = *(const bf16x8*)(proj + (size_t)qrow * NPROJ + OFF_Q + h * 128 + map * 64 + 16 * s + 8 * hi);
    const int nreal = qb >= 0 ? 2 * qb + 2 : 0, ntile = nreal + 1;
    float qbound;
    { float s = 0.f;
#pragma unroll
      for (int ss = 0; ss < 4; ++ss)
#pragma unroll
          for (int j = 0; j < 8; ++j) { const float v = __uint_as_float(((unsigned)(unsigned short)qf[ss][j]) << 16); s += v * v; }
      s = sum32(s);
      const float kmx = __uint_as_float(xb_ld(F.ctl + CW_KMAX + l * 64 + b * 16 + h * 2 + map));
      qbound = sqrtf(s * kmx) * 1.0001f + 1e-3f; }
    volatile LAS unsigned* DW = F.LC + 112;
    if (lane == 0) DW[wid] = 0x7fffffffu;
    bool wdone = false;
    const int dk_row = 8 * wid + (lane >> 3), dk_ch = (lane & 7) ^ ((dk_row >> 1) & 7);
    const int dv_row0 = 4 * wid + (lane >> 4), dv_ch = (lane & 15) ^ (4 * (dv_row0 & 3));
    auto dma_tile = [&](int kt, int boff) {
        const int r0 = kt >= 0 ? b * SEQ + 64 * kt : NREAL + b * NMETA;
        const bf16_t* rk = proj + (size_t)(kt >= 0 ? r0 + dk_row : r0 + (dk_row & 15)) * NPROJ + OFF_K + h * 128 + dk_ch * 8;
        const bf16_t* rv0 = proj + (size_t)(kt >= 0 ? r0 + dv_row0 : r0 + (dv_row0 & 15)) * NPROJ + OFF_V + h * 128 + dv_ch * 8;
        const bf16_t* rv1 = proj + (size_t)(kt >= 0 ? r0 + dv_row0 + 32 : r0 + (dv_row0 & 15)) * NPROJ + OFF_V + h * 128 + dv_ch * 8;
        LAS unsigned char* Bd = L + boff;
        __builtin_amdgcn_global_load_lds((const unsigned*)rk, (LAS unsigned*)(Bd + AD_K1 + wid * 1024), 16, 0, 0);
        __builtin_amdgcn_global_load_lds((const unsigned*)(rk + 64), (LAS unsigned*)(Bd + AD_K2 + wid * 1024), 16, 0, 0);
        __builtin_amdgcn_global_load_lds((const unsigned*)rv0, (LAS unsigned*)(Bd + AD_V + wid * 1024), 16, 0, 0);
        __builtin_amdgcn_global_load_lds((const unsigned*)rv1, (LAS unsigned*)(Bd + AD_V + 8192 + wid * 1024), 16, 0, 0);
    };
    const int npair = qb >= 0 ? qb + 1 : 0, niter = npair + 1;
    auto dma_iter = [&](int it, int stage) { if (it < npair) { dma_tile(2 * (npair - 1 - it) + 1, stage); dma_tile(2 * (npair - 1 - it), stage + AD_SUB); } else dma_tile(-1, stage); };
    float m_run = -1e30f, l_run = 0.f;
    float m_true = -1e30f;
    f32x16 O[4]; O[0] = f32x16{}; O[1] = f32x16{}; O[2] = f32x16{}; O[3] = f32x16{};
    f32x16 CB;
#pragma unroll
    for (int r = 0; r < 16; ++r) CB[r] = slope2 * (float)((r & 3) + 8 * (r >> 2));
    const f32x16 Z16 = {};
    const int vq = (lane & 15) >> 2, vp = lane & 3, vblk = (lane >> 4) & 1;
    const int vrow_off = (4 * hi + vq) * 256 + 32 * vblk + 8 * vp;
    const int kswz = (r32 >> 1) & 7;
    const int diag_kt = 2 * qb + (qs >> 1);
    bf16x8 pk[4];
#define AT_VRD2(dst, g_) do { _Pragma("unroll") for (int j_ = 0; j_ < 2; ++j_) { const int c_ = 2 * ((g_) & 1) + j_; \
            const s16x4 t0_ = ds_tr16(Vb_ + (16 * ((g_) >> 1)) * 256 + 64 * (c_ ^ vq)), t1_ = ds_tr16(Vb_ + (16 * ((g_) >> 1) + 8) * 256 + 64 * (c_ ^ vq)); \
            dst[j_] = (bf16x8){t0_[0], t0_[1], t0_[2], t0_[3], t1_[0], t1_[1], t1_[2], t1_[3]}; } } while (0)
#define AT_VMM(src, g_) do { O[2 * ((g_) & 1)] = __builtin_amdgcn_mfma_f32_32x32x16_bf16(src[0], pk[(g_) >> 1], O[2 * ((g_) & 1)], 0, 0, 0); \
            O[2 * ((g_) & 1) + 1] = __builtin_amdgcn_mfma_f32_32x32x16_bf16(src[1], pk[(g_) >> 1], O[2 * ((g_) & 1) + 1], 0, 0, 0); __builtin_amdgcn_sched_barrier(0); } while (0)
#define AT_WAIT_BAR() do { asm volatile("s_waitcnt vmcnt(0) lgkmcnt(0)" ::: "memory"); __builtin_amdgcn_s_barrier(); asm volatile("" ::: "memory"); } while (0)
    auto tile = [&](int kt, int boff) {
        const bool is_meta = kt < 0;
        const bool vis = (is_meta || (kt <= diag_kt)) && !wdone;
        if (vis) {
            const bool general = is_meta || (kt == diag_kt);
            f32x16 S0 = general ? Z16 : CB, S1 = S0;
            { const LAS unsigned char* Kb = L + boff + (map ? AD_K2 : AD_K1) + r32 * 128; bf16x8 ka[2], kb[2];
#define AT_KRD(dst, s_) do { dst[0] = *(const LAS bf16x8*)(Kb + 16 * ((2 * (s_) + hi) ^ kswz)); dst[1] = *(const LAS bf16x8*)(Kb + 32 * 128 + 16 * ((2 * (s_) + hi) ^ kswz)); } while (0)
#define AT_KMM(src, s_) do { S0 = __builtin_amdgcn_mfma_f32_32x32x16_bf16(src[0], qf[s_], S0, 0, 0, 0); S1 = __builtin_amdgcn_mfma_f32_32x32x16_bf16(src[1], qf[s_], S1, 0, 0, 0); __builtin_amdgcn_sched_barrier(0); } while (0)
              AT_KRD(ka, 0); AT_KRD(kb, 1); __builtin_amdgcn_sched_barrier(0);
              AT_KMM(ka, 0); AT_KRD(ka, 2); __builtin_amdgcn_sched_barrier(0);
              AT_KMM(kb, 1); AT_KRD(kb, 3); __builtin_amdgcn_sched_barrier(0);
              AT_KMM(ka, 2); AT_KMM(kb, 3);
#undef AT_KRD
#undef AT_KMM
            }
            float c0, c1;
            if (general) {
                const float kpos0 = is_meta ? 0.f : (float)(NMETA + 64 * kt);
                const float dq = (float)qpos - kpos0 - (float)(4 * hi);
#pragma unroll
                for (int r = 0; r < 16; ++r) { const float kc = (float)((r & 3) + 8 * (r >> 2));
                    S0[r] = S0[r] - slope2 * fabsf(dq - kc); S1[r] = S1[r] - slope2 * fabsf(dq - kc - 32.f);
                    if (is_meta) { if (r >= 8) S0[r] = -1e30f; S1[r] = -1e30f; } }
                c0 = 0.f; c1 = 0.f;
            } else {
                c0 = slope2 * (float)(NMETA + 64 * kt + 4 * hi - qpos); c1 = c0 + 32.f * slope2;
            }
            bool skip = false;
            { float mA, mB;
              asm("v_max3_f32 %0, %1, %2, %3" : "=v"(mA) : "v"(S0[0]), "v"(S0[1]), "v"(S0[2])); asm("v_max3_f32 %0, %1, %2, %3" : "=v"(mB) : "v"(S1[0]), "v"(S1[1]), "v"(S1[2]));
#pragma unroll
              for (int r = 3; r < 15; r += 2) { asm("v_max3_f32 %0, %1, %2, %3" : "=v"(mA) : "v"(mA), "v"(S0[r]), "v"(S0[r + 1])); asm("v_max3_f32 %0, %1, %2, %3" : "=v"(mB) : "v"(mB), "v"(S1[r]), "v"(S1[r + 1])); }
              mA = fmaxf(mA, S0[15]); mB = fmaxf(mB, S1[15]);
              float mt = fmaxf(mA + c0, mB + c1);
              if (!general && __all(mt < m_true - ATT_THRESH)) skip = true;
              else {
                mt = max32(mt); m_true = fmaxf(m_true, mt);
                if (__any(mt > m_run + 8.0f)) {
                    const float m_new = fmaxf(m_run, mt);
                    const float alpha = __builtin_amdgcn_exp2f(m_run - m_new);
                    m_run = m_new; l_run *= alpha;
#pragma unroll
                    for (int c = 0; c < 4; ++c) O[c] *= alpha;
                }
              } }
            if (!skip) {
            const float e0 = c0 - m_run, e1 = c1 - m_run;
            float ps0 = 0.f, ps1 = 0.f;
            S0 = S0 + e0; S1 = S1 + e1;
#pragma unroll
            for (int r = 0; r < 16; ++r) { S0[r] = __builtin_amdgcn_exp2f(S0[r]); S1[r] = __builtin_amdgcn_exp2f(S1[r]); ps0 += S0[r]; ps1 += S1[r]; }
            l_run += ps0 + ps1;
#pragma unroll
            for (int s2 = 0; s2 < 2; ++s2) {
                u32x4 w0, w1;
                w0.x = cvt_pk_bf16(S0[8 * s2 + 0], S0[8 * s2 + 1]); w0.y = cvt_pk_bf16(S0[8 * s2 + 2], S0[8 * s2 + 3]); w0.z = cvt_pk_bf16(S0[8 * s2 + 4], S0[8 * s2 + 5]); w0.w = cvt_pk_bf16(S0[8 * s2 + 6], S0[8 * s2 + 7]);
                w1.x = cvt_pk_bf16(S1[8 * s2 + 0], S1[8 * s2 + 1]); w1.y = cvt_pk_bf16(S1[8 * s2 + 2], S1[8 * s2 + 3]); w1.z = cvt_pk_bf16(S1[8 * s2 + 4], S1[8 * s2 + 5]); w1.w = cvt_pk_bf16(S1[8 * s2 + 6], S1[8 * s2 + 7]);
                pk[s2] = __builtin_bit_cast(bf16x8, w0); pk[2 + s2] = __builtin_bit_cast(bf16x8, w1);
            }
            __builtin_amdgcn_sched_barrier(0);
            { const LAS unsigned char* Vb_ = L + boff + AD_V + vrow_off; bf16x8 va_[2], vb_[2], vc_[2];
              AT_VRD2(va_, 0); AT_VRD2(vb_, 1); __builtin_amdgcn_sched_barrier(0);
              AT_VRD2(vc_, 2); __builtin_amdgcn_sched_barrier(0); AT_VMM(va_, 0);
              AT_VRD2(va_, 3); __builtin_amdgcn_sched_barrier(0); AT_VMM(vb_, 1);
              AT_VRD2(vb_, 4); __builtin_amdgcn_sched_barrier(0); AT_VMM(vc_, 2);
              AT_VRD2(vc_, 5); __builtin_amdgcn_sched_barrier(0); AT_VMM(va_, 3);
              AT_VRD2(va_, 6); __builtin_amdgcn_sched_barrier(0); AT_VMM(vb_, 4);
              AT_VRD2(vb_, 7); __builtin_amdgcn_sched_barrier(0); AT_VMM(vc_, 5);
              AT_VMM(va_, 6); AT_VMM(vb_, 7); }
            }
        }
        if (!wdone && !is_meta) {
            const float dmin = (float)(qpos - (NMETA + 64 * kt) + 1);
            const bool c = qbound - slope2 * dmin < m_true - ATT_THRESH;
            if (__all(c)) wdone = true;
        }
    };
    asm volatile("s_waitcnt vmcnt(0)" ::: "memory");
    dma_iter(0, 0);
    AT_WAIT_BAR();
    int stage = 0;
    for (int it = 0; it < niter; ++it) {
        if (it + 1 < niter) dma_iter(it + 1, stage ^ AD_STAGE);
        { const int nsub = it < npair ? 2 : 1, kt0 = it < npair ? 2 * (npair - 1 - it) + 1 : -1;
#pragma unroll 1
          for (int sub = 0; sub < nsub; ++sub) { tile(kt0 - sub, stage + sub * AD_SUB); __builtin_amdgcn_sched_barrier(0); } }
        if (wdone && lane == 0 && DW[wid] == 0x7fffffffu) DW[wid] = (unsigned)it;
        stage ^= AD_STAGE;
        AT_WAIT_BAR();
        { const u32x4 d0 = *(const LAS u32x4*)(F.lds + LCTL_OFF + 112 * 4), d1 = *(const LAS u32x4*)(F.lds + LCTL_OFF + 116 * 4);
          const unsigned dm = max(max(max(d0.x, d0.y), max(d0.z, d0.w)), max(max(d1.x, d1.y), max(d1.z, d1.w)));
          if (dm <= (unsigned)it) break; }
    }
#undef AT_VRD2
#undef AT_VMM
#undef AT_WAIT_BAR
    __syncthreads();
    const float lt = sum32(l_run);
    const float inv = 1.0f / lt;
    if (map == 1) {
#pragma unroll
        for (int c = 0; c < 4; ++c)
#pragma unroll
            for (int r = 0; r < 16; ++r) *(LAS float*)(L + AT_EX + ((32 * c + crow(r, hi)) * 128 + qi) * 4) = O[c][r] * inv;
    }
    __syncthreads();
    if (map == 0) {
        const float* pbl = (const float*)(F.ws + WS_PB) + l * PBL;
        const float lam = pbl[PB_LAM], lam_init = pbl[PB_LAM + 1];
        float ss = 0.f;
#pragma unroll
        for (int c = 0; c < 4; ++c)
#pragma unroll
            for (int r = 0; r < 16; ++r) { const float o2 = *(const LAS float*)(L + AT_EX + ((32 * c + crow(r, hi)) * 128 + qi) * 4); const float o = O[c][r] * inv - lam * o2; O[c][r] = o; ss += o * o; }
        ss = sum32(ss);
        const float rn = (1.0f / sqrtf(ss * (1.f / 128.f) + RMS_EPS)) * (1.0f - lam_init);
#pragma unroll
        for (int c = 0; c < 4; ++c)
#pragma unroll
            for (int r = 0; r < 16; r += 2) { const int dv = 32 * c + crow(r, hi);
                const float g0 = pbl[PB_SUBG + dv], g1 = pbl[PB_SUBG + dv + 1];
                *(LAS unsigned*)(L + AT_OS + qi * AT_OSTR + dv * 2) = cvt_pk_bf16(O[c][r] * rn * g0, O[c][r + 1] * rn * g1); }
    }
    __syncthreads();
#pragma unroll
    for (int i = 0; i < 4; ++i) { const int idx = tid + 512 * i, row = idx >> 4, ch = idx & 15;
        const bool ok = qb >= 0 || row < 16;
        if (ok) { const int orow = qb >= 0 ? b * SEQ + 128 * qb + row : NREAL + b * NMETA + row;
            *(u32x4*)(mix + (size_t)orow * DM + LRUW + h * 128 + ch * 8) = *(const LAS u32x4*)(L + AT_OS + row * AT_OSTR + ch * 16); } }
    __syncthreads();
}


constexpr int NT32 = (NTOK + 31) / 32;
constexpr int RT_PART = 0;
constexpr int RT_SSQ = 2 * 4 * 32 * 33 * 4;
__device__ __forceinline__ void router_phase(Frame& F, const Params& p, int l) {
    const bool count = true;
    PHASE_IDS(); const int hi = lane >> 5, r32 = lane & 31;
    const int ntile_b = F.bid < NT32 ? (NT32 - F.bid + F.G - 1) / F.G : 0;
    volatile LAS unsigned* hist = F.LC + 16;
    if (tid < 16) hist[tid] = 0u;
    __syncthreads();
    const bf16_t* wrh = (const bf16_t*)(F.ws + WS_WR) + (size_t)(l * 2) * 32 * DM; const bf16_t* wrl = wrh + (size_t)32 * DM;
    const bf16_t* hbp = (const bf16_t*)(F.ws + WS_XN);
    const float* rgb = (const float*)(F.ws + WS_PB) + l * PBL + PB_RGB; const float* reb = (const float*)(F.ws + WS_PB) + l * PBL + PB_REB;
    u32x4* tokinfo = (u32x4*)(F.ws + WS_TOKINFO);
    LAS float* part = (LAS float*)(F.lds + RT_PART); LAS float* ssqp = (LAS float*)(F.lds + RT_SSQ);
    for (int k0 = 0; k0 < ntile_b; k0 += 4) {
        const bool lone = (ntile_b - k0 == 1);
        const int ts = lone ? 0 : (wid & 3), ksl = lone ? wid : (wid >> 2), klen = lone ? 256 : 1024;
        if (k0 + ts < ntile_b) {
            int row = 32 * (F.bid + F.G * (k0 + ts)) + r32; row = row < NTOK ? row : NTOK - 1;
            const bf16_t* hp = hbp + (size_t)row * DM + ksl * klen + 8 * hi;
            const bf16_t* wph = wrh + (size_t)r32 * DM + ksl * klen + 8 * hi; const bf16_t* wpl = wrl + (size_t)r32 * DM + ksl * klen + 8 * hi;
            f32x16 acc = {}; float ssq = 0.f;
#pragma unroll 1
            for (int c0 = 0; c0 < klen / 16; c0 += 8) {
                bf16x8 av[8], wh[8], wl[8];
#pragma unroll
                for (int u = 0; u < 8; ++u) { av[u] = *(const bf16x8*)(hp + 16 * (c0 + u)); wh[u] = *(const bf16x8*)(wph + 16 * (c0 + u)); wl[u] = *(const bf16x8*)(wpl + 16 * (c0 + u)); }
                __builtin_amdgcn_sched_barrier(0);
#pragma unroll
                for (int u = 0; u < 8; ++u) {
#pragma unroll
                    for (int j = 0; j < 8; ++j) { const float v = __uint_as_float(((unsigned)(unsigned short)av[u][j]) << 16); ssq += v * v; }
                    acc = __builtin_amdgcn_mfma_f32_32x32x16_bf16(av[u], wh[u], acc, 0, 0, 0); acc = __builtin_amdgcn_mfma_f32_32x32x16_bf16(av[u], wl[u], acc, 0, 0, 0); }
                __builtin_amdgcn_sched_barrier(0);
            }
            ssq = sum32(ssq);
#pragma unroll
            for (int r = 0; r < 16; ++r) part[(wid * 32 + crow(r, hi)) * 33 + r32] = acc[r];
            if (hi == 0) ssqp[wid * 32 + r32] = ssq;
        }
        __syncthreads();
        if (tid < 128) {
            const int ts2 = tid >> 5, i = tid & 31; const int row = 32 * (F.bid + F.G * (k0 + ts2)) + i;
            if (k0 + ts2 < ntile_b && row < NTOK && !(lone && ts2 > 0)) {
                const int nsl = lone ? 8 : 2, sst = lone ? 1 : 4;
                float sq = 0.f; for (int sl = 0; sl < nsl; ++sl) sq += ssqp[(ts2 + sst * sl) * 32 + i];
                const float rstd = 1.0f / sqrtf(sq * (1.f / DM) + RMS_EPS);
                float lg[20];
#pragma unroll
                for (int o = 0; o < 20; ++o) { float a = 0.f; for (int sl = 0; sl < nsl; ++sl) a += part[((ts2 + sst * sl) * 32 + i) * 33 + o]; lg[o] = a * rstd + (o < 4 ? rgb[o] : reb[o - 4]); }
                int gi = 0; float gm = lg[0];
#pragma unroll
                for (int o = 1; o < 4; ++o) if (lg[o] > gm) { gm = lg[o]; gi = o; }
                float gs = 0.f;
#pragma unroll
                for (int o = 0; o < 4; ++o) gs += __expf(lg[o] - gm);
                const float gprob = 1.0f / gs;
                float li[4];
#pragma unroll
                for (int j = 0; j < 4; ++j) li[j] = gi == 0 ? lg[4 + j] : gi == 1 ? lg[8 + j] : gi == 2 ? lg[12 + j] : lg[16 + j];
                int i1 = 0; float v1 = li[0];
#pragma unroll
                for (int j = 1; j < 4; ++j) if (li[j] > v1) { v1 = li[j]; i1 = j; }
                int i2 = -1; float v2 = -3.0e38f;
#pragma unroll
                for (int j = 0; j < 4; ++j) if (j != i1 && li[j] > v2) { v2 = li[j]; i2 = j; }
                const float e2 = __expf(v2 - v1); const float p1 = 1.0f / (1.0f + e2), p2 = e2 / (1.0f + e2);
                const int ea = gi * 4 + i1, eb = gi * 4 + i2;
                u32x4 ti; ti.x = (unsigned)ea | ((unsigned)eb << 8); ti.y = __float_as_uint(p1 * gprob); ti.z = __float_as_uint(p2 * gprob); ti.w = __float_as_uint(rstd);
                tokinfo[row] = ti;
                if (count) { lds_add((LAS unsigned*)&hist[ea], 1u); lds_add((LAS unsigned*)&hist[eb], 1u); }
            }
        }
        __syncthreads();
    }
    if (tid < 16 && count) { const unsigned hc = hist[tid]; ((unsigned*)(F.ws + WS_HIST))[F.bid * 16 + tid] = hc; if (hc) atomicAdd(F.ctl + CW_CNT + l * 16 + tid, hc); }
    __syncthreads();
}

__device__ __forceinline__ void moe_tables(Frame& F, int l) {
    const int tz = (F.wid << 6) | lane_now();
    if (tz < 64) {
        const int ln = tz & 63; const int c = ln < 16 ? (int)xb_ld(F.ctl + CW_CNT + l * 16 + ln) : 0; const int np = (c + 255) >> 8;
        int inc = np;
#pragma unroll
        for (int o = 1; o < 16; o <<= 1) { const int t = __builtin_amdgcn_ds_bpermute((ln - o) << 2, inc); if (ln >= o) inc += t; }
        if (ln < 16) { F.LC[32 + ln] = (unsigned)(inc - np); F.LC[64 + ln] = (unsigned)((inc - np) * 256); }
        if (ln == 15) { F.LC[48] = (unsigned)inc; F.LC[80] = (unsigned)(inc * 256); } }
    __syncthreads();
}

__device__ __forceinline__ void slots_phase(Frame& F, const Params& p, int l) {
    PHASE_IDS();
    const int ntile_b = F.bid < NT32 ? (NT32 - F.bid + F.G - 1) / F.G : 0;
    moe_tables(F, l);
    volatile LAS unsigned* boff = F.LC + 96;
    if (tid < 16) boff[tid] = 0u;
    __syncthreads();
    { const unsigned* hg = (const unsigned*)(F.ws + WS_HIST); const int e = tid & 15; unsigned sacc = 0;
#pragma unroll 8
      for (int bb = tid >> 4; bb < F.bid; bb += 32) sacc += hg[bb * 16 + e];
      if (sacc) lds_add((LAS unsigned*)&boff[e], sacc); }
    __syncthreads();
    const u32x4* tokinfo = (const u32x4*)(F.ws + WS_TOKINFO);
    u32x2* tokslot = (u32x2*)(F.ws + WS_TOKSLOT);
    int* tokmap = (int*)(F.ws + WS_TOKMAP); float* rslot = (float*)(F.ws + WS_RSLOT);
    if (wid == 0) {
        volatile LAS unsigned* run = F.LC + 128;
        if (lane < 16) run[lane] = F.LC[64 + lane] + boff[lane];
        for (int k0 = 0; k0 < ntile_b; k0 += 2) {
            const int kk = k0 + (lane >> 5); const int row = 32 * (F.bid + F.G * kk) + (lane & 31); const bool ok = kk < ntile_b && row < NTOK;
            u32x4 ti = (u32x4){0xffffu, 0u, 0u, 0u}; if (ok) ti = tokinfo[row];
            const unsigned ea = ti.x & 0xffu, eb = (ti.x >> 8) & 0xffu;
            unsigned sa = 0, sb2 = 0;
#pragma unroll 1
            for (int e = 0; e < 16; ++e) {
                const bool hit = ok && (ea == (unsigned)e || eb == (unsigned)e);
                const unsigned long long mk = __ballot(hit);
                const unsigned rank = __popcll(mk & ((1ull << lane) - 1ull));
                const unsigned cur = run[e];
                if (ea == (unsigned)e) sa = cur + rank;
                if (eb == (unsigned)e) sb2 = cur + rank;
                if (lane == 0) run[e] = cur + (unsigned)__popcll(mk);
            }
            if (ok) { tokslot[row] = (u32x2){sa, sb2}; tokmap[sa] = row; tokmap[sb2] = row; const float rs = __uint_as_float(ti.w); rslot[sa] = rs; rslot[sb2] = rs; }
        }
    }
    if (F.bid < 16) {
        const int e = F.bid; const int c = (int)xb_ld(F.ctl + CW_CNT + l * 16 + e), base = (int)F.LC[64 + e], pc = ((c + 255) >> 8) << 8;
        for (int i = c + tid; i < pc; i += 512) { tokmap[base + i] = 0; rslot[base + i] = 0.f; }
    }
    __syncthreads();
}

__device__ __forceinline__ void combine_phase(Frame& F, const Params& p, int l) {
    PHASE_IDS(); const int gw = F.bid * 8 + wid, NGW = F.G * 8;
    const u32x4* tokinfo = (const u32x4*)(F.ws + WS_TOKINFO);
    const u32x2* tokslot = (const u32x2*)(F.ws + WS_TOKSLOT);
    const unsigned char* y = (const unsigned char*)(F.ws + WS_PROJ);
    bf16_t* xn = (bf16_t*)(F.ws + WS_XN);
    const bool lastl = (l == DEPTH - 1);
    const int nrows = lastl ? NREAL : NTOK;
    u32x4 ti_n = (u32x4){0u, 0u, 0u, 0u}; u32x2 ts_n = (u32x2){0u, 0u};
    if (gw < nrows) { ti_n = tokinfo[gw]; ts_n = tokslot[gw]; }
    for (int row = gw; row < nrows; row += NGW) {
        const u32x4 ti = ti_n; const u32x2 ts = ts_n;
        { const int nr = row + NGW < nrows ? row + NGW : row; ti_n = tokinfo[nr]; ts_n = tokslot[nr]; }
        asm volatile("" ::: "memory");
        const float wa = __uint_as_float(ti.y) * Y8_INV, wb = __uint_as_float(ti.z) * Y8_INV;
        const u32x4* hb = (const u32x4*)(xn + (size_t)row * DM) + lane;
        const u32x2* ya = (const u32x2*)(y + (size_t)ts.x * DM) + lane; const u32x2* yb = (const u32x2*)(y + (size_t)ts.y * DM) + lane;
        u32x4 hq[4]; u32x2 aq[4], bq[4];
#pragma unroll
        for (int j = 0; j < 4; ++j) { hq[j] = hb[64 * j]; aq[j] = ya[64 * j]; bq[j] = yb[64 * j]; }
        float v[4][8]; float s = 0.f;
#pragma unroll
        for (int j = 0; j < 4; ++j)
#pragma unroll
            for (int w2 = 0; w2 < 2; ++w2) {
                const auto a0 = __builtin_amdgcn_cvt_pk_f32_fp8((int)aq[j][w2], false), a1 = __builtin_amdgcn_cvt_pk_f32_fp8((int)aq[j][w2], true);
                const auto b0 = __builtin_amdgcn_cvt_pk_f32_fp8((int)bq[j][w2], false), b1 = __builtin_amdgcn_cvt_pk_f32_fp8((int)bq[j][w2], true);
                const unsigned h0 = hq[j][2 * w2], h1 = hq[j][2 * w2 + 1];
                const float v0 = bf_lo(h0) + wa * a0[0] + wb * b0[0], v1 = bf_hi(h0) + wa * a0[1] + wb * b0[1], v2 = bf_lo(h1) + wa * a1[0] + wb * b1[0], v3 = bf_hi(h1) + wa * a1[1] + wb * b1[1];
                v[j][4 * w2] = v0; v[j][4 * w2 + 1] = v1; v[j][4 * w2 + 2] = v2; v[j][4 * w2 + 3] = v3; s += (v0 * v0 + v1 * v1) + (v2 * v2 + v3 * v3); }
        const float rms = sqrtf(wave_sum(s) * (1.f / DM) + RMS_EPS), rstd = 1.0f / rms;
        if (!lastl) {
            if (lane == 0) ((float*)(F.ws + WS_RINV))[row] = rms;
            u32x4* o8 = (u32x4*)(xn + (size_t)row * DM) + lane;
#pragma unroll
            for (int j = 0; j < 4; ++j) { u32x4 wn;
#pragma unroll
                for (int e = 0; e < 4; ++e) wn[e] = cvt_pk_bf16(v[j][2 * e] * rstd, v[j][2 * e + 1] * rstd);
                o8[64 * j] = wn; }
        } else {
            const float* gp = (const float*)(F.ws + WS_PB) + PB_FING + lane * 8; float* op = p.out + (size_t)row * DM + lane * 8;
#pragma unroll
            for (int j = 0; j < 4; ++j) { const f32x4 g0 = *(const f32x4*)(gp + 512 * j), g1 = *(const f32x4*)(gp + 512 * j + 4);
                { *(f32x4*)(op + 512 * j) = (f32x4){v[j][0] * rstd * g0.x, v[j][1] * rstd * g0.y, v[j][2] * rstd * g0.z, v[j][3] * rstd * g0.w};
                            *(f32x4*)(op + 512 * j + 4) = (f32x4){v[j][4] * rstd * g1.x, v[j][5] * rstd * g1.y, v[j][6] * rstd * g1.z, v[j][7] * rstd * g1.w}; } }
        }
    }
}

template <class Sink>
__device__ __forceinline__ void meta_gemm_group(LAS unsigned char* lds, int wid, const bf16_t* A, const bf16_t* Bt, int K, const Sink& sink) {
    asm volatile("" : "+s"(wid)); const int lane = lane_now(), tid = (wid << 6) | lane; const int hi = lane >> 5, r32 = lane & 31;
    const int kper = K >> 3;
    const bf16_t* ap = A + (size_t)r32 * K + wid * kper + 8 * hi; const bf16_t* bp = Bt + (size_t)r32 * K + wid * kper + 8 * hi;
    f32x16 acc = {};
#pragma unroll 8
    for (int sidx = 0; sidx < kper / 16; ++sidx) { const bf16x8 a = *(const bf16x8*)(ap + 16 * sidx), bq = *(const bf16x8*)(bp + 16 * sidx); acc = __builtin_amdgcn_mfma_f32_32x32x16_bf16(a, bq, acc, 0, 0, 0); }
    LAS float* part = (LAS float*)lds;
#pragma unroll
    for (int r = 0; r < 16; ++r) part[(wid * 32 + crow(r, hi)) * 33 + r32] = acc[r];
    __syncthreads();
#pragma unroll
    for (int o = 0; o < 2; ++o) { const int e = tid + 512 * o, row = e >> 5, col = e & 31; float v = 0.f;
#pragma unroll
        for (int w = 0; w < 8; ++w) v += part[(w * 32 + row) * 33 + col];
        sink(row, col, v); }
    __syncthreads();
}

constexpr int PH_PER_LAYER = 9, N_PHASES = 1 + DEPTH * PH_PER_LAYER;
__global__ void __launch_bounds__(512, 2) mega_fwd(Params p) {
    extern __shared__ __attribute__((aligned(16))) unsigned char lds_raw[];
    Frame F;
    F.lds = (LAS unsigned char*)lds_raw; F.LC = (volatile LAS unsigned*)(F.lds + LCTL_OFF);
    F.G = gridDim.x; F.bid = blockIdx.x; F.wid = __builtin_amdgcn_readfirstlane(threadIdx.x >> 6);
    F.ws = p.ws; F.ctl = (unsigned*)(p.ws + WS_CTL);
    for (int u = threadIdx.x; u < (LDS_BYTES - LCTL_OFF) / 4; u += 512) F.LC[u] = 0u;
    __syncthreads();
    XcdBarrier bar; bar.bar = F.ctl + CW_BAR; bar.x = 0; bar.st = nullptr; bar.wid = F.wid;
    const int lo = p.ph_lo, hi = p.ph_hi;
    if (hi - lo > 1) { bar = xcd_barrier_post(F.ctl + CW_BAR, F.LC + 8, F.wid); xcd_barrier_census(bar); }
#define IN(k) (lo <= (k) && (k) < hi)
#define REBASE() do { unsigned char* w_ = p.ws; asm volatile("" : "+s"(w_)); F.ws = w_; F.ctl = (unsigned*)(w_ + WS_CTL); } while (0)
#define SEAM(k) do { if (IN(k) && IN((k) + 1)) xcd_barrier(bar); } while (0)
    if (IN(0)) p0_prologue(F, p);
    SEAM(0);
    for (int l = 0; l < DEPTH; ++l) {
        const int pb = 1 + l * PH_PER_LAYER;
        if (IN(pb + 0)) { REBASE();
            { bf16_t* projm = (bf16_t*)(F.ws + WS_PROJ) + (size_t)NREAL * NPROJ;
              for (int g = F.bid; g < NPROJ / 32; g += F.G)
                  meta_gemm_group(F.lds, F.wid, (const bf16_t*)(F.ws + WS_XN) + (size_t)NREAL * DM, (const bf16_t*)(F.ws + WS_WIN) + ((size_t)l * NPROJ + 32 * g) * DM, DM,
                                  [&](int row, int col, float v) { projm[(size_t)row * NPROJ + 32 * g + col] = (bf16_t)(cvt_pk_bf16(v, 0.f) & 0xffffu); }); }
            pg8::DenseOrder S; S.init(F.ws + WS_XN, F.ws + WS_WIN + (size_t)l * NPROJ * DM * 2, NREAL, NPROJ, DM, F.G, F.bid);
            pg8::EpiBf16 E{(bf16_t*)(F.ws + WS_PROJ), NPROJ, 1.0f};
            pg8::gemm_phase<pg8::EpiBf16, pg8::DenseOrder>(F.lds, F.wid, DM, S, E);
        }
        SEAM(pb + 0);
        if (IN(pb + 1)) { REBASE();
            for (int u = F.bid; u < 256; u += F.G) lru_unit<1>(F, p, l, u);
            kmax_phase(F, l); }
        SEAM(pb + 1);
        if (IN(pb + 2)) { REBASE();
            for (int u = F.bid; u < 256; u += F.G) lru_unit<2>(F, p, l, u);
            for (;;) {
                __syncthreads();
                if (F.wid == 0 && lane_now() == 0) F.LC[0] = atomicAdd(F.ctl + CW_QUEUE + l * 64, 1u);
                __syncthreads();
                const int u = (int)F.LC[0];
                if (u >= 16 * 129) break;
                const int qb = 127 - (u >> 4), bh = u & 15;
                attn_unit(F, p, l, bh >> 3, bh & 7, qb);
            }
        }
        SEAM(pb + 2);
        if (IN(pb + 3)) { REBASE();
            { bf16_t* hbm = (bf16_t*)(F.ws + WS_XN) + (size_t)NREAL * DM; unsigned char* hbm8 = (unsigned char*)(F.ws + WS_HB8) + (size_t)NREAL * DM; const float* rmsm = (const float*)(F.ws + WS_RINV) + NREAL;
              for (int g = F.bid; g < DM / 32; g += F.G)
                  meta_gemm_group(F.lds, F.wid, (const bf16_t*)(F.ws + WS_MIX) + (size_t)NREAL * DM, (const bf16_t*)(F.ws + WS_WOUT) + ((size_t)l * DM + 32 * g) * DM, DM,
                                  [&](int row, int col, float v) { const int c = 32 * g + col;
                                      const float bs = __uint_as_float((unsigned)hbm[(size_t)row * DM + c] << 16) * rmsm[row];
                                      hbm[(size_t)row * DM + c] = (bf16_t)(cvt_pk_bf16(bs + v, 0.f) & 0xffffu); hbm8[(size_t)row * DM + c] = (unsigned char)(cvt4_fp8(bs + v, 0.f, 0.f, 0.f) & 0xffu); }); }
            pg8::DenseOrder S; S.init(F.ws + WS_MIX, F.ws + WS_WOUT + (size_t)l * DM * DM * 2, NREAL, DM, DM, F.G, F.bid);
            pg8::EpiResid E{(bf16_t*)(F.ws + WS_XN), (const float*)(F.ws + WS_RINV), (unsigned char*)(F.ws + WS_HB8)};
            pg8::gemm_phase<pg8::EpiResid, pg8::DenseOrder>(F.lds, F.wid, DM, S, E);
        }
        SEAM(pb + 3);
        if (IN(pb + 4)) { REBASE(); router_phase(F, p, l); }
        SEAM(pb + 4);
        if (IN(pb + 5)) { REBASE(); slots_phase(F, p, l); }
        SEAM(pb + 5);
        if (IN(pb + 6)) { REBASE();
            moe_tables(F, l);
            pg8::MoeOrder S{(const char*)(F.ws + WS_HB8), (const char*)(F.ws + WS_WGU + (size_t)l * 16 * 1024 * DM), (size_t)0, (size_t)1024 * DM, (size_t)256 * DM, 4, F.G, F.bid,
                            (const LAS int*)(F.lds + LCTL_OFF + 32 * 4), (const LAS int*)(F.lds + LCTL_OFF + 64 * 4)};
            pg8::EpiSwiGLU E{(unsigned char*)(F.ws + WS_HE), (const float*)(F.ws + WS_RSLOT)};
            { LAS int* idxt = (LAS int*)(F.lds + LIDX_OFF); const int* tokmap = (const int*)(F.ws + WS_TOKMAP); pg8::Unit uu;
              const int tz = (F.wid << 6) | lane_now();
#pragma unroll 1
              for (int i = 0; i < MAXGU; ++i) { if (!S.next(i, uu)) break; if (tz < 256) idxt[i * 256 + tz] = tokmap[uu.row0 + tz]; }
              __syncthreads(); }
            pg8::gemm_phase<pg8::EpiSwiGLU, pg8::MoeOrder, true, true, true, true>(F.lds, F.wid, DM, S, E, (const char*)(F.ws + WS_HB8), (const LAS int*)(F.lds + LIDX_OFF));
        }
        SEAM(pb + 6);
        if (IN(pb + 7)) { REBASE();
            moe_tables(F, l);
            pg8::MoeOrder S{(const char*)(F.ws + WS_HE), (const char*)(F.ws + WS_WD + (size_t)l * 16 * DM * DEXP), (size_t)DEXP, (size_t)DM * DEXP, (size_t)256 * DEXP, 8, F.G, F.bid,
                            (const LAS int*)(F.lds + LCTL_OFF + 32 * 4), (const LAS int*)(F.lds + LCTL_OFF + 64 * 4)};
            pg8::EpiY8 E{(unsigned char*)(F.ws + WS_PROJ)};
            pg8::gemm_phase<pg8::EpiY8, pg8::MoeOrder, true, true, false, true>(F.lds, F.wid, DEXP, S, E);
        }
        SEAM(pb + 7);
        if (IN(pb + 8)) { REBASE(); combine_phase(F, p, l); }
        SEAM(pb + 8);
    }
#undef IN
#undef REBASE
#undef SEAM
}

extern "C" void kernel_launch(void* const* d_in, const int* in_sizes, int n_in, void* d_out, int out_size, void* d_ws, size_t ws_size, hipStream_t stream) {
    static int grid = 0;
    if (grid == 0) {
        if (n_in != 26 || out_size != NREAL * DM || ws_size < WS_END) { fprintf(stderr, "kernel_launch: unexpected shapes (n_in %d out %d ws %zu)\n", n_in, out_size, ws_size); grid = -1; return; }
        int dev = 0, cus = 0, per_cu = 0;
        if (hipGetDevice(&dev) != hipSuccess || hipDeviceGetAttribute(&cus, hipDeviceAttributeMultiprocessorCount, dev) != hipSuccess) { grid = -1; return; }
        if (hipFuncSetAttribute((const void*)mega_fwd, hipFuncAttributeMaxDynamicSharedMemorySize, LDS_BYTES) != hipSuccess) { fprintf(stderr, "kernel_launch: hipFuncSetAttribute failed\n"); grid = -1; return; }
        if (hipOccupancyMaxActiveBlocksPerMultiprocessor(&per_cu, (const void*)mega_fwd, 512, LDS_BYTES) != hipSuccess || per_cu < 1) { fprintf(stderr, "kernel_launch: occupancy query says %d\n", per_cu); (void)hipGetLastError(); }
        grid = cus;
        if (grid > 1024) grid = 1024;
    }
    if (grid < 0) return;
    if (hipMemsetAsync((char*)d_ws + WS_CTL, 0, CTL_BYTES, stream) != hipSuccess) return;
    Params p{};
    for (int i = 0; i < 26; ++i) p.in[i] = (const float*)d_in[i];
    p.out = (float*)d_out; p.ws = (unsigned char*)d_ws;
#if MK_N_LAUNCHES == 1
    p.ph_lo = 0; p.ph_hi = N_PHASES;
    hipLaunchKernelGGL(mega_fwd, dim3(grid), dim3(512), LDS_BYTES, stream, p);
#else
    for (int k = 0; k < N_PHASES; ++k) { p.ph_lo = k; p.ph_hi = k + 1; hipLaunchKernelGGL(mega_fwd, dim3(grid), dim3(512), LDS_BYTES, stream, p); }
#endif
}
```

```cpp
#include <hip/hip_runtime.h>
#include <cstdio>
#include <cstdint>

#ifndef MK_N_LAUNCHES
#define MK_N_LAUNCHES 1
#endif

#define LAS __attribute__((address_space(3)))
typedef unsigned short bf16_t;
typedef short bf16x8 __attribute__((ext_vector_type(8)));
typedef short s16x4 __attribute__((ext_vector_type(4)));
typedef float f32x2 __attribute__((ext_vector_type(2)));
typedef float f32x4 __attribute__((ext_vector_type(4)));
typedef float f32x16 __attribute__((ext_vector_type(16)));
typedef unsigned u32x2 __attribute__((ext_vector_type(2)));
typedef unsigned u32x4 __attribute__((ext_vector_type(4)));
typedef int i32x8 __attribute__((ext_vector_type(8)));
typedef int i32x4 __attribute__((ext_vector_type(4)));

constexpr int BATCH = 2, SEQ = 16384, NMETA = 16, TLEN = SEQ + NMETA, DM = 2048, NPROJ = 5120, DEPTH = 2;
constexpr int NREAL = BATCH * SEQ;
constexpr int NTOK = NREAL + BATCH * NMETA;
constexpr int RPAD = 33024, NPAN = RPAD / 256;
constexpr int LRUW = 1024, NEXP = 16, DEXP = 512, NHEAD = 8;
constexpr int XS_ROWS = 2 * NTOK + NEXP * 256;
constexpr int OFF_U = 0, OFF_YG = 1024, OFF_Q = 2048, OFF_K = 3072, OFF_V = 4096;
constexpr float RMS_EPS = 1e-6f;
constexpr float LOG2E = 1.4426950408889634f;
constexpr float QSCALE = 0.125f * LOG2E;

constexpr size_t MiB = 1u << 20;
constexpr size_t WS_CTL = 0, CTL_BYTES = 1 * MiB;
constexpr size_t WS_TOKINFO = 1 * MiB;
constexpr size_t WS_TOKSLOT = WS_TOKINFO + 640 * 1024;
constexpr size_t WS_HIST = WS_TOKSLOT + 320 * 1024;
constexpr size_t WS_LRUSUM = WS_HIST + 64 * 1024;
constexpr size_t WS_HMETA = WS_LRUSUM + 256 * 1024;
constexpr size_t WS_WR = WS_HMETA + 256 * 1024;
constexpr size_t WS_PB = WS_WR + 512 * 1024;
constexpr size_t WS_TOKMAP = WS_PB + 256 * 1024;
constexpr size_t WS_RSLOT = WS_TOKMAP + 288 * 1024;
constexpr size_t WS_RINV = WS_RSLOT + 288 * 1024;
constexpr size_t WS_WGATES = 4 * MiB;
constexpr size_t WS_WIN = 6 * MiB;
constexpr size_t WS_WOUT = 46 * MiB;
constexpr size_t WS_WGU = 62 * MiB;
constexpr size_t WS_WD = 190 * MiB;
constexpr size_t WS_XN = 254 * MiB;
constexpr size_t WS_MIX = 383 * MiB;
constexpr size_t WS_HE = 512 * MiB;
constexpr size_t WS_PROJ = 581 * MiB;
constexpr size_t WS_HB8 = 904 * MiB;
constexpr size_t WS_END = 970 * MiB;
static_assert(WS_WR + 2 * 32 * 2048 * 4 <= WS_PB && WS_PB + 3 * 16384 * 4 <= WS_TOKMAP && (size_t)XS_ROWS * 4 <= 288 * 1024 && WS_RINV + (size_t)RPAD * 4 <= WS_WGATES && WS_PROJ + (size_t)RPAD * NPROJ * 2 <= WS_HB8 && WS_HB8 + (size_t)RPAD * DM <= WS_END && WS_HE + (size_t)XS_ROWS * DEXP * 2 <= WS_PROJ, "ws map");
constexpr int PBL = 16384, PB_CW = 0, PB_CB = 4096, PB_BA = 5120, PB_BX = 6144, PB_SP8 = 7168, PB_SUBG = 8192, PB_RGB = 8320, PB_REB = 8324, PB_LAM = 8352, PB_FING = 2 * PBL;
constexpr int CW_BAR = 4096;
constexpr int CW_QUEUE = 8192;
constexpr int CW_CNT = 8192 + 256;
constexpr int CW_KMAX = 8192 + 512;

constexpr int RING_BYTES = 131072;
constexpr int LCTL_OFF = RING_BYTES;
constexpr int LIDX_OFF = LCTL_OFF + 1024;
constexpr int MAXGU = 12;
constexpr int LDS_BYTES = 147456;
static_assert(LIDX_OFF + MAXGU * 1024 <= LDS_BYTES, "LDS map");

__device__ __forceinline__ unsigned cvt_pk_bf16(float lo, float hi) { unsigned r; asm volatile("v_cvt_pk_bf16_f32 %0, %1, %2" : "=v"(r) : "v"(lo), "v"(hi)); return r; }
constexpr float HE_SCALE = 0.5f, Y8_INV = 1.0f / (64.0f * 0.5f);
constexpr float W8_SCALE = 64.0f, W8_INV = 1.0f / 64.0f;
__device__ __forceinline__ unsigned cvt4_fp8(float a, float b, float c, float d) { int w = __builtin_amdgcn_cvt_pk_fp8_f32(a, b, 0, false); w = __builtin_amdgcn_cvt_pk_fp8_f32(c, d, w, true); return (unsigned)w; }
__device__ __forceinline__ float bf_lo(unsigned u) { return __uint_as_float(u << 16); }
__device__ __forceinline__ float bf_hi(unsigned u) { return __uint_as_float(u & 0xffff0000u); }
__device__ __forceinline__ float shx1(float v) { return __int_as_float(__builtin_amdgcn_mov_dpp(__float_as_int(v), 0xB1, 0xf, 0xf, true)); }
__device__ __forceinline__ float shx2(float v) { return __int_as_float(__builtin_amdgcn_mov_dpp(__float_as_int(v), 0x4E, 0xf, 0xf, true)); }
template <int M> __device__ __forceinline__ float shxs(float v) { return __int_as_float(__builtin_amdgcn_ds_swizzle(__float_as_int(v), (M << 10) | 0x1f)); }
__device__ __forceinline__ float sum32(float v) { const auto r = __builtin_amdgcn_permlane32_swap(__float_as_int(v), __float_as_int(v), false, false); return __int_as_float(r[0]) + __int_as_float(r[1]); }
__device__ __forceinline__ float max32(float v) { const auto r = __builtin_amdgcn_permlane32_swap(__float_as_int(v), __float_as_int(v), false, false); return fmaxf(__int_as_float(r[0]), __int_as_float(r[1])); }
__device__ __forceinline__ float wave_sum(float v) { v += shx1(v); v += shx2(v); v += shxs<4>(v); v += shxs<8>(v); v += shxs<16>(v); return sum32(v); }
__device__ __forceinline__ int crow(int r, int hi) { return (r & 3) + 8 * (r >> 2) + 4 * hi; }
__device__ __forceinline__ int tok_row(int b, int pos) { return pos < NMETA ? NREAL + b * NMETA + pos : b * SEQ + pos - NMETA; }
#define LDS_WAIT() asm volatile("s_waitcnt lgkmcnt(0)" ::: "memory")
#define LDS_BARRIER() do { asm volatile("s_waitcnt lgkmcnt(0)" ::: "memory"); __builtin_amdgcn_s_barrier(); asm volatile("" ::: "memory"); } while (0)
__device__ __forceinline__ void lds_add(LAS unsigned* p, unsigned v) { (void)__hip_atomic_fetch_add(p, v, __ATOMIC_RELAXED, __HIP_MEMORY_SCOPE_WORKGROUP); }

#define XB_TMO      128
#define XB_XCNT(j)  (256  + 64 * (j))
#define XB_XSUB(j)  (1280 + 64 * (j))
#define XB_XGEN(j)  (2304 + 64 * (j))
#define XB_TOP      3328
#define XB_TOPGEN   3392
#define XCD_BAR_WORDS 3456
#define XB_SPIN_CAP (1u << 24)
__device__ __forceinline__ unsigned xb_ld(unsigned* p)              { return __hip_atomic_load(p, __ATOMIC_RELAXED, __HIP_MEMORY_SCOPE_AGENT); }
__device__ __forceinline__ unsigned xb_add(unsigned* p, unsigned v) { return __hip_atomic_fetch_add(p, v, __ATOMIC_RELAXED, __HIP_MEMORY_SCOPE_AGENT); }
__device__ __forceinline__ unsigned xb_xcc_id() { return (unsigned)__builtin_amdgcn_s_getreg((3 << 11) | 20) & 0xFu; }
#define XB_SPIN(cond, bar) do { unsigned _sp = 0; while (cond) { __builtin_amdgcn_s_sleep(1); \
    if ((++_sp & 255u) == 0u) { if (xb_ld(&(bar)[XB_TMO])) break; if (_sp > XB_SPIN_CAP) { atomicAdd(&(bar)[XB_TMO], 1u); break; } } } } while (0)
__device__ __forceinline__ int lane_now() { int l; asm volatile("v_mbcnt_lo_u32_b32 %0, -1, 0\n\tv_mbcnt_hi_u32_b32 %0, -1, %0" : "=v"(l)); return l; }
struct XcdBarrier { unsigned* bar; unsigned x; volatile LAS unsigned* st; int wid; };
__device__ __forceinline__ XcdBarrier xcd_barrier_post(unsigned* bar, volatile LAS unsigned* st, int wid) {
    XcdBarrier b; b.bar = bar; b.x = xb_xcc_id(); b.st = st; b.wid = wid;
    if (wid == 0 && lane_now() == 0) (void)xb_add(&bar[XB_XCNT(b.x)], 1u);
    return b;
}
__device__ __forceinline__ void xcd_barrier_complete(unsigned* bar, unsigned x, unsigned& nloc, unsigned& nx) {
    const unsigned G = gridDim.x * gridDim.y * gridDim.z;
    unsigned sum, cnt, mine, sp = 0u;
    for (;;) {
        sum = 0u; cnt = 0u; mine = 0u;
#pragma unroll
        for (unsigned j = 0; j < 16; ++j) { const unsigned c = xb_ld(&bar[XB_XCNT(j)]); sum += c; cnt += (c > 0u) ? 1u : 0u; mine = (j == x) ? c : mine; }
        if (sum == G) break;
        __builtin_amdgcn_s_sleep(1);
        if ((++sp & 255u) == 0u) { if (xb_ld(&bar[XB_TMO])) break; if (sp > XB_SPIN_CAP) { atomicAdd(&bar[XB_TMO], 1u); break; } }
    }
    nloc = mine > 0u ? mine : 1u; nx = cnt > 0u ? cnt : 1u;
}
__device__ __forceinline__ void xcd_barrier_census(const XcdBarrier& b) {
    if (b.wid == 0 && lane_now() == 0) { unsigned nloc, nx; xcd_barrier_complete(b.bar, b.x, nloc, nx); b.st[0] = nloc; b.st[1] = nx; }
    __syncthreads();
}
__device__ __forceinline__ void xcd_barrier(const XcdBarrier& b) {
    asm volatile("s_waitcnt vmcnt(0)" ::: "memory");
    __syncthreads();
    if (b.wid == 0 && lane_now() == 0) {
        unsigned* bar = b.bar;
        __builtin_amdgcn_s_waitcnt(0);
        const unsigned nloc = b.st[0], nx = b.st[1];
        const unsigned old = xb_add(&bar[XB_XSUB(b.x)], 1u);
        const unsigned gen = old / nloc;
        if (old + 1u == (gen + 1u) * nloc) {
            __builtin_amdgcn_fence(__ATOMIC_RELEASE, "agent");
            asm volatile("s_waitcnt vmcnt(0)" ::: "memory");
            const unsigned og = xb_add(&bar[XB_TOP], 1u);
            const unsigned tg = og / nx;
            if (og + 1u == (tg + 1u) * nx) xb_add(&bar[XB_TOPGEN], 1u);
            else XB_SPIN(xb_ld(&bar[XB_TOPGEN]) == tg, bar);
            __builtin_amdgcn_fence(__ATOMIC_ACQUIRE, "agent");
            xb_add(&bar[XB_XGEN(b.x)], 1u);
            asm volatile("s_waitcnt vmcnt(0)" ::: "memory");
        } else {
            XB_SPIN(xb_ld(&bar[XB_XGEN(b.x)]) == gen, bar);
            __builtin_amdgcn_fence(__ATOMIC_ACQUIRE, "agent");
            asm volatile("s_waitcnt vmcnt(0)" ::: "memory");
        }
    }
    __syncthreads();
}

namespace pg8 {
constexpr int BM = 256, BK = 64, HALF = 128, HTB = HALF * BK * 2, STAGE_BYTES = 8 * HTB, NXCD = 8, WGM = 8;
__host__ __device__ __forceinline__ int lds_byte(int r, int c) { const int st = (r >> 4) * 2 + (c >> 5), rr = r & 15, cc = c & 31, ob = rr * 64 + cc * 2; return st * 1024 + (ob ^ (((ob >> 9) & 1) << 5)); }
__host__ __device__ __forceinline__ void stage_rc(int b, int& R, int& C) { const int st = b / 1024, sb = b % 1024, swz = sb ^ (((sb >> 9) & 1) << 5); R = (st >> 1) * 16 + swz / 64; C = (st & 1) * 32 + (swz % 64) / 2; }
__host__ __device__ __forceinline__ int perm32(int rho) { const int n = rho >> 4, i = rho & 15; return 8 * (i >> 2) + 4 * n + (i & 3); }

struct Unit { const char* A; const char* B; int row0, col0; };

struct DenseOrder {
    const char* A; const char* Bt; size_t tstep; int nM, nN, nwg, G, c;
    __device__ void init(const void* A_, const void* Bt_, int M, int N, int K, int G_, int c_) { A = (const char*)A_; Bt = (const char*)Bt_; tstep = (size_t)BM * K * 2; nM = M / BM; nN = N / BM; nwg = nM * nN; G = G_; c = c_; }
    __device__ bool next(int i, Unit& u) const {
        const long L = (long)i * G + c; if (L >= nwg) return false;
        int wgid = (int)L; { const int q = nwg / NXCD, r = nwg % NXCD, xcd = wgid % NXCD, off = wgid / NXCD; wgid = (xcd < r ? xcd * (q + 1) : r * (q + 1) + (xcd - r) * q) + off; }
        const int nig = WGM * nN, gid = wgid / nig, fm = gid * WGM, gsz = (nM - fm) < WGM ? (nM - fm) : WGM;
        const int pm = fm + ((wgid % nig) % gsz), pn = (wgid % nig) / gsz;
        u.A = A + (size_t)pm * tstep; u.B = Bt + (size_t)pn * tstep; u.row0 = pm * BM; u.col0 = pn * BM; return true;
    }
};
struct MoeOrder {
    const char* A; const char* Bt; size_t rowbytes, ebytes, tstepB; int NT, G, c; const LAS int* pp; const LAS int* sb;
    __device__ bool next(int i, Unit& u) const {
        int pg, pn;
        if ((G & 7) == 0 && ((G >> 3) % NT) == 0) { const int x = c & 7, idx = c >> 3, ppr = (G >> 3) / NT; pn = idx % NT; pg = i * (8 * ppr) + x * ppr + idx / NT; }
        else { const long L = (long)i * G + c; pg = (int)(L / NT); pn = (int)(L % NT); }
        if (pg >= pp[16]) return false;
        int e = 0;
#pragma unroll
        for (int j = 1; j < 16; ++j) e += (pg >= pp[j]) ? 1 : 0;
        e = __builtin_amdgcn_readfirstlane(e);
        const int row0 = __builtin_amdgcn_readfirstlane(sb[e] + (pg - pp[e]) * BM);
        u.A = A + (size_t)row0 * rowbytes; u.B = Bt + (size_t)e * ebytes + (size_t)pn * tstepB; u.row0 = row0; u.col0 = pn * BM; return true;
    }
};

struct EpiBf16 {
    static constexpr bool PERM = true;
    bf16_t* O; int ldc; float sc;
    __device__ __forceinline__ void operator()(const f32x4 (&acc)[2][2][4][2], const Unit& u, int wr, int wc, int fr, int fq) const {
        const int row0 = u.row0 + wr * 64 + fr, col0 = u.col0 + wc * 32 + 8 * fq;
#pragma unroll
        for (int ai = 0; ai < 2; ++ai)
#pragma unroll
            for (int m = 0; m < 4; ++m) { bf16_t* rowp = O + (size_t)(row0 + ai * HALF + m * 16) * ldc + col0;
#pragma unroll
                for (int bj = 0; bj < 2; ++bj) { const f32x4 v0 = acc[ai][bj][m][0] * sc, v1 = acc[ai][bj][m][1] * sc;
                    u32x4 w; w.x = cvt_pk_bf16(v0[0], v0[1]); w.y = cvt_pk_bf16(v0[2], v0[3]); w.z = cvt_pk_bf16(v1[0], v1[1]); w.w = cvt_pk_bf16(v1[2], v1[3]);
                    *(u32x4*)(rowp + bj * HALF) = w; } }
    }
};
struct EpiY8 {
    static constexpr bool PERM = true;
    unsigned char* O;
    __device__ __forceinline__ void operator()(const f32x4 (&acc)[2][2][4][2], const Unit& u, int wr, int wc, int fr, int fq) const {
        const int row0 = u.row0 + wr * 64 + fr, col0 = u.col0 + wc * 32 + 8 * fq;
#pragma unroll
        for (int ai = 0; ai < 2; ++ai)
#pragma unroll
            for (int m = 0; m < 4; ++m) { unsigned char* rowp = O + (size_t)(row0 + ai * HALF + m * 16) * DM + col0;
#pragma unroll
                for (int bj = 0; bj < 2; ++bj) { const f32x4 v0 = acc[ai][bj][m][0], v1 = acc[ai][bj][m][1];
                    u32x2 w; w.x = cvt4_fp8(v0[0], v0[1], v0[2], v0[3]); w.y = cvt4_fp8(v1[0], v1[1], v1[2], v1[3]); *(u32x2*)(rowp + bj * HALF) = w; } }
    }
};
struct EpiSwiGLU {
    static constexpr bool PERM = true;
    unsigned char* O; const float* rs;
    __device__ __forceinline__ void operator()(const f32x4 (&acc)[2][2][4][2], const Unit& u, int wr, int wc, int fr, int fq) const {
        const int row0 = u.row0 + wr * 64 + fr, hid0 = (u.col0 + wc * 32 + 8 * fq) >> 1;
#pragma unroll
        for (int ai = 0; ai < 2; ++ai)
#pragma unroll
            for (int m = 0; m < 4; ++m) { unsigned char* rowp = O + (size_t)(row0 + ai * HALF + m * 16) * DEXP + hid0; const float rsv = rs[row0 + ai * HALF + m * 16] * W8_INV;
#pragma unroll
                for (int bj = 0; bj < 2; ++bj) { const f32x4 g = acc[ai][bj][m][0] * rsv, up = acc[ai][bj][m][1] * (rsv * HE_SCALE); float o[4];
#pragma unroll
                    for (int j = 0; j < 4; ++j) { const float s = g[j] / (1.0f + __expf(-g[j])); o[j] = s * up[j]; }
                    *(unsigned*)(rowp + bj * (HALF / 2)) = cvt4_fp8(o[0], o[1], o[2], o[3]); } }
    }
};
struct EpiResid {
    static constexpr bool PERM = true;
    bf16_t* hb; const float* rms; unsigned char* hb8;
    __device__ __forceinline__ void operator()(const f32x4 (&acc)[2][2][4][2], const Unit& u, int wr, int wc, int fr, int fq) const {
        const int row0 = u.row0 + wr * 64 + fr;
        const size_t off0 = (size_t)row0 * DM + (u.col0 + wc * 32 + 8 * fq);
        u32x4 q[2][4][2]; float sc[2][4];
#pragma unroll
        for (int ai = 0; ai < 2; ++ai)
#pragma unroll
            for (int m = 0; m < 4; ++m) { sc[ai][m] = rms[row0 + ai * HALF + m * 16];
#pragma unroll
                for (int bj = 0; bj < 2; ++bj) q[ai][m][bj] = *(const u32x4*)(hb + off0 + (size_t)(ai * HALF + m * 16) * DM + bj * HALF); }
#pragma unroll
        for (int ai = 0; ai < 2; ++ai)
#pragma unroll
            for (int m = 0; m < 4; ++m)
#pragma unroll
                for (int bj = 0; bj < 2; ++bj) { const u32x4 t = q[ai][m][bj]; const float r = sc[ai][m]; const size_t o = off0 + (size_t)(ai * HALF + m * 16) * DM + bj * HALF;
                    const f32x4 v0 = acc[ai][bj][m][0] + (f32x4){bf_lo(t.x), bf_hi(t.x), bf_lo(t.y), bf_hi(t.y)} * r, v1 = acc[ai][bj][m][1] + (f32x4){bf_lo(t.z), bf_hi(t.z), bf_lo(t.w), bf_hi(t.w)} * r;
                    u32x4 w; w.x = cvt_pk_bf16(v0[0], v0[1]); w.y = cvt_pk_bf16(v0[2], v0[3]); w.z = cvt_pk_bf16(v1[0], v1[1]); w.w = cvt_pk_bf16(v1[2], v1[3]);
                    *(u32x4*)(hb + o) = w;
                    u32x2 w8; w8.x = cvt4_fp8(v0[0], v0[1], v0[2], v0[3]); w8.y = cvt4_fp8(v1[0], v1[1], v1[2], v1[3]); *(u32x2*)(hb8 + o) = w8; }
    }
};

template <class Epi, class Sched, bool ALIGN_EPI = true, bool SP2 = true, bool GATHER = false, bool FP8 = false>
__device__ __forceinline__ void gemm_phase(LAS unsigned char* lds, const int wid, const int Kel, const Sched& S, const Epi& E, const char* Ab = nullptr, const LAS int* idx = nullptr) {
    static_assert(!GATHER || SP2, "gather needs the SP2 loop");
    const int lane = lane_now(), tid = (wid << 6) | lane, wr = wid >> 2, wc = wid & 3, fr = lane & 15, fq = lane >> 4;
    const int K = FP8 ? (Kel >> 1) : Kel;
    int nt = K / BK; asm volatile("" : "+s"(nt));
    unsigned voffA[2], voffB[2];
#pragma unroll
    for (int i = 0; i < 2; ++i) { int R, C; stage_rc(tid * 16 + i * 8192, R, C); const int Rb = Epi::PERM ? ((R & ~31) + perm32(R & 31)) : R;
        voffA[i] = (unsigned)(R * K + C) * 2u; voffB[i] = (unsigned)(Rb * K + C) * 2u; }
    unsigned goff[2][2];
#define PG8_GOFF(dst, unit_i) do { const int tz_ = (wid << 6) | lane_now(); _Pragma("unroll") for (int i_ = 0; i_ < 2; ++i_) { int R_, C_; stage_rc(tz_ * 16 + i_ * 8192, R_, C_); \
        _Pragma("unroll") for (int h_ = 0; h_ < 2; ++h_) dst[h_][i_] = (unsigned)idx[(unit_i) * 256 + 128 * h_ + R_] * (unsigned)(K * 2) + (unsigned)(C_ * 2); } } while (0)
    const size_t kstep = (size_t)(BK * 2);
    const size_t hstep = (size_t)HALF * K * 2;
    const unsigned ldsw = (unsigned)wid * 1024u;
    const int aoff = lds_byte(wr * 64 + fr, fq * 8), boff = lds_byte(wc * 32 + fr, fq * 8);
#define PG8_SA(b, h) (((b) * 2 + (h)) * HTB)
#define PG8_SB(b, h) ((4 + (b) * 2 + (h)) * HTB)
#define PG8_STAGE(bufoff, gbase, voff) do { _Pragma("unroll") for (int _i = 0; _i < 2; ++_i) \
        __builtin_amdgcn_global_load_lds((const unsigned*)((const char*)(gbase) + (voff)[_i]), (LAS unsigned*)(lds + (bufoff) + ldsw + _i * 8192), 16, 0, 0); } while (0)
#define PG8_LDA(dst, b, h) do { _Pragma("unroll") for (int m = 0; m < 4; ++m) _Pragma("unroll") for (int k = 0; k < 2; ++k) dst[m][k] = *(const LAS bf16x8*)(lds + PG8_SA(b, h) + aoff + m * 2048 + k * 1024); } while (0)
#define PG8_LDB(dst, b, h) do { _Pragma("unroll") for (int n = 0; n < 2; ++n) _Pragma("unroll") for (int k = 0; k < 2; ++k) dst[n][k] = *(const LAS bf16x8*)(lds + PG8_SB(b, h) + boff + n * 2048 + k * 1024); } while (0)
#define PG8_CAT(f) __builtin_shufflevector(__builtin_bit_cast(i32x4, f[0]), __builtin_bit_cast(i32x4, f[1]), 0, 1, 2, 3, 4, 5, 6, 7)
#define PG8_MMA(ai, bj, At, Bt) do { __builtin_amdgcn_s_setprio(1); _Pragma("unroll") for (int m = 0; m < 4; ++m) _Pragma("unroll") for (int n = 0; n < 2; ++n) { \
        if constexpr (FP8) acc[ai][bj][m][n] = __builtin_amdgcn_mfma_scale_f32_16x16x128_f8f6f4(PG8_CAT(Bt[n]), PG8_CAT(At[m]), acc[ai][bj][m][n], 0, 0, 0, 0, 0, 0); \
        else { _Pragma("unroll") for (int k = 0; k < 2; ++k) acc[ai][bj][m][n] = __builtin_amdgcn_mfma_f32_16x16x32_bf16(Bt[n][k], At[m][k], acc[ai][bj][m][n], 0, 0, 0); } } \
        __builtin_amdgcn_s_setprio(0); } while (0)
#define PG8_WAIT_V(n) asm volatile("s_waitcnt vmcnt(" #n ")" ::: "memory")
#define PG8_WAIT_L(n) asm volatile("s_waitcnt lgkmcnt(" #n ")" ::: "memory")
#define PG8_BAR __builtin_amdgcn_s_barrier()
#define PG8_SCHED __builtin_amdgcn_sched_barrier(0)
    Unit cur, nxt; int ui = 0;
    if (!S.next(0, cur)) return;
    f32x4 acc[2][2][4][2];
#pragma unroll
    for (int a = 0; a < 2; ++a)
#pragma unroll
        for (int b = 0; b < 2; ++b)
#pragma unroll
            for (int m = 0; m < 4; ++m)
#pragma unroll
                for (int n = 0; n < 2; ++n) acc[a][b][m][n] = (f32x4){0.f, 0.f, 0.f, 0.f};
    bf16x8 At[4][2], B0[2][2], B1[2][2];
    const char* cA = cur.A; const char* cB = cur.B;
    if constexpr (GATHER) {
        PG8_GOFF(goff, 0);
        PG8_STAGE(PG8_SB(0, 0), cB, voffB); PG8_STAGE(PG8_SB(0, 1), cB + hstep, voffB); PG8_STAGE(PG8_SA(0, 0), Ab, goff[0]); PG8_STAGE(PG8_SA(0, 1), Ab, goff[1]);
        if (wr == 1) PG8_BAR;
        PG8_WAIT_V(2); PG8_BAR;
        PG8_STAGE(PG8_SB(1, 0), cB + kstep, voffB); PG8_STAGE(PG8_SA(1, 0), Ab + kstep, goff[0]); PG8_STAGE(PG8_SB(1, 1), cB + hstep + kstep, voffB);
        PG8_WAIT_V(6); PG8_BAR;
    } else if constexpr (SP2) {
        PG8_STAGE(PG8_SB(0, 0), cB, voffB); PG8_STAGE(PG8_SB(0, 1), cB + hstep, voffB); PG8_STAGE(PG8_SA(0, 0), cA, voffA); PG8_STAGE(PG8_SA(0, 1), cA + hstep, voffA);
        if (wr == 1) PG8_BAR;
        PG8_WAIT_V(2); PG8_BAR;
        PG8_STAGE(PG8_SB(1, 0), cB + kstep, voffB); PG8_STAGE(PG8_SA(1, 0), cA + kstep, voffA); PG8_STAGE(PG8_SB(1, 1), cB + hstep + kstep, voffB);
        PG8_WAIT_V(6); PG8_BAR;
    } else {
        PG8_STAGE(PG8_SB(0, 0), cB, voffB); PG8_STAGE(PG8_SA(0, 0), cA, voffA); PG8_STAGE(PG8_SB(0, 1), cB + hstep, voffB); PG8_STAGE(PG8_SA(0, 1), cA + hstep, voffA);
        if (wr == 1) PG8_BAR;
        PG8_WAIT_V(4); PG8_BAR;
        PG8_STAGE(PG8_SB(1, 0), cB + kstep, voffB); PG8_STAGE(PG8_SA(1, 0), cA + kstep, voffA); PG8_STAGE(PG8_SB(1, 1), cB + hstep + kstep, voffB);
        PG8_WAIT_V(6); PG8_BAR;
    }
    for (;;) {
        const bool has_next = S.next(ui + 1, nxt);
        const char* nA = has_next ? nxt.A : cA; const char* nB = has_next ? nxt.B : cB;
#pragma unroll 1
        for (int t = 0; t < nt; t += 2) {
            const bool last = (t == nt - 2);
            asm volatile("" : "+v"(voffA[0]), "+v"(voffA[1]), "+v"(voffB[0]), "+v"(voffB[1]));
            const char* a1 = cA + (size_t)(t + 1) * kstep;
            const char* a2 = last ? nA : cA + (size_t)(t + 2) * kstep; const char* b2 = last ? nB : cB + (size_t)(t + 2) * kstep;
            const char* a3 = a2 + kstep; const char* b3 = b2 + kstep;
            if constexpr (GATHER) {
            const char* g1 = Ab + (size_t)(t + 1) * kstep; const char* g2 = last ? Ab : Ab + (size_t)(t + 2) * kstep; const char* g3 = g2 + kstep;
            PG8_LDB(B0, 0, 0); PG8_LDB(B1, 0, 1); PG8_SCHED; PG8_LDA(At, 0, 0); PG8_STAGE(PG8_SA(1, 1), g1, goff[1]);
            PG8_WAIT_V(8); PG8_WAIT_L(0); PG8_BAR; PG8_MMA(0, 0, At, B0); PG8_MMA(0, 1, At, B1); PG8_BAR; PG8_SCHED;
            if (last && has_next) PG8_GOFF(goff, ui + 1);
            PG8_LDA(At, 0, 1); PG8_STAGE(PG8_SB(0, 0), b2, voffB); PG8_STAGE(PG8_SB(0, 1), b2 + hstep, voffB); PG8_STAGE(PG8_SA(0, 0), g2, goff[0]);
            PG8_WAIT_V(8); PG8_WAIT_L(0); PG8_BAR; PG8_MMA(1, 0, At, B0); PG8_MMA(1, 1, At, B1); PG8_BAR; PG8_SCHED;
            PG8_LDB(B0, 1, 0); PG8_LDB(B1, 1, 1); PG8_SCHED; PG8_LDA(At, 1, 0); PG8_STAGE(PG8_SA(0, 1), g2, goff[1]);
            PG8_WAIT_V(8); PG8_WAIT_L(0); PG8_BAR; PG8_MMA(0, 0, At, B0); PG8_MMA(0, 1, At, B1); PG8_BAR; PG8_SCHED;
            PG8_LDA(At, 1, 1); PG8_STAGE(PG8_SB(1, 0), b3, voffB); PG8_STAGE(PG8_SB(1, 1), b3 + hstep, voffB); PG8_STAGE(PG8_SA(1, 0), g3, goff[0]);
            PG8_WAIT_V(8); PG8_WAIT_L(0); PG8_BAR; PG8_MMA(1, 0, At, B0); PG8_MMA(1, 1, At, B1); PG8_BAR; PG8_SCHED;
            } else if constexpr (SP2) {
            PG8_LDB(B0, 0, 0); PG8_LDB(B1, 0, 1); PG8_SCHED; PG8_LDA(At, 0, 0); PG8_STAGE(PG8_SA(1, 1), a1 + hstep, voffA);
            PG8_WAIT_V(8); PG8_WAIT_L(0); PG8_BAR; PG8_MMA(0, 0, At, B0); PG8_MMA(0, 1, At, B1); PG8_BAR; PG8_SCHED;
            PG8_LDA(At, 0, 1); PG8_STAGE(PG8_SB(0, 0), b2, voffB); PG8_STAGE(PG8_SB(0, 1), b2 + hstep, voffB); PG8_STAGE(PG8_SA(0, 0), a2, voffA);
            PG8_WAIT_V(8); PG8_WAIT_L(0); PG8_BAR; PG8_MMA(1, 0, At, B0); PG8_MMA(1, 1, At, B1); PG8_BAR; PG8_SCHED;
            PG8_LDB(B0, 1, 0); PG8_LDB(B1, 1, 1); PG8_SCHED; PG8_LDA(At, 1, 0); PG8_STAGE(PG8_SA(0, 1), a2 + hstep, voffA);
            PG8_WAIT_V(8); PG8_WAIT_L(0); PG8_BAR; PG8_MMA(0, 0, At, B0); PG8_MMA(0, 1, At, B1); PG8_BAR; PG8_SCHED;
            PG8_LDA(At, 1, 1); PG8_STAGE(PG8_SB(1, 0), b3, voffB); PG8_STAGE(PG8_SB(1, 1), b3 + hstep, voffB); PG8_STAGE(PG8_SA(1, 0), a3, voffA);
            PG8_WAIT_V(8); PG8_WAIT_L(0); PG8_BAR; PG8_MMA(1, 0, At, B0); PG8_MMA(1, 1, At, B1); PG8_BAR; PG8_SCHED;
            } else {
            PG8_LDB(B0, 0, 0); PG8_SCHED; PG8_LDA(At, 0, 0); PG8_STAGE(PG8_SA(1, 1), a1 + hstep, voffA);
            PG8_WAIT_L(8); PG8_BAR; PG8_WAIT_L(0); PG8_MMA(0, 0, At, B0); PG8_BAR; PG8_SCHED;
            PG8_LDB(B1, 0, 1); PG8_STAGE(PG8_SB(0, 0), b2, voffB);
            PG8_BAR; PG8_WAIT_L(0); PG8_MMA(0, 1, At, B1); PG8_BAR;
            PG8_LDA(At, 0, 1); PG8_STAGE(PG8_SA(0, 0), a2, voffA);
            PG8_BAR; PG8_WAIT_L(0); PG8_MMA(1, 0, At, B0); PG8_BAR; PG8_SCHED;
            PG8_STAGE(PG8_SB(0, 1), b2 + hstep, voffB);
            PG8_WAIT_V(6); PG8_BAR; PG8_MMA(1, 1, At, B1); PG8_BAR;
            PG8_LDB(B0, 1, 0); PG8_SCHED; PG8_LDA(At, 1, 0); PG8_STAGE(PG8_SA(0, 1), a2 + hstep, voffA);
            PG8_WAIT_L(8); PG8_BAR; PG8_WAIT_L(0); PG8_MMA(0, 0, At, B0); PG8_BAR; PG8_SCHED;
            PG8_LDB(B1, 1, 1); PG8_STAGE(PG8_SB(1, 0), b3, voffB);
            PG8_BAR; PG8_WAIT_L(0); PG8_MMA(0, 1, At, B1); PG8_BAR;
            PG8_LDA(At, 1, 1); PG8_STAGE(PG8_SA(1, 0), a3, voffA);
            PG8_BAR; PG8_WAIT_L(0); PG8_MMA(1, 0, At, B0); PG8_BAR; PG8_SCHED;
            PG8_STAGE(PG8_SB(1, 1), b3 + hstep, voffB);
            PG8_WAIT_V(6); PG8_BAR; PG8_MMA(1, 1, At, B1); PG8_BAR;
            }
        }
        if constexpr (ALIGN_EPI) { if (wr == 0) PG8_BAR; }
        { const int lz = lane_now(); E(acc, cur, wr, wc, lz & 15, lz >> 4); }
        if (!has_next) break;
#pragma unroll
        for (int a = 0; a < 2; ++a)
#pragma unroll
            for (int b = 0; b < 2; ++b)
#pragma unroll
                for (int m = 0; m < 4; ++m)
#pragma unroll
                    for (int n = 0; n < 2; ++n) acc[a][b][m][n] = (f32x4){0.f, 0.f, 0.f, 0.f};
        cur = nxt; cA = nA; cB = nB; ++ui;
        if constexpr (ALIGN_EPI) { if (wr == 1) PG8_BAR; }
    }
    PG8_WAIT_V(0);
    if constexpr (!ALIGN_EPI) { if (wr == 0) PG8_BAR; }
    PG8_BAR;
#undef PG8_GOFF
#undef PG8_CAT
#undef PG8_SA
#undef PG8_SB
#undef PG8_STAGE
#undef PG8_LDA
#undef PG8_LDB
#undef PG8_MMA
#undef PG8_WAIT_V
#undef PG8_WAIT_L
#undef PG8_BAR
#undef PG8_SCHED
}
}

struct Params {
    const float* in[26];
    float* out;
    unsigned char* ws;
    int ph_lo, ph_hi;
};
struct Frame {
    LAS unsigned char* lds;
    volatile LAS unsigned* LC;
    unsigned* ctl;
    unsigned char* ws;
    int G, bid, wid;
};
#define PHASE_IDS() int wid = F.wid; asm volatile("" : "+s"(wid)); const int lane = lane_now(); const int tid = (wid << 6) | lane; (void)tid

__device__ __forceinline__ void tr_item(const float* W, int K, int N, bf16_t* WT, int item, LAS float* scr, int lane, const float* gk, int qscale, int rowmap) {
    const int nblk = N / 32, kb = item / nblk, nb = item % nblk, k0 = 64 * kb, n0 = 32 * nb;
    float tv[32];
#pragma unroll
    for (int i = 0; i < 32; ++i) { const int kk = 2 * i + (lane >> 5); tv[i] = W[(size_t)(k0 + kk) * N + n0 + (lane & 31)]; }
#pragma unroll
    for (int i = 0; i < 32; ++i) { const int kk = 2 * i + (lane >> 5); const int n = n0 + (lane & 31);
        float v = tv[i]; if (gk) v *= gk[k0 + kk]; if (qscale && n >= OFF_Q && n < OFF_K) v *= QSCALE;
        scr[kk * 33 + (lane & 31)] = v; }
    LDS_WAIT(); asm volatile("" ::: "memory");
    const int c = lane & 7;
#pragma unroll
    for (int j = 0; j < 4; ++j) { const int n = (lane >> 3) + 8 * j; const LAS float* s = scr + (8 * c) * 33 + n;
        u32x4 o; o.x = cvt_pk_bf16(s[0 * 33], s[1 * 33]); o.y = cvt_pk_bf16(s[2 * 33], s[3 * 33]); o.z = cvt_pk_bf16(s[4 * 33], s[5 * 33]); o.w = cvt_pk_bf16(s[6 * 33], s[7 * 33]);
        const int ng = n0 + n; const int dr = rowmap == 0 ? ng : (8 * (ng >> 2) + (ng & 3) + (rowmap == 2 ? 4 : 0));
        *(u32x4*)(WT + (size_t)dr * K + k0 + 8 * c) = o; }
    LDS_WAIT(); asm volatile("" ::: "memory");
}
__device__ __forceinline__ void tr_item8(const float* W, int K, int N, unsigned char* WT, int item, LAS float* scr, int lane, const float* gk, int rowmap) {
    const int nblk = N / 32, kb = item / nblk, nb = item % nblk, k0 = 64 * kb, n0 = 32 * nb;
    float tv[32];
#pragma unroll
    for (int i = 0; i < 32; ++i) { const int kk = 2 * i + (lane >> 5); tv[i] = W[(size_t)(k0 + kk) * N + n0 + (lane & 31)]; }
#pragma unroll
    for (int i = 0; i < 32; ++i) { const int kk = 2 * i + (lane >> 5); float v = tv[i] * W8_SCALE; if (gk) v *= gk[k0 + kk]; scr[kk * 33 + (lane & 31)] = v; }
    LDS_WAIT(); asm volatile("" ::: "memory");
    const int c = lane & 3;
#pragma unroll
    for (int j = 0; j < 2; ++j) { const int n = (lane >> 2) + 16 * j; const LAS float* sp = scr + (16 * c) * 33 + n;
        u32x4 o; o.x = cvt4_fp8(sp[0 * 33], sp[1 * 33], sp[2 * 33], sp[3 * 33]); o.y = cvt4_fp8(sp[4 * 33], sp[5 * 33], sp[6 * 33], sp[7 * 33]);
        o.z = cvt4_fp8(sp[8 * 33], sp[9 * 33], sp[10 * 33], sp[11 * 33]); o.w = cvt4_fp8(sp[12 * 33], sp[13 * 33], sp[14 * 33], sp[15 * 33]);
        const int ng = n0 + n; const int dr = rowmap == 0 ? ng : (8 * (ng >> 2) + (ng & 3) + (rowmap == 2 ? 4 : 0));
        *(u32x4*)(WT + (size_t)dr * K + k0 + 16 * c) = o; }
    LDS_WAIT(); asm volatile("" ::: "memory");
}
__device__ __forceinline__ void norm_row_to_bf16(const float* xrow, bf16_t* orow, float* rinv, int lane) {
    const f32x4* xr = (const f32x4*)xrow + lane;
    f32x4 v[8]; float s = 0.f;
#pragma unroll
    for (int j = 0; j < 8; ++j) { v[j] = xr[64 * j]; s += (v[j].x * v[j].x + v[j].y * v[j].y) + (v[j].z * v[j].z + v[j].w * v[j].w); }
    const float rms = sqrtf(wave_sum(s) * (1.f / DM) + RMS_EPS), rstd = 1.0f / rms;
    if (lane == 0) *rinv = rms;
    u32x2* o8 = (u32x2*)orow + lane;
#pragma unroll
    for (int j = 0; j < 8; ++j) { u32x2 w; w.x = cvt_pk_bf16(v[j].x * rstd, v[j].y * rstd); w.y = cvt_pk_bf16(v[j].z * rstd, v[j].w * rstd); o8[64 * j] = w; }
}
__device__ __forceinline__ void norm_rows2_to_bf16(const float* xrow, bf16_t* orow, float* rinv, int lane) {
    const f32x4* xr = (const f32x4*)xrow + lane;
    f32x4 v[16]; float s0 = 0.f, s1 = 0.f;
#pragma unroll
    for (int j = 0; j < 16; ++j) v[j] = xr[64 * j];
#pragma unroll
    for (int j = 0; j < 8; ++j) { s0 += (v[j].x * v[j].x + v[j].y * v[j].y) + (v[j].z * v[j].z + v[j].w * v[j].w); s1 += (v[8 + j].x * v[8 + j].x + v[8 + j].y * v[8 + j].y) + (v[8 + j].z * v[8 + j].z + v[8 + j].w * v[8 + j].w); }
    const float q0 = sqrtf(wave_sum(s0) * (1.f / DM) + RMS_EPS), q1 = sqrtf(wave_sum(s1) * (1.f / DM) + RMS_EPS), r0 = 1.0f / q0, r1 = 1.0f / q1;
    if (lane == 0) { rinv[0] = q0; rinv[1] = q1; }
    u32x2* o8 = (u32x2*)orow + lane;
#pragma unroll
    for (int j = 0; j < 16; ++j) { const float r = j < 8 ? r0 : r1; u32x2 w; w.x = cvt_pk_bf16(v[j].x * r, v[j].y * r); w.y = cvt_pk_bf16(v[j].z * r, v[j].w * r); o8[64 * j] = w; }
}
__device__ __forceinline__ void p0_prologue(Frame& F, const Params& p) {
    PHASE_IDS();
    LAS float* scr = (LAS float*)(F.lds + wid * 16384);
    const int gw = F.bid * 8 + wid, NGW = F.G * 8;
    constexpr int I_IN = 32 * 160, I_OUT = 32 * 64, I_GU = 32 * 16, I_D = 8 * 64, I_G = 2 * 4;
    constexpr int N_IN = 2 * I_IN, N_OUT = 2 * I_OUT, N_GU = 2 * 16 * 2 * I_GU, N_D = 2 * 16 * I_D, N_G = 2 * 2 * 8 * I_G;
    constexpr int NITEMS = N_IN + N_OUT + N_GU + N_D + N_G;
    unsigned char* ws = F.ws;
    for (int it = gw; it < NITEMS; it += NGW) {
        int r = it;
        if (r < N_IN) { const int l = r / I_IN; tr_item(p.in[3] + (size_t)l * DM * NPROJ, DM, NPROJ, (bf16_t*)(ws + WS_WIN) + (size_t)l * NPROJ * DM, r % I_IN, scr, lane, p.in[2] + l * DM, 1, 0); continue; } r -= N_IN;
        if (r < N_OUT) { const int l = r / I_OUT; tr_item(p.in[16] + (size_t)l * DM * DM, DM, DM, (bf16_t*)(ws + WS_WOUT) + (size_t)l * DM * DM, r % I_OUT, scr, lane, nullptr, 0, 0); continue; } r -= N_OUT;
        if (r < N_GU) { const int le = r / (2 * I_GU), rr = r % (2 * I_GU), which = rr / I_GU; const int l = le >> 4;
            tr_item8(p.in[which ? 23 : 22] + (size_t)le * DM * DEXP, DM, DEXP, (unsigned char*)(ws + WS_WGU) + (size_t)le * 1024 * DM, rr % I_GU, scr, lane, p.in[17] + l * DM, which ? 2 : 1); continue; } r -= N_GU;
        if (r < N_D) { const int le = r / I_D; tr_item8(p.in[24] + (size_t)le * DEXP * DM, DEXP, DM, (unsigned char*)(ws + WS_WD) + (size_t)le * DM * DEXP, r % I_D, scr, lane, nullptr, 0); continue; } r -= N_D;
        { const int mi = r / I_G; const int l = mi >> 4, which = (mi >> 3) & 1, g = mi & 7;
          tr_item(p.in[which ? 8 : 6] + (size_t)(l * 8 + g) * 128 * 128, 128, 128, (bf16_t*)(ws + WS_WGATES) + (size_t)((l * 2 + which) * 8 + g) * 128 * 128, r % I_G, scr, lane, nullptr, 0, 0); }
    }
    bf16_t* wr = (bf16_t*)(ws + WS_WR);
    for (int i = F.bid * 512 + tid; i < 2 * 32 * DM; i += F.G * 512) { const int l = i / (32 * DM), o = (i / DM) % 32, k = i % DM;
        const float w0 = o < 4 ? p.in[18][((size_t)l * DM + k) * 4 + o] : o < 20 ? p.in[20][((size_t)l * DM + k) * 16 + (o - 4)] : 0.f;
        const float w = w0 * p.in[17][l * DM + k];
        const unsigned hb_ = cvt_pk_bf16(w, 0.f) & 0xffffu; const float whi = __uint_as_float(hb_ << 16);
        wr[((size_t)(l * 2 + 0) * 32 + o) * DM + k] = (bf16_t)hb_; wr[((size_t)(l * 2 + 1) * 32 + o) * DM + k] = (bf16_t)(cvt_pk_bf16(w - whi, 0.f) & 0xffffu); }
    { float* pb = (float*)(ws + WS_PB);
      for (int i = F.bid * 512 + tid; i < 2 * PBL + DM; i += F.G * 512) {
          if (i >= 2 * PBL) { pb[i] = p.in[25][i - 2 * PBL]; continue; }
          const int l = i / PBL, o = i % PBL; float v = 0.f;
          if (o < PB_CB) v = p.in[4][l * 4096 + o];
          else if (o < PB_BA) v = p.in[5][l * LRUW + o - PB_CB];
          else if (o < PB_BX) v = p.in[7][l * LRUW + o - PB_BA];
          else if (o < PB_SP8) v = p.in[9][l * LRUW + o - PB_BX];
          else if (o < PB_SUBG) v = -8.0f * log1pf(__expf(-p.in[10][l * LRUW + o - PB_SP8]));
          else if (o < PB_RGB) v = p.in[15][l * 128 + o - PB_SUBG];
          else if (o < PB_REB) v = p.in[19][l * 4 + o - PB_RGB];
          else if (o < PB_REB + 16) v = p.in[21][l * 16 + o - PB_REB];
          else if (o == PB_LAM || o == PB_LAM + 1) continue;
          pb[i] = v; }
      if (F.bid == 0 && wid < DEPTH) {
          const int l = wid; const float s1 = wave_sum(p.in[11][l * 64 + lane] * p.in[12][l * 64 + lane]), s2 = wave_sum(p.in[13][l * 64 + lane] * p.in[14][l * 64 + lane]);
          const float lam_init = 0.8f - 0.6f * expf(-0.3f * (float)l);
          if (lane == 0) { pb[l * PBL + PB_LAM] = expf(s1) - expf(s2) + lam_init; pb[l * PBL + PB_LAM + 1] = lam_init; } } }
    bf16_t* xn = (bf16_t*)(ws + WS_XN);
    for (int m = 2 * gw; m < NREAL; m += 2 * NGW) norm_rows2_to_bf16(p.in[0] + (size_t)m * DM, xn + (size_t)m * DM, (float*)(ws + WS_RINV) + m, lane);
    for (int m = NREAL + gw; m < RPAD; m += NGW) {
        if (m < NTOK) norm_row_to_bf16(p.in[1] + (size_t)((m - NREAL) & 15) * DM, xn + (size_t)m * DM, (float*)(ws + WS_RINV) + m, lane);
        else { u32x4* o = (u32x4*)(xn + (size_t)m * DM) + lane;
#pragma unroll
            for (int j = 0; j < 4; ++j) o[64 * j] = (u32x4){0u, 0u, 0u, 0u}; }
    }
}

__device__ __forceinline__ float sigmoidf_(float x) { return __builtin_amdgcn_rcpf(1.0f + __builtin_amdgcn_exp2f(-LOG2E * x)); }
__device__ __forceinline__ float gelu_tanh(float x) { const float z = 0.7978845608028654f * (x + 0.044715f * x * x * x); return x * sigmoidf_(2.0f * z); }
__device__ __forceinline__ float one_minus_exp(float x) {
    const float ser = -x * (1.0f + x * (0.5f + x * (0.16666667f + x * (0.041666668f + x * 0.0083333338f))));
    const float dir = 1.0f - __builtin_amdgcn_exp2f(LOG2E * x);
    return x > -0.25f ? ser : dir;
}
constexpr int LRU_XCB = 0;
constexpr int LRU_AS = 17408;
constexpr int LRU_BS = LRU_AS + 32768;
constexpr int LRU_XC = LRU_BS + 32768;
constexpr int LRU_SEG = LRU_XC + 32768;
template <int PASS>
__device__ __forceinline__ void lru_unit(Frame& F, const Params& p, int l, int unit) {
    const int b = unit >> 7, g = (unit >> 4) & 7, st = unit & 15;
    PHASE_IDS(); const int hi = lane >> 5, r32 = lane & 31;
    const bf16_t* proj = (const bf16_t*)(F.ws + WS_PROJ);
    bf16_t* mix = (bf16_t*)(F.ws + WS_MIX);
    float* lsum = (float*)(F.ws + WS_LRUSUM);
    LAS unsigned char* L = F.lds;
    const int cc = tid & 63, rg = wid;
    const float* pbl = (const float*)(F.ws + WS_PB) + l * PBL;
    const float* cw = pbl + PB_CW + g * 128 + 2 * cc; const float* cbp = pbl + PB_CB + g * 128 + 2 * cc;
    const f32x2 w0 = *(const f32x2*)(cw), w1 = *(const f32x2*)(cw + LRUW), w2 = *(const f32x2*)(cw + 2 * LRUW), w3 = *(const f32x2*)(cw + 3 * LRUW), cb = *(const f32x2*)cbp;
    const int tm = wid >> 2, tn = wid & 3; const int chl = tn * 32 + r32, chg = g * 128 + chl;
    const bf16_t* wat = (const bf16_t*)(F.ws + WS_WGATES) + (size_t)((l * 2 + 0) * 8 + g) * 128 * 128 + (size_t)chl * 128 + 8 * hi;
    const bf16_t* wxt = (const bf16_t*)(F.ws + WS_WGATES) + (size_t)((l * 2 + 1) * 8 + g) * 128 * 128 + (size_t)chl * 128 + 8 * hi;
    bf16x8 waf[8], wxf[8];
#pragma unroll
    for (int s = 0; s < 8; ++s) { waf[s] = *(const bf16x8*)(wat + 16 * s); wxf[s] = *(const bf16x8*)(wxt + 16 * s); }
    const float ba = pbl[PB_BA + chg], bx = pbl[PB_BX + chg];
    const float sp8 = pbl[PB_SP8 + chg];
    const int sc = tid & 127, sg = tid >> 7; const int scg = g * 128 + sc;
    float hstate = 0.f, pstate = 1.f;
    if (PASS == 2) {
#pragma unroll 1
        for (int s0 = 0; s0 < st; s0 += 8) { f32x2 ph[8];
#pragma unroll
            for (int j = 0; j < 8; ++j) ph[j] = *(const f32x2*)(lsum + ((size_t)(b * 16 + (s0 + j < st ? s0 + j : 0)) * LRUW + scg) * 2);
#pragma unroll
            for (int j = 0; j < 8; ++j) asm volatile("" : "+v"(ph[j]));
#pragma unroll
            for (int j = 0; j < 8; ++j) if (s0 + j < st) hstate = ph[j].x * hstate + ph[j].y; } }
    const int ntile = st == 0 ? 17 : 16;
    auto tile_pos0 = [&](int i) { return st == 0 ? (i == 0 ? 0 : NMETA + 64 * (i - 1)) : NMETA + 1024 * st + 64 * i; };
    auto load_u = [&](unsigned (&uu)[11], int i) {
        const int pos0 = tile_pos0(i), nv = (st == 0 && i == 0) ? 16 : 64;
#pragma unroll
        for (int k = 0; k < 11; ++k) { const int pos = pos0 + 8 * rg + k - 3;
            uu[k] = *(const unsigned*)(proj + (size_t)tok_row(b, pos < 0 ? 0 : pos) * NPROJ + OFF_U + g * 128 + 2 * cc); }
#pragma unroll
        for (int k = 0; k < 11; ++k) asm volatile("" : "+v"(uu[k]));
#pragma unroll
        for (int k = 0; k < 11; ++k) { const int rr = 8 * rg + k - 3; if (!(pos0 + rr >= 0 && rr < nv)) uu[k] = 0u; }
    };
    unsigned ucur[11]; load_u(ucur, 0);
#define LT(k) do { } while (0)
    for (int i = 0; i < ntile; ++i) {
        LT(0);
        const int pos0 = tile_pos0(i), nvalid = (st == 0 && i == 0) ? 16 : 64;
        unsigned short ygv[16];
        if (PASS == 2) {
#pragma unroll
            for (int k = 0; k < 16; ++k) { const int tt = 16 * sg + k; ygv[k] = proj[(size_t)tok_row(b, pos0 + tt) * NPROJ + OFF_YG + scg]; }
        }
        {
            float ux[11], uy[11];
#pragma unroll
            for (int k = 0; k < 11; ++k) { ux[k] = bf_lo(ucur[k]); uy[k] = bf_hi(ucur[k]); }
#pragma unroll
            for (int k = 0; k < 8; ++k) { const int rr = 8 * rg + k;
                const float xa = cb.x + w0.x * ux[k + 3] + w1.x * ux[k + 2] + w2.x * ux[k + 1] + w3.x * ux[k];
                const float xb = cb.y + w0.y * uy[k + 3] + w1.y * uy[k + 2] + w2.y * uy[k + 1] + w3.y * uy[k];
                *(LAS unsigned*)(L + LRU_XCB + rr * 272 + 4 * cc) = cvt_pk_bf16(xa, xb);
                *(LAS f32x2*)(L + LRU_XC + rr * 512 + 8 * cc) = (f32x2){xa, xb}; }
        }
        if (i + 1 < ntile) load_u(ucur, i + 1);
        LDS_BARRIER(); LT(1);
        {
            f32x16 aa = {}, ax = {};
#pragma unroll
            for (int s = 0; s < 8; ++s) { const bf16x8 af = *(const LAS bf16x8*)(L + LRU_XCB + (32 * tm + r32) * 272 + 32 * s + 16 * hi);
                aa = __builtin_amdgcn_mfma_f32_32x32x16_bf16(af, waf[s], aa, 0, 0, 0); ax = __builtin_amdgcn_mfma_f32_32x32x16_bf16(af, wxf[s], ax, 0, 0, 0); }
#pragma unroll
            for (int r = 0; r < 16; ++r) { const int tt = 32 * tm + crow(r, hi);
                const float ra = sigmoidf_(aa[r] + ba), ix = sigmoidf_(ax[r] + bx);
                const float xcv = *(const LAS float*)(L + LRU_XC + tt * 512 + 4 * chl);
                const float la = sp8 * ra; float a = __builtin_amdgcn_exp2f(LOG2E * la);
                float bb = __builtin_amdgcn_sqrtf(1.0f - __builtin_amdgcn_exp2f((2.0f * LOG2E) * la)) * (ix * xcv);
                if (nvalid < 64 && tt >= nvalid) { a = 1.f; bb = 0.f; }
                *(LAS float*)(L + LRU_AS + tt * 512 + 4 * chl) = a; *(LAS float*)(L + LRU_BS + tt * 512 + 4 * chl) = bb; }
        }
        LDS_BARRIER(); LT(2);
        float H = 0.f, P = 1.f;
#pragma unroll
        for (int k = 0; k < 16; ++k) { const int tt = 16 * sg + k; const float a = *(const LAS float*)(L + LRU_AS + tt * 512 + 4 * sc), bb = *(const LAS float*)(L + LRU_BS + tt * 512 + 4 * sc);
            H = a * H + bb; P *= a; }
        *(LAS f32x2*)(L + LRU_SEG + (sg * 128 + sc) * 8) = (f32x2){P, H};
        LDS_BARRIER(); LT(3);
        float cin = hstate;
#pragma unroll
        for (int s2 = 0; s2 < 4; ++s2) { const f32x2 ph = *(const LAS f32x2*)(L + LRU_SEG + (s2 * 128 + sc) * 8);
            if (s2 < sg) cin = ph.x * cin + ph.y;
            hstate = ph.x * hstate + ph.y; pstate *= ph.x; }
        if (PASS == 2) {
#pragma unroll
            for (int k = 0; k < 16; ++k) { const int tt = 16 * sg + k;
                const float a = *(const LAS float*)(L + LRU_AS + tt * 512 + 4 * sc), bb = *(const LAS float*)(L + LRU_BS + tt * 512 + 4 * sc);
                cin = a * cin + bb;
                if (tt < nvalid) { const float hv = cin; const float y = __uint_as_float((unsigned)ygv[k] << 16);
                    const float o = hv * gelu_tanh(y); mix[(size_t)tok_row(b, pos0 + tt) * DM + scg] = (bf16_t)(cvt_pk_bf16(o, 0.f) & 0xffffu); } }
        }
    }
#undef LT
    if (PASS == 1 && sg == 0) *(f32x2*)(lsum + ((size_t)(b * 16 + st) * LRUW + scg) * 2) = (f32x2){pstate, hstate};
    __syncthreads();
}


__device__ __forceinline__ void kmax_phase(Frame& F, int l) {
    PHASE_IDS();
    const bf16_t* proj = (const bf16_t*)(F.ws + WS_PROJ);
    const int gw = F.bid * 8 + wid, NGW = F.G * 8;
    for (int b = 0; b < BATCH; ++b) {
        float mx = 0.f;
        for (int i0 = gw; i0 < TLEN; i0 += 4 * NGW) {
            u32x4 a[4], c[4];
#pragma unroll
            for (int u = 0; u < 4; ++u) { const int i = min(i0 + u * NGW, TLEN - 1); const u32x4* kp = (const u32x4*)(proj + (size_t)tok_row(b, i) * NPROJ + OFF_K + lane * 16); a[u] = kp[0]; c[u] = kp[1]; }
#pragma unroll
            for (int u = 0; u < 4; ++u) { float s = 0.f;
#pragma unroll
                for (int j = 0; j < 4; ++j) { const unsigned x = a[u][j], y = c[u][j]; s += bf_lo(x) * bf_lo(x) + bf_hi(x) * bf_hi(x) + bf_lo(y) * bf_lo(y) + bf_hi(y) * bf_hi(y); }
                s += shx1(s); s += shx2(s);
                mx = fmaxf(mx, s); }
        }
        if ((lane & 3) == 0) atomicMax(F.ctl + CW_KMAX + l * 64 + b * 16 + (lane >> 2), __float_as_uint(mx));
    }
}
constexpr int AT_KSTR = 144, AT_VSTR = 320;
constexpr float ATT_THRESH = 24.0f;
constexpr int AD_K1 = 0, AD_K2 = 8192, AD_V = 16384, AD_SUB = 32768, AD_STAGE = 65536;
constexpr int AT_EX = 0, AT_OS = 65536, AT_OSTR = 272;
static_assert(2 * AD_STAGE <= RING_BYTES && AT_OS + 128 * AT_OSTR <= RING_BYTES, "attention LDS");
__device__ __forceinline__ s16x4 ds_tr16(const LAS unsigned char* p) { typedef short v4i16_t __attribute__((ext_vector_type(4))); return __builtin_bit_cast(s16x4, __builtin_amdgcn_ds_read_tr16_b64_v4i16((LAS v4i16_t*)p)); }

__device__ __forceinline__ void attn_unit(Frame& F, const Params& p, int l, int b, int h, int qb) {
    PHASE_IDS(); const int hi = lane >> 5, r32 = lane & 31, map = wid >> 2, qs = wid & 3;
    const bf16_t* proj = (const bf16_t*)(F.ws + WS_PROJ);
    bf16_t* mix = (bf16_t*)(F.ws + WS_MIX);
    LAS unsigned char* L = F.lds;
    const float slope2 = exp2f(-(float)(h + 1)) * LOG2E;
    const int qi = qs * 32 + r32;
    int qrow, qpos; if (qb >= 0) { qrow = b * SEQ + 128 * qb + qi; qpos = NMETA + 128 * qb + qi; } else { qrow = NREAL + b * NMETA + (qi & 15); qpos = qi & 15; }
    bf16x8 qf[4];
#pragma unroll
    for (int s = 0; s < 4; ++s) qf[s] = *(const bf16x8*)(proj + (size_t)qrow * NPROJ + OFF_Q + h * 128 + map * 64 + 16 * s + 8 * hi);
    const int nreal = qb >= 0 ? 2 * qb + 2 : 0, ntile = nreal + 1;
    float qbound;
    { float s = 0.f;
#pragma unroll
      for (int ss = 0; ss < 4; ++ss)
#pragma unroll
          for (int j = 0; j < 8; ++j) { const float v = __uint_as_float(((unsigned)(unsigned short)qf[ss][j]) << 16); s += v * v; }
      s = sum32(s);
      const float kmx = __uint_as_float(xb_ld(F.ctl + CW_KMAX + l * 64 + b * 16 + h * 2 + map));
      qbound = sqrtf(s * kmx) * 1.0001f + 1e-3f; }
    volatile LAS unsigned* DW = F.LC + 112;
    if (lane == 0) DW[wid] = 0x7fffffffu;
    bool wdone = false;
    const int dk_row = 8 * wid + (lane >> 3), dk_ch = (lane & 7) ^ ((dk_row >> 1) & 7);
    const int dv_row0 = 4 * wid + (lane >> 4), dv_ch = (lane & 15) ^ (4 * (dv_row0 & 3));
    auto dma_tile = [&](int kt, int boff) {
        const int r0 = kt >= 0 ? b * SEQ + 64 * kt : NREAL + b * NMETA;
        const bf16_t* rk = proj + (size_t)(kt >= 0 ? r0 + dk_row : r0 + (dk_row & 15)) * NPROJ + OFF_K + h * 128 + dk_ch * 8;
        const bf16_t* rv0 = proj + (size_t)(kt >= 0 ? r0 + dv_row0 : r0 + (dv_row0 & 15)) * NPROJ + OFF_V + h * 128 + dv_ch * 8;
        const bf16_t* rv1 = proj + (size_t)(kt >= 0 ? r0 + dv_row0 + 32 : r0 + (dv_row0 & 15)) * NPROJ + OFF_V + h * 128 + dv_ch * 8;
        LAS unsigned char* Bd = L + boff;
        __builtin_amdgcn_global_load_lds((const unsigned*)rk, (LAS unsigned*)(Bd + AD_K1 + wid * 1024), 16, 0, 0);
        __builtin_amdgcn_global_load_lds((const unsigned*)(rk + 64), (LAS unsigned*)(Bd + AD_K2 + wid * 1024), 16, 0, 0);
        __builtin_amdgcn_global_load_lds((const unsigned*)rv0, (LAS unsigned*)(Bd + AD_V + wid * 1024), 16, 0, 0);
        __builtin_amdgcn_global_load_lds((const unsigned*)rv1, (LAS unsigned*)(Bd + AD_V + 8192 + wid * 1024), 16, 0, 0);
    };
    const int npair = qb >= 0 ? qb + 1 : 0, niter = npair + 1;
    auto dma_iter = [&](int it, int stage) { if (it < npair) { dma_tile(2 * (npair - 1 - it) + 1, stage); dma_tile(2 * (npair - 1 - it), stage + AD_SUB); } else dma_tile(-1, stage); };
    float m_run = -1e30f, l_run = 0.f;
    f32x16 O[4]; O[0] = f32x16{}; O[1] = f32x16{}; O[2] = f32x16{}; O[3] = f32x16{};
    f32x16 CB;
#pragma unroll
    for (int r = 0; r < 16; ++r) CB[r] = slope2 * (float)((r & 3) + 8 * (r >> 2));
    const f32x16 Z16 = {};
    const int vq = (lane & 15) >> 2, vp = lane & 3, vblk = (lane >> 4) & 1;
    const int vrow_off = (4 * hi + vq) * 256 + 32 * vblk + 8 * vp;
    const int kswz = (r32 >> 1) & 7;
    const int diag_kt = 2 * qb + (qs >> 1);
    bf16x8 pk[4];
#define AT_VRD2(dst, g_) do { _Pragma("unroll") for (int j_ = 0; j_ < 2; ++j_) { const int c_ = 2 * ((g_) & 1) + j_; \
            const s16x4 t0_ = ds_tr16(Vb_ + (16 * ((g_) >> 1)) * 256 + 64 * (c_ ^ vq)), t1_ = ds_tr16(Vb_ + (16 * ((g_) >> 1) + 8) * 256 + 64 * (c_ ^ vq)); \
            dst[j_] = (bf16x8){t0_[0], t0_[1], t0_[2], t0_[3], t1_[0], t1_[1], t1_[2], t1_[3]}; } } while (0)
#define AT_VMM(src, g_) do { O[2 * ((g_) & 1)] = __builtin_amdgcn_mfma_f32_32x32x16_bf16(src[0], pk[(g_) >> 1], O[2 * ((g_) & 1)], 0, 0, 0); \
            O[2 * ((g_) & 1) + 1] = __builtin_amdgcn_mfma_f32_32x32x16_bf16(src[1], pk[(g_) >> 1], O[2 * ((g_) & 1) + 1], 0, 0, 0); __builtin_amdgcn_sched_barrier(0); } while (0)
#define AT_WAIT_BAR() do { asm volatile("s_waitcnt vmcnt(0) lgkmcnt(0)" ::: "memory"); __builtin_amdgcn_s_barrier(); asm volatile("" ::: "memory"); } while (0)
    auto tile = [&](int kt, int boff) {
        const bool is_meta = kt < 0;
        const bool vis = (is_meta || (kt <= diag_kt)) && !wdone;
        if (vis) {
            const bool general = is_meta || (kt == diag_kt);
            f32x16 S0 = general ? Z16 : CB, S1 = S0;
            { const LAS unsigned char* Kb = L + boff + (map ? AD_K2 : AD_K1) + r32 * 128; bf16x8 ka[2], kb[2];
#define AT_KRD(dst, s_) do { dst[0] = *(const LAS bf16x8*)(Kb + 16 * ((2 * (s_) + hi) ^ kswz)); dst[1] = *(const LAS bf16x8*)(Kb + 32 * 128 + 16 * ((2 * (s_) + hi) ^ kswz)); } while (0)
#define AT_KMM(src, s_) do { S0 = __builtin_amdgcn_mfma_f32_32x32x16_bf16(src[0], qf[s_], S0, 0, 0, 0); S1 = __builtin_amdgcn_mfma_f32_32x32x16_bf16(src[1], qf[s_], S1, 0, 0, 0); __builtin_amdgcn_sched_barrier(0); } while (0)
              AT_KRD(ka, 0); AT_KRD(kb, 1); __builtin_amdgcn_sched_barrier(0);
              AT_KMM(ka, 0); AT_KRD(ka, 2); __builtin_amdgcn_sched_barrier(0);
              AT_KMM(kb, 1); AT_KRD(kb, 3); __builtin_amdgcn_sched_barrier(0);
              AT_KMM(ka, 2); AT_KMM(kb, 3);
#undef AT_KRD
#undef AT_KMM
            }
            float c0, c1;
            if (general) {
                const float kpos0 = is_meta ? 0.f : (float)(NMETA + 64 * kt);
                const float dq = (float)qpos - kpos0 - (float)(4 * hi);
#pragma unroll
                for (int r = 0; r < 16; ++r) { const float kc = (float)((r & 3) + 8 * (r >> 2));
                    S0[r] = S0[r] - slope2 * fabsf(dq - kc); S1[r] = S1[r] - slope2 * fabsf(dq - kc - 32.f);
                    if (is_meta) { if (r >= 8) S0[r] = -1e30f; S1[r] = -1e30f; } }
                c0 = 0.f; c1 = 0.f;
            } else {
                c0 = slope2 * (float)(NMETA + 64 * kt + 4 * hi - qpos); c1 = c0 + 32.f * slope2;
            }
            bool skip = false;
            { float mA, mB;
              asm("v_max3_f32 %0, %1, %2, %3" : "=v"(mA) : "v"(S0[0]), "v"(S0[1]), "v"(S0[2])); asm("v_max3_f32 %0, %1, %2, %3" : "=v"(mB) : "v"(S1[0]), "v"(S1[1]), "v"(S1[2]));
#pragma unroll
              for (int r = 3; r < 15; r += 2) { asm("v_max3_f32 %0, %1, %2, %3" : "=v"(mA) : "v"(mA), "v"(S0[r]), "v"(S0[r + 1])); asm("v_max3_f32 %0, %1, %2, %3" : "=v"(mB) : "v"(mB), "v"(S1[r]), "v"(S1[r + 1])); }
              mA = fmaxf(mA, S0[15]); mB = fmaxf(mB, S1[15]);
              float mt = fmaxf(mA + c0, mB + c1);
              if (!general && __all(mt < m_run - ATT_THRESH)) skip = true;
              else {
                mt = max32(mt);
                if (__any(mt > m_run + 8.0f)) {
                    const float m_new = fmaxf(m_run, mt);
                    const float alpha = __builtin_amdgcn_exp2f(m_run - m_new);
                    m_run = m_new; l_run *= alpha;
#pragma unroll
                    for (int c = 0; c < 4; ++c) O[c] *= alpha;
                }
              } }
            if (!skip) {
            const float e0 = c0 - m_run, e1 = c1 - m_run;
            float ps0 = 0.f, ps1 = 0.f;
#pragma unroll
            for (int r = 0; r < 16; ++r) { S0[r] = __builtin_amdgcn_exp2f(S0[r] + e0); S1[r] = __builtin_amdgcn_exp2f(S1[r] + e1); ps0 += S0[r]; ps1 += S1[r]; }
            l_run += ps0 + ps1;
#pragma unroll
            for (int s2 = 0; s2 < 2; ++s2) {
                u32x4 w0, w1;
                w0.x = cvt_pk_bf16(S0[8 * s2 + 0], S0[8 * s2 + 1]); w0.y = cvt_pk_bf16(S0[8 * s2 + 2], S0[8 * s2 + 3]); w0.z = cvt_pk_bf16(S0[8 * s2 + 4], S0[8 * s2 + 5]); w0.w = cvt_pk_bf16(S0[8 * s2 + 6], S0[8 * s2 + 7]);
                w1.x = cvt_pk_bf16(S1[8 * s2 + 0], S1[8 * s2 + 1]); w1.y = cvt_pk_bf16(S1[8 * s2 + 2], S1[8 * s2 + 3]); w1.z = cvt_pk_bf16(S1[8 * s2 + 4], S1[8 * s2 + 5]); w1.w = cvt_pk_bf16(S1[8 * s2 + 6], S1[8 * s2 + 7]);
                pk[s2] = __builtin_bit_cast(bf16x8, w0); pk[2 + s2] = __builtin_bit_cast(bf16x8, w1);
            }
            __builtin_amdgcn_sched_barrier(0);
            { const LAS unsigned char* Vb_ = L + boff + AD_V + vrow_off; bf16x8 va_[2], vb_[2], vc_[2];
              AT_VRD2(va_, 0); AT_VRD2(vb_, 1); __builtin_amdgcn_sched_barrier(0);
              AT_VRD2(vc_, 2); __builtin_amdgcn_sched_barrier(0); AT_VMM(va_, 0);
              AT_VRD2(va_, 3); __builtin_amdgcn_sched_barrier(0); AT_VMM(vb_, 1);
              AT_VRD2(vb_, 4); __builtin_amdgcn_sched_barrier(0); AT_VMM(vc_, 2);
              AT_VRD2(vc_, 5); __builtin_amdgcn_sched_barrier(0); AT_VMM(va_, 3);
              AT_VRD2(va_, 6); __builtin_amdgcn_sched_barrier(0); AT_VMM(vb_, 4);
              AT_VRD2(vb_, 7); __builtin_amdgcn_sched_barrier(0); AT_VMM(vc_, 5);
              AT_VMM(va_, 6); AT_VMM(vb_, 7); }
            }
        }
        if (!wdone && !is_meta) {
            const float dmin = (float)(qpos - (NMETA + 64 * kt) + 1);
            const bool c = qbound - slope2 * dmin < m_run - ATT_THRESH;
            if (__all(c)) wdone = true;
        }
    };
    asm volatile("s_waitcnt vmcnt(0)" ::: "memory");
    dma_iter(0, 0);
    AT_WAIT_BAR();
    int stage = 0;
    for (int it = 0; it < niter; ++it) {
        if (it + 1 < niter) dma_iter(it + 1, stage ^ AD_STAGE);
        { const int nsub = it < npair ? 2 : 1, kt0 = it < npair ? 2 * (npair - 1 - it) + 1 : -1;
#pragma unroll 1
          for (int sub = 0; sub < nsub; ++sub) { tile(kt0 - sub, stage + sub * AD_SUB); __builtin_amdgcn_sched_barrier(0); } }
        if (wdone && lane == 0 && DW[wid] == 0x7fffffffu) DW[wid] = (unsigned)it;
        stage ^= AD_STAGE;
        AT_WAIT_BAR();
        { const u32x4 d0 = *(const LAS u32x4*)(F.lds + LCTL_OFF + 112 * 4), d1 = *(const LAS u32x4*)(F.lds + LCTL_OFF + 116 * 4);
          const unsigned dm = max(max(max(d0.x, d0.y), max(d0.z, d0.w)), max(max(d1.x, d1.y), max(d1.z, d1.w)));
          if (dm <= (unsigned)it) break; }
    }
#undef AT_VRD2
#undef AT_VMM
#undef AT_WAIT_BAR
    __syncthreads();
    const float lt = sum32(l_run);
    const float inv = 1.0f / lt;
    if (map == 1) {
#pragma unroll
        for (int c = 0; c < 4; ++c)
#pragma unroll
            for (int r = 0; r < 16; ++r) *(LAS float*)(L + AT_EX + ((32 * c + crow(r, hi)) * 128 + qi) * 4) = O[c][r] * inv;
    }
    __syncthreads();
    if (map == 0) {
        const float* pbl = (const float*)(F.ws + WS_PB) + l * PBL;
        const float lam = pbl[PB_LAM], lam_init = pbl[PB_LAM + 1];
        float ss = 0.f;
#pragma unroll
        for (int c = 0; c < 4; ++c)
#pragma unroll
            for (int r = 0; r < 16; ++r) { const float o2 = *(const LAS float*)(L + AT_EX + ((32 * c + crow(r, hi)) * 128 + qi) * 4); const float o = O[c][r] * inv - lam * o2; O[c][r] = o; ss += o * o; }
        ss = sum32(ss);
        const float rn = (1.0f / sqrtf(ss * (1.f / 128.f) + RMS_EPS)) * (1.0f - lam_init);
#pragma unroll
        for (int c = 0; c < 4; ++c)
#pragma unroll
            for (int r = 0; r < 16; r += 2) { const int dv = 32 * c + crow(r, hi);
                const float g0 = pbl[PB_SUBG + dv], g1 = pbl[PB_SUBG + dv + 1];
                *(LAS unsigned*)(L + AT_OS + qi * AT_OSTR + dv * 2) = cvt_pk_bf16(O[c][r] * rn * g0, O[c][r + 1] * rn * g1); }
    }
    __syncthreads();
#pragma unroll
    for (int i = 0; i < 4; ++i) { const int idx = tid + 512 * i, row = idx >> 4, ch = idx & 15;
        const bool ok = qb >= 0 || row < 16;
        if (ok) { const int orow = qb >= 0 ? b * SEQ + 128 * qb + row : NREAL + b * NMETA + row;
            *(u32x4*)(mix + (size_t)orow * DM + LRUW + h * 128 + ch * 8) = *(const LAS u32x4*)(L + AT_OS + row * AT_OSTR + ch * 16); } }
    __syncthreads();
}


constexpr int NT32 = (NTOK + 31) / 32;
constexpr int RT_PART = 0;
constexpr int RT_SSQ = 2 * 4 * 32 * 33 * 4;
__device__ __forceinline__ void router_phase(Frame& F, const Params& p, int l) {
    const bool count = true;
    PHASE_IDS(); const int hi = lane >> 5, r32 = lane & 31;
    const int ntile_b = F.bid < NT32 ? (NT32 - F.bid + F.G - 1) / F.G : 0;
    volatile LAS unsigned* hist = F.LC + 16;
    if (tid < 16) hist[tid] = 0u;
    __syncthreads();
    const bf16_t* wrh = (const bf16_t*)(F.ws + WS_WR) + (size_t)(l * 2) * 32 * DM; const bf16_t* wrl = wrh + (size_t)32 * DM;
    const bf16_t* hbp = (const bf16_t*)(F.ws + WS_XN);
    const float* rgb = (const float*)(F.ws + WS_PB) + l * PBL + PB_RGB; const float* reb = (const float*)(F.ws + WS_PB) + l * PBL + PB_REB;
    u32x4* tokinfo = (u32x4*)(F.ws + WS_TOKINFO);
    LAS float* part = (LAS float*)(F.lds + RT_PART); LAS float* ssqp = (LAS float*)(F.lds + RT_SSQ);
    for (int k0 = 0; k0 < ntile_b; k0 += 4) {
        const bool lone = (ntile_b - k0 == 1);
        const int ts = lone ? 0 : (wid & 3), ksl = lone ? wid : (wid >> 2), klen = lone ? 256 : 1024;
        if (k0 + ts < ntile_b) {
            int row = 32 * (F.bid + F.G * (k0 + ts)) + r32; row = row < NTOK ? row : NTOK - 1;
            const bf16_t* hp = hbp + (size_t)row * DM + ksl * klen + 8 * hi;
            const bf16_t* wph = wrh + (size_t)r32 * DM + ksl * klen + 8 * hi; const bf16_t* wpl = wrl + (size_t)r32 * DM + ksl * klen + 8 * hi;
            f32x16 acc = {}; float ssq = 0.f;
#pragma unroll 1
            for (int c0 = 0; c0 < klen / 16; c0 += 8) {
                bf16x8 av[8], wh[8], wl[8];
#pragma unroll
                for (int u = 0; u < 8; ++u) { av[u] = *(const bf16x8*)(hp + 16 * (c0 + u)); wh[u] = *(const bf16x8*)(wph + 16 * (c0 + u)); wl[u] = *(const bf16x8*)(wpl + 16 * (c0 + u)); }
                __builtin_amdgcn_sched_barrier(0);
#pragma unroll
                for (int u = 0; u < 8; ++u) {
#pragma unroll
                    for (int j = 0; j < 8; ++j) { const float v = __uint_as_float(((unsigned)(unsigned short)av[u][j]) << 16); ssq += v * v; }
                    acc = __builtin_amdgcn_mfma_f32_32x32x16_bf16(av[u], wh[u], acc, 0, 0, 0); acc = __builtin_amdgcn_mfma_f32_32x32x16_bf16(av[u], wl[u], acc, 0, 0, 0); }
                __builtin_amdgcn_sched_barrier(0);
            }
            ssq = sum32(ssq);
#pragma unroll
            for (int r = 0; r < 16; ++r) part[(wid * 32 + crow(r, hi)) * 33 + r32] = acc[r];
            if (hi == 0) ssqp[wid * 32 + r32] = ssq;
        }
        __syncthreads();
        if (tid < 128) {
            const int ts2 = tid >> 5, i = tid & 31; const int row = 32 * (F.bid + F.G * (k0 + ts2)) + i;
            if (k0 + ts2 < ntile_b && row < NTOK && !(lone && ts2 > 0)) {
                const int nsl = lone ? 8 : 2, sst = lone ? 1 : 4;
                float sq = 0.f; for (int sl = 0; sl < nsl; ++sl) sq += ssqp[(ts2 + sst * sl) * 32 + i];
                const float rstd = 1.0f / sqrtf(sq * (1.f / DM) + RMS_EPS);
                float lg[20];
#pragma unroll
                for (int o = 0; o < 20; ++o) { float a = 0.f; for (int sl = 0; sl < nsl; ++sl) a += part[((ts2 + sst * sl) * 32 + i) * 33 + o]; lg[o] = a * rstd + (o < 4 ? rgb[o] : reb[o - 4]); }
                int gi = 0; float gm = lg[0];
#pragma unroll
                for (int o = 1; o < 4; ++o) if (lg[o] > gm) { gm = lg[o]; gi = o; }
                float gs = 0.f;
#pragma unroll
                for (int o = 0; o < 4; ++o) gs += __expf(lg[o] - gm);
                const float gprob = 1.0f / gs;
                float li[4];
#pragma unroll
                for (int j = 0; j < 4; ++j) li[j] = gi == 0 ? lg[4 + j] : gi == 1 ? lg[8 + j] : gi == 2 ? lg[12 + j] : lg[16 + j];
                int i1 = 0; float v1 = li[0];
#pragma unroll
                for (int j = 1; j < 4; ++j) if (li[j] > v1) { v1 = li[j]; i1 = j; }
                int i2 = -1; float v2 = -3.0e38f;
#pragma unroll
                for (int j = 0; j < 4; ++j) if (j != i1 && li[j] > v2) { v2 = li[j]; i2 = j; }
                const float e2 = __expf(v2 - v1); const float p1 = 1.0f / (1.0f + e2), p2 = e2 / (1.0f + e2);
                const int ea = gi * 4 + i1, eb = gi * 4 + i2;
                u32x4 ti; ti.x = (unsigned)ea | ((unsigned)eb << 8); ti.y = __float_as_uint(p1 * gprob); ti.z = __float_as_uint(p2 * gprob); ti.w = __float_as_uint(rstd);
                tokinfo[row] = ti;
                if (count) { lds_add((LAS unsigned*)&hist[ea], 1u); lds_add((LAS unsigned*)&hist[eb], 1u); }
            }
        }
        __syncthreads();
    }
    if (tid < 16 && count) { const unsigned hc = hist[tid]; ((unsigned*)(F.ws + WS_HIST))[F.bid * 16 + tid] = hc; if (hc) atomicAdd(F.ctl + CW_CNT + l * 16 + tid, hc); }
    __syncthreads();
}

__device__ __forceinline__ void moe_tables(Frame& F, int l) {
    const int tz = (F.wid << 6) | lane_now();
    if (tz < 64) {
        const int ln = tz & 63; const int c = ln < 16 ? (int)xb_ld(F.ctl + CW_CNT + l * 16 + ln) : 0; const int np = (c + 255) >> 8;
        int inc = np;
#pragma unroll
        for (int o = 1; o < 16; o <<= 1) { const int t = __builtin_amdgcn_ds_bpermute((ln - o) << 2, inc); if (ln >= o) inc += t; }
        if (ln < 16) { F.LC[32 + ln] = (unsigned)(inc - np); F.LC[64 + ln] = (unsigned)((inc - np) * 256); }
        if (ln == 15) { F.LC[48] = (unsigned)inc; F.LC[80] = (unsigned)(inc * 256); } }
    __syncthreads();
}

__device__ __forceinline__ void slots_phase(Frame& F, const Params& p, int l) {
    PHASE_IDS();
    const int ntile_b = F.bid < NT32 ? (NT32 - F.bid + F.G - 1) / F.G : 0;
    moe_tables(F, l);
    volatile LAS unsigned* boff = F.LC + 96;
    if (tid < 16) boff[tid] = 0u;
    __syncthreads();
    { const unsigned* hg = (const unsigned*)(F.ws + WS_HIST); const int e = tid & 15; unsigned sacc = 0;
#pragma unroll 8
      for (int bb = tid >> 4; bb < F.bid; bb += 32) sacc += hg[bb * 16 + e];
      if (sacc) lds_add((LAS unsigned*)&boff[e], sacc); }
    __syncthreads();
    const u32x4* tokinfo = (const u32x4*)(F.ws + WS_TOKINFO);
    u32x2* tokslot = (u32x2*)(F.ws + WS_TOKSLOT);
    int* tokmap = (int*)(F.ws + WS_TOKMAP); float* rslot = (float*)(F.ws + WS_RSLOT);
    if (wid == 0) {
        volatile LAS unsigned* run = F.LC + 128;
        if (lane < 16) run[lane] = F.LC[64 + lane] + boff[lane];
        for (int k0 = 0; k0 < ntile_b; k0 += 2) {
            const int kk = k0 + (lane >> 5); const int row = 32 * (F.bid + F.G * kk) + (lane & 31); const bool ok = kk < ntile_b && row < NTOK;
            u32x4 ti = (u32x4){0xffffu, 0u, 0u, 0u}; if (ok) ti = tokinfo[row];
            const unsigned ea = ti.x & 0xffu, eb = (ti.x >> 8) & 0xffu;
            unsigned sa = 0, sb2 = 0;
#pragma unroll 1
            for (int e = 0; e < 16; ++e) {
                const bool hit = ok && (ea == (unsigned)e || eb == (unsigned)e);
                const unsigned long long mk = __ballot(hit);
                const unsigned rank = __popcll(mk & ((1ull << lane) - 1ull));
                const unsigned cur = run[e];
                if (ea == (unsigned)e) sa = cur + rank;
                if (eb == (unsigned)e) sb2 = cur + rank;
                if (lane == 0) run[e] = cur + (unsigned)__popcll(mk);
            }
            if (ok) { tokslot[row] = (u32x2){sa, sb2}; tokmap[sa] = row; tokmap[sb2] = row; const float rs = __uint_as_float(ti.w); rslot[sa] = rs; rslot[sb2] = rs; }
        }
    }
    if (F.bid < 16) {
        const int e = F.bid; const int c = (int)xb_ld(F.ctl + CW_CNT + l * 16 + e), base = (int)F.LC[64 + e], pc = ((c + 255) >> 8) << 8;
        for (int i = c + tid; i < pc; i += 512) { tokmap[base + i] = 0; rslot[base + i] = 0.f; }
    }
    __syncthreads();
}

__device__ __forceinline__ void combine_phase(Frame& F, const Params& p, int l) {
    PHASE_IDS(); const int gw = F.bid * 8 + wid, NGW = F.G * 8;
    const u32x4* tokinfo = (const u32x4*)(F.ws + WS_TOKINFO);
    const u32x2* tokslot = (const u32x2*)(F.ws + WS_TOKSLOT);
    const unsigned char* y = (const unsigned char*)(F.ws + WS_PROJ);
    bf16_t* xn = (bf16_t*)(F.ws + WS_XN);
    const bool lastl = (l == DEPTH - 1);
    const int nrows = lastl ? NREAL : NTOK;
    u32x4 ti_n = (u32x4){0u, 0u, 0u, 0u}; u32x2 ts_n = (u32x2){0u, 0u};
    if (gw < nrows) { ti_n = tokinfo[gw]; ts_n = tokslot[gw]; }
    for (int row = gw; row < nrows; row += NGW) {
        const u32x4 ti = ti_n; const u32x2 ts = ts_n;
        { const int nr = row + NGW < nrows ? row + NGW : row; ti_n = tokinfo[nr]; ts_n = tokslot[nr]; }
        asm volatile("" ::: "memory");
        const float wa = __uint_as_float(ti.y) * Y8_INV, wb = __uint_as_float(ti.z) * Y8_INV;
        const u32x4* hb = (const u32x4*)(xn + (size_t)row * DM) + lane;
        const u32x2* ya = (const u32x2*)(y + (size_t)ts.x * DM) + lane; const u32x2* yb = (const u32x2*)(y + (size_t)ts.y * DM) + lane;
        u32x4 hq[4]; u32x2 aq[4], bq[4];
#pragma unroll
        for (int j = 0; j < 4; ++j) { hq[j] = hb[64 * j]; aq[j] = ya[64 * j]; bq[j] = yb[64 * j]; }
        float v[4][8]; float s = 0.f;
#pragma unroll
        for (int j = 0; j < 4; ++j)
#pragma unroll
            for (int w2 = 0; w2 < 2; ++w2) {
                const auto a0 = __builtin_amdgcn_cvt_pk_f32_fp8((int)aq[j][w2], false), a1 = __builtin_amdgcn_cvt_pk_f32_fp8((int)aq[j][w2], true);
                const auto b0 = __builtin_amdgcn_cvt_pk_f32_fp8((int)bq[j][w2], false), b1 = __builtin_amdgcn_cvt_pk_f32_fp8((int)bq[j][w2], true);
                const unsigned h0 = hq[j][2 * w2], h1 = hq[j][2 * w2 + 1];
                const float v0 = bf_lo(h0) + wa * a0[0] + wb * b0[0], v1 = bf_hi(h0) + wa * a0[1] + wb * b0[1], v2 = bf_lo(h1) + wa * a1[0] + wb * b1[0], v3 = bf_hi(h1) + wa * a1[1] + wb * b1[1];
                v[j][4 * w2] = v0; v[j][4 * w2 + 1] = v1; v[j][4 * w2 + 2] = v2; v[j][4 * w2 + 3] = v3; s += (v0 * v0 + v1 * v1) + (v2 * v2 + v3 * v3); }
        const float rms = sqrtf(wave_sum(s) * (1.f / DM) + RMS_EPS), rstd = 1.0f / rms;
        if (!lastl) {
            if (lane == 0) ((float*)(F.ws + WS_RINV))[row] = rms;
            u32x4* o8 = (u32x4*)(xn + (size_t)row * DM) + lane;
#pragma unroll
            for (int j = 0; j < 4; ++j) { u32x4 wn;
#pragma unroll
                for (int e = 0; e < 4; ++e) wn[e] = cvt_pk_bf16(v[j][2 * e] * rstd, v[j][2 * e + 1] * rstd);
                o8[64 * j] = wn; }
        } else {
            const float* gp = (const float*)(F.ws + WS_PB) + PB_FING + lane * 8; float* op = p.out + (size_t)row * DM + lane * 8;
#pragma unroll
            for (int j = 0; j < 4; ++j) { const f32x4 g0 = *(const f32x4*)(gp + 512 * j), g1 = *(const f32x4*)(gp + 512 * j + 4);
                { *(f32x4*)(op + 512 * j) = (f32x4){v[j][0] * rstd * g0.x, v[j][1] * rstd * g0.y, v[j][2] * rstd * g0.z, v[j][3] * rstd * g0.w};
                            *(f32x4*)(op + 512 * j + 4) = (f32x4){v[j][4] * rstd * g1.x, v[j][5] * rstd * g1.y, v[j][6] * rstd * g1.z, v[j][7] * rstd * g1.w}; } }
        }
    }
}

template <class Sink>
__device__ __forceinline__ void meta_gemm_group(LAS unsigned char* lds, int wid, const bf16_t* A, const bf16_t* Bt, int K, const Sink& sink) {
    asm volatile("" : "+s"(wid)); const int lane = lane_now(), tid = (wid << 6) | lane; const int hi = lane >> 5, r32 = lane & 31;
    const int kper = K >> 3;
    const bf16_t* ap = A + (size_t)r32 * K + wid * kper + 8 * hi; const bf16_t* bp = Bt + (size_t)r32 * K + wid * kper + 8 * hi;
    f32x16 acc = {};
#pragma unroll 8
    for (int sidx = 0; sidx < kper / 16; ++sidx) { const bf16x8 a = *(const bf16x8*)(ap + 16 * sidx), bq = *(const bf16x8*)(bp + 16 * sidx); acc = __builtin_amdgcn_mfma_f32_32x32x16_bf16(a, bq, acc, 0, 0, 0); }
    LAS float* part = (LAS float*)lds;
#pragma unroll
    for (int r = 0; r < 16; ++r) part[(wid * 32 + crow(r, hi)) * 33 + r32] = acc[r];
    __syncthreads();
#pragma unroll
    for (int o = 0; o < 2; ++o) { const int e = tid + 512 * o, row = e >> 5, col = e & 31; float v = 0.f;
#pragma unroll
        for (int w = 0; w < 8; ++w) v += part[(w * 32 + row) * 33 + col];
        sink(row, col, v); }
    __syncthreads();
}

constexpr int PH_PER_LAYER = 9, N_PHASES = 1 + DEPTH * PH_PER_LAYER;
__global__ void __launch_bounds__(512, 2) mega_fwd(Params p) {
    extern __shared__ __attribute__((aligned(16))) unsigned char lds_raw[];
    Frame F;
    F.lds = (LAS unsigned char*)lds_raw; F.LC = (volatile LAS unsigned*)(F.lds + LCTL_OFF);
    F.G = gridDim.x; F.bid = blockIdx.x; F.wid = __builtin_amdgcn_readfirstlane(threadIdx.x >> 6);
    F.ws = p.ws; F.ctl = (unsigned*)(p.ws + WS_CTL);
    for (int u = threadIdx.x; u < (LDS_BYTES - LCTL_OFF) / 4; u += 512) F.LC[u] = 0u;
    __syncthreads();
    XcdBarrier bar; bar.bar = F.ctl + CW_BAR; bar.x = 0; bar.st = nullptr; bar.wid = F.wid;
    const int lo = p.ph_lo, hi = p.ph_hi;
    if (hi - lo > 1) { bar = xcd_barrier_post(F.ctl + CW_BAR, F.LC + 8, F.wid); xcd_barrier_census(bar); }
#define IN(k) (lo <= (k) && (k) < hi)
#define REBASE() do { unsigned char* w_ = p.ws; asm volatile("" : "+s"(w_)); F.ws = w_; F.ctl = (unsigned*)(w_ + WS_CTL); } while (0)
#define SEAM(k) do { if (IN(k) && IN((k) + 1)) xcd_barrier(bar); } while (0)
    if (IN(0)) p0_prologue(F, p);
    SEAM(0);
    for (int l = 0; l < DEPTH; ++l) {
        const int pb = 1 + l * PH_PER_LAYER;
        if (IN(pb + 0)) { REBASE();
            { bf16_t* projm = (bf16_t*)(F.ws + WS_PROJ) + (size_t)NREAL * NPROJ;
              for (int g = F.bid; g < NPROJ / 32; g += F.G)
                  meta_gemm_group(F.lds, F.wid, (const bf16_t*)(F.ws + WS_XN) + (size_t)NREAL * DM, (const bf16_t*)(F.ws + WS_WIN) + ((size_t)l * NPROJ + 32 * g) * DM, DM,
                                  [&](int row, int col, float v) { projm[(size_t)row * NPROJ + 32 * g + col] = (bf16_t)(cvt_pk_bf16(v, 0.f) & 0xffffu); }); }
            pg8::DenseOrder S; S.init(F.ws + WS_XN, F.ws + WS_WIN + (size_t)l * NPROJ * DM * 2, NREAL, NPROJ, DM, F.G, F.bid);
            pg8::EpiBf16 E{(bf16_t*)(F.ws + WS_PROJ), NPROJ, 1.0f};
            pg8::gemm_phase<pg8::EpiBf16, pg8::DenseOrder>(F.lds, F.wid, DM, S, E);
        }
        SEAM(pb + 0);
        if (IN(pb + 1)) { REBASE();
            for (int u = F.bid; u < 256; u += F.G) lru_unit<1>(F, p, l, u);
            kmax_phase(F, l); }
        SEAM(pb + 1);
        if (IN(pb + 2)) { REBASE();
            for (int u = F.bid; u < 256; u += F.G) lru_unit<2>(F, p, l, u);
            for (;;) {
                __syncthreads();
                if (F.wid == 0 && lane_now() == 0) F.LC[0] = atomicAdd(F.ctl + CW_QUEUE + l * 64, 1u);
                __syncthreads();
                const int u = (int)F.LC[0];
                if (u >= 16 * 129) break;
                const int qb = 127 - (u >> 4), bh = u & 15;
                attn_unit(F, p, l, bh >> 3, bh & 7, qb);
            }
        }
        SEAM(pb + 2);
        if (IN(pb + 3)) { REBASE();
            { bf16_t* hbm = (bf16_t*)(F.ws + WS_XN) + (size_t)NREAL * DM; unsigned char* hbm8 = (unsigned char*)(F.ws + WS_HB8) + (size_t)NREAL * DM; const float* rmsm = (const float*)(F.ws + WS_RINV) + NREAL;
              for (int g = F.bid; g < DM / 32; g += F.G)
                  meta_gemm_group(F.lds, F.wid, (const bf16_t*)(F.ws + WS_MIX) + (size_t)NREAL * DM, (const bf16_t*)(F.ws + WS_WOUT) + ((size_t)l * DM + 32 * g) * DM, DM,
                                  [&](int row, int col, float v) { const int c = 32 * g + col;
                                      const float bs = __uint_as_float((unsigned)hbm[(size_t)row * DM + c] << 16) * rmsm[row];
                                      hbm[(size_t)row * DM + c] = (bf16_t)(cvt_pk_bf16(bs + v, 0.f) & 0xffffu); hbm8[(size_t)row * DM + c] = (unsigned char)(cvt4_fp8(bs + v, 0.f, 0.f, 0.f) & 0xffu); }); }
            pg8::DenseOrder S; S.init(F.ws + WS_MIX, F.ws + WS_WOUT + (size_t)l * DM * DM * 2, NREAL, DM, DM, F.G, F.bid);
            pg8::EpiResid E{(bf16_t*)(F.ws + WS_XN), (const float*)(F.ws + WS_RINV), (unsigned char*)(F.ws + WS_HB8)};
            pg8::gemm_phase<pg8::EpiResid, pg8::DenseOrder>(F.lds, F.wid, DM, S, E);
        }
        SEAM(pb + 3);
        if (IN(pb + 4)) { REBASE(); router_phase(F, p, l); }
        SEAM(pb + 4);
        if (IN(pb + 5)) { REBASE(); slots_phase(F, p, l); }
        SEAM(pb + 5);
        if (IN(pb + 6)) { REBASE();
            moe_tables(F, l);
            pg8::MoeOrder S{(const char*)(F.ws + WS_HB8), (const char*)(F.ws + WS_WGU + (size_t)l * 16 * 1024 * DM), (size_t)0, (size_t)1024 * DM, (size_t)256 * DM, 4, F.G, F.bid,
                            (const LAS int*)(F.lds + LCTL_OFF + 32 * 4), (const LAS int*)(F.lds + LCTL_OFF + 64 * 4)};
            pg8::EpiSwiGLU E{(unsigned char*)(F.ws + WS_HE), (const float*)(F.ws + WS_RSLOT)};
            { LAS int* idxt = (LAS int*)(F.lds + LIDX_OFF); const int* tokmap = (const int*)(F.ws + WS_TOKMAP); pg8::Unit uu;
              const int tz = (F.wid << 6) | lane_now();
#pragma unroll 1
              for (int i = 0; i < MAXGU; ++i) { if (!S.next(i, uu)) break; if (tz < 256) idxt[i * 256 + tz] = tokmap[uu.row0 + tz]; }
              __syncthreads(); }
            pg8::gemm_phase<pg8::EpiSwiGLU, pg8::MoeOrder, true, true, true, true>(F.lds, F.wid, DM, S, E, (const char*)(F.ws + WS_HB8), (const LAS int*)(F.lds + LIDX_OFF));
        }
        SEAM(pb + 6);
        if (IN(pb + 7)) { REBASE();
            moe_tables(F, l);
            pg8::MoeOrder S{(const char*)(F.ws + WS_HE), (const char*)(F.ws + WS_WD + (size_t)l * 16 * DM * DEXP), (size_t)DEXP, (size_t)DM * DEXP, (size_t)256 * DEXP, 8, F.G, F.bid,
                            (const LAS int*)(F.lds + LCTL_OFF + 32 * 4), (const LAS int*)(F.lds + LCTL_OFF + 64 * 4)};
            pg8::EpiY8 E{(unsigned char*)(F.ws + WS_PROJ)};
            pg8::gemm_phase<pg8::EpiY8, pg8::MoeOrder, true, true, false, true>(F.lds, F.wid, DEXP, S, E);
        }
        SEAM(pb + 7);
        if (IN(pb + 8)) { REBASE(); combine_phase(F, p, l); }
        SEAM(pb + 8);
    }
#undef IN
#undef REBASE
#undef SEAM
}

extern "C" void kernel_launch(void* const* d_in, const int* in_sizes, int n_in, void* d_out, int out_size, void* d_ws, size_t ws_size, hipStream_t stream) {
    static int grid = 0;
    if (grid == 0) {
        if (n_in != 26 || out_size != NREAL * DM || ws_size < WS_END) { fprintf(stderr, "kernel_launch: unexpected shapes (n_in %d out %d ws %zu)\n", n_in, out_size, ws_size); grid = -1; return; }
        int dev = 0, cus = 0, per_cu = 0;
        if (hipGetDevice(&dev) != hipSuccess || hipDeviceGetAttribute(&cus, hipDeviceAttributeMultiprocessorCount, dev) != hipSuccess) { grid = -1; return; }
        if (hipFuncSetAttribute((const void*)mega_fwd, hipFuncAttributeMaxDynamicSharedMemorySize, LDS_BYTES) != hipSuccess) { fprintf(stderr, "kernel_launch: hipFuncSetAttribute failed\n"); grid = -1; return; }
        if (hipOccupancyMaxActiveBlocksPerMultiprocessor(&per_cu, (const void*)mega_fwd, 512, LDS_BYTES) != hipSuccess || per_cu < 1) { fprintf(stderr, "kernel_launch: occupancy query says %d\n", per_cu); (void)hipGetLastError(); }
        grid = cus;
        if (grid > 1024) grid = 1024;
    }
    if (grid < 0) return;
    if (hipMemsetAsync((char*)d_ws + WS_CTL, 0, CTL_BYTES, stream) != hipSuccess) return;
    Params p{};
    for (int i = 0; i < 26; ++i) p.in[i] = (const float*)d_in[i];
    p.out = (float*)d_out; p.ws = (unsigned char*)d_ws;
#if MK_N_LAUNCHES == 1
    p.ph_lo = 0; p.ph_hi = N_PHASES;
    hipLaunchKernelGGL(mega_fwd, dim3(grid), dim3(512), LDS_BYTES, stream, p);
#else
    for (int k = 0; k < N_PHASES; ++k) { p.ph_lo = k; p.ph_hi = k + 1; hipLaunchKernelGGL(mega_fwd, dim3(grid), dim3(512), LDS_BYTES, stream, p); }
#endif
}
```

```cpp
#include <hip/hip_runtime.h>
#include <cstdio>
#include <cstdint>

#ifndef MK_N_LAUNCHES
#define MK_N_LAUNCHES 1
#endif

#define LAS __attribute__((address_space(3)))
typedef unsigned short bf16_t;
typedef short bf16x8 __attribute__((ext_vector_type(8)));
typedef short s16x4 __attribute__((ext_vector_type(4)));
typedef float f32x2 __attribute__((ext_vector_type(2)));
typedef float f32x4 __attribute__((ext_vector_type(4)));
typedef float f32x16 __attribute__((ext_vector_type(16)));
typedef unsigned u32x2 __attribute__((ext_vector_type(2)));
typedef unsigned u32x4 __attribute__((ext_vector_type(4)));
typedef int i32x8 __attribute__((ext_vector_type(8)));
typedef int i32x4 __attribute__((ext_vector_type(4)));

constexpr int BATCH = 2, SEQ = 16384, NMETA = 16, TLEN = SEQ + NMETA, DM = 2048, NPROJ = 5120, DEPTH = 2;
constexpr int NREAL = BATCH * SEQ;
constexpr int NTOK = NREAL + BATCH * NMETA;
constexpr int RPAD = 33024, NPAN = RPAD / 256;
constexpr int LRUW = 1024, NEXP = 16, DEXP = 512, NHEAD = 8;
constexpr int XS_ROWS = 2 * NTOK + NEXP * 256;
constexpr int OFF_U = 0, OFF_YG = 1024, OFF_Q = 2048, OFF_K = 3072, OFF_V = 4096;
constexpr float RMS_EPS = 1e-6f;
constexpr float LOG2E = 1.4426950408889634f;
constexpr float QSCALE = 0.125f * LOG2E;

constexpr size_t MiB = 1u << 20;
constexpr size_t WS_CTL = 0, CTL_BYTES = 1 * MiB;
constexpr size_t WS_TOKINFO = 1 * MiB;
constexpr size_t WS_TOKSLOT = WS_TOKINFO + 640 * 1024;
constexpr size_t WS_HIST = WS_TOKSLOT + 320 * 1024;
constexpr size_t WS_LRUSUM = WS_HIST + 64 * 1024;
constexpr size_t WS_HMETA = WS_LRUSUM + 256 * 1024;
constexpr size_t WS_WR = WS_HMETA + 256 * 1024;
constexpr size_t WS_PB = WS_WR + 512 * 1024;
constexpr size_t WS_TOKMAP = WS_PB + 256 * 1024;
constexpr size_t WS_RSLOT = WS_TOKMAP + 288 * 1024;
constexpr size_t WS_RINV = WS_RSLOT + 288 * 1024;
constexpr size_t WS_WGATES = 4 * MiB;
constexpr size_t WS_WIN = 6 * MiB;
constexpr size_t WS_WOUT = 46 * MiB;
constexpr size_t WS_WGU = 62 * MiB;
constexpr size_t WS_WD = 190 * MiB;
constexpr size_t WS_XN = 254 * MiB;
constexpr size_t WS_MIX = 383 * MiB;
constexpr size_t WS_HE = 512 * MiB;
constexpr size_t WS_PROJ = 581 * MiB;
constexpr size_t WS_HB8 = 904 * MiB;
constexpr size_t WS_END = 970 * MiB;
static_assert(WS_WR + 2 * 32 * 2048 * 4 <= WS_PB && WS_PB + 3 * 16384 * 4 <= WS_TOKMAP && (size_t)XS_ROWS * 4 <= 288 * 1024 && WS_RINV + (size_t)RPAD * 4 <= WS_WGATES && WS_PROJ + (size_t)RPAD * NPROJ * 2 <= WS_HB8 && WS_HB8 + (size_t)RPAD * DM <= WS_END && WS_HE + (size_t)XS_ROWS * DEXP * 2 <= WS_PROJ, "ws map");
constexpr int PBL = 16384, PB_CW = 0, PB_CB = 4096, PB_BA = 5120, PB_BX = 6144, PB_SP8 = 7168, PB_SUBG = 8192, PB_RGB = 8320, PB_REB = 8324, PB_LAM = 8352, PB_FING = 2 * PBL;
constexpr int CW_BAR = 4096;
constexpr int CW_QUEUE = 8192;
constexpr int CW_CNT = 8192 + 256;
constexpr int CW_KMAX = 8192 + 512;

constexpr int RING_BYTES = 131072;
constexpr int LCTL_OFF = RING_BYTES;
constexpr int LIDX_OFF = LCTL_OFF + 1024;
constexpr int MAXGU = 12;
constexpr int LDS_BYTES = 147456;
static_assert(LIDX_OFF + MAXGU * 1024 <= LDS_BYTES, "LDS map");

__device__ __forceinline__ unsigned cvt_pk_bf16(float lo, float hi) { unsigned r; asm volatile("v_cvt_pk_bf16_f32 %0, %1, %2" : "=v"(r) : "v"(lo), "v"(hi)); return r; }
constexpr float HE_SCALE = 0.5f, Y8_INV = 1.0f / (64.0f * 0.5f);
constexpr float W8_SCALE = 64.0f, W8_INV = 1.0f / 64.0f;
__device__ __forceinline__ unsigned cvt4_fp8(float a, float b, float c, float d) { int w = __builtin_amdgcn_cvt_pk_fp8_f32(a, b, 0, false); w = __builtin_amdgcn_cvt_pk_fp8_f32(c, d, w, true); return (unsigned)w; }
__device__ __forceinline__ float bf_lo(unsigned u) { return __uint_as_float(u << 16); }
__device__ __forceinline__ float bf_hi(unsigned u) { return __uint_as_float(u & 0xffff0000u); }
__device__ __forceinline__ float shx1(float v) { return __int_as_float(__builtin_amdgcn_mov_dpp(__float_as_int(v), 0xB1, 0xf, 0xf, true)); }
__device__ __forceinline__ float shx2(float v) { return __int_as_float(__builtin_amdgcn_mov_dpp(__float_as_int(v), 0x4E, 0xf, 0xf, true)); }
template <int M> __device__ __forceinline__ float shxs(float v) { return __int_as_float(__builtin_amdgcn_ds_swizzle(__float_as_int(v), (M << 10) | 0x1f)); }
__device__ __forceinline__ float sum32(float v) { const auto r = __builtin_amdgcn_permlane32_swap(__float_as_int(v), __float_as_int(v), false, false); return __int_as_float(r[0]) + __int_as_float(r[1]); }
__device__ __forceinline__ float max32(float v) { const auto r = __builtin_amdgcn_permlane32_swap(__float_as_int(v), __float_as_int(v), false, false); return fmaxf(__int_as_float(r[0]), __int_as_float(r[1])); }
__device__ __forceinline__ float wave_sum(float v) { v += shx1(v); v += shx2(v); v += shxs<4>(v); v += shxs<8>(v); v += shxs<16>(v); return sum32(v); }
__device__ __forceinline__ int crow(int r, int hi) { return (r & 3) + 8 * (r >> 2) + 4 * hi; }
__device__ __forceinline__ int tok_row(int b, int pos) { return pos < NMETA ? NREAL + b * NMETA + pos : b * SEQ + pos - NMETA; }
#define LDS_WAIT() asm volatile("s_waitcnt lgkmcnt(0)" ::: "memory")
#define LDS_BARRIER() do { asm volatile("s_waitcnt lgkmcnt(0)" ::: "memory"); __builtin_amdgcn_s_barrier(); asm volatile("" ::: "memory"); } while (0)
__device__ __forceinline__ void lds_add(LAS unsigned* p, unsigned v) { (void)__hip_atomic_fetch_add(p, v, __ATOMIC_RELAXED, __HIP_MEMORY_SCOPE_WORKGROUP); }

#define XB_TMO      128
#define XB_XCNT(j)  (256  + 64 * (j))
#define XB_XSUB(j)  (1280 + 64 * (j))
#define XB_XGEN(j)  (2304 + 64 * (j))
#define XB_TOP      3328
#define XB_TOPGEN   3392
#define XCD_BAR_WORDS 3456
#define XB_SPIN_CAP (1u << 24)
__device__ __forceinline__ unsigned xb_ld(unsigned* p)              { return __hip_atomic_load(p, __ATOMIC_RELAXED, __HIP_MEMORY_SCOPE_AGENT); }
__device__ __forceinline__ unsigned xb_add(unsigned* p, unsigned v) { return __hip_atomic_fetch_add(p, v, __ATOMIC_RELAXED, __HIP_MEMORY_SCOPE_AGENT); }
__device__ __forceinline__ unsigned xb_xcc_id() { return (unsigned)__builtin_amdgcn_s_getreg((3 << 11) | 20) & 0xFu; }
#define XB_SPIN(cond, bar) do { unsigned _sp = 0; while (cond) { __builtin_amdgcn_s_sleep(1); \
    if ((++_sp & 255u) == 0u) { if (xb_ld(&(bar)[XB_TMO])) break; if (_sp > XB_SPIN_CAP) { atomicAdd(&(bar)[XB_TMO], 1u); break; } } } } while (0)
__device__ __forceinline__ int lane_now() { int l; asm volatile("v_mbcnt_lo_u32_b32 %0, -1, 0\n\tv_mbcnt_hi_u32_b32 %0, -1, %0" : "=v"(l)); return l; }
struct XcdBarrier { unsigned* bar; unsigned x; volatile LAS unsigned* st; int wid; };
__device__ __forceinline__ XcdBarrier xcd_barrier_post(unsigned* bar, volatile LAS unsigned* st, int wid) {
    XcdBarrier b; b.bar = bar; b.x = xb_xcc_id(); b.st = st; b.wid = wid;
    if (wid == 0 && lane_now() == 0) (void)xb_add(&bar[XB_XCNT(b.x)], 1u);
    return b;
}
__device__ __forceinline__ void xcd_barrier_complete(unsigned* bar, unsigned x, unsigned& nloc, unsigned& nx) {
    const unsigned G = gridDim.x * gridDim.y * gridDim.z;
    unsigned sum, cnt, mine, sp = 0u;
    for (;;) {
        sum = 0u; cnt = 0u; mine = 0u;
#pragma unroll
        for (unsigned j = 0; j < 16; ++j) { const unsigned c = xb_ld(&bar[XB_XCNT(j)]); sum += c; cnt += (c > 0u) ? 1u : 0u; mine = (j == x) ? c : mine; }
        if (sum == G) break;
        __builtin_amdgcn_s_sleep(1);
        if ((++sp & 255u) == 0u) { if (xb_ld(&bar[XB_TMO])) break; if (sp > XB_SPIN_CAP) { atomicAdd(&bar[XB_TMO], 1u); break; } }
    }
    nloc = mine > 0u ? mine : 1u; nx = cnt > 0u ? cnt : 1u;
}
__device__ __forceinline__ void xcd_barrier_census(const XcdBarrier& b) {
    if (b.wid == 0 && lane_now() == 0) { unsigned nloc, nx; xcd_barrier_complete(b.bar, b.x, nloc, nx); b.st[0] = nloc; b.st[1] = nx; }
    __syncthreads();
}
__device__ __forceinline__ void xcd_barrier(const XcdBarrier& b) {
    asm volatile("s_waitcnt vmcnt(0)" ::: "memory");
    __syncthreads();
    if (b.wid == 0 && lane_now() == 0) {
        unsigned* bar = b.bar;
        __builtin_amdgcn_s_waitcnt(0);
        const unsigned nloc = b.st[0], nx = b.st[1];
        const unsigned old = xb_add(&bar[XB_XSUB(b.x)], 1u);
        const unsigned gen = old / nloc;
        if (old + 1u == (gen + 1u) * nloc) {
            __builtin_amdgcn_fence(__ATOMIC_RELEASE, "agent");
            asm volatile("s_waitcnt vmcnt(0)" ::: "memory");
            const unsigned og = xb_add(&bar[XB_TOP], 1u);
            const unsigned tg = og / nx;
            if (og + 1u == (tg + 1u) * nx) xb_add(&bar[XB_TOPGEN], 1u);
            else XB_SPIN(xb_ld(&bar[XB_TOPGEN]) == tg, bar);
            __builtin_amdgcn_fence(__ATOMIC_ACQUIRE, "agent");
            xb_add(&bar[XB_XGEN(b.x)], 1u);
            asm volatile("s_waitcnt vmcnt(0)" ::: "memory");
        } else {
            XB_SPIN(xb_ld(&bar[XB_XGEN(b.x)]) == gen, bar);
            __builtin_amdgcn_fence(__ATOMIC_ACQUIRE, "agent");
            asm volatile("s_waitcnt vmcnt(0)" ::: "memory");
        }
    }
    __syncthreads();
}

namespace pg8 {
constexpr int BM = 256, BK = 64, HALF = 128, HTB = HALF * BK * 2, STAGE_BYTES = 8 * HTB, NXCD = 8, WGM = 8;
__host__ __device__ __forceinline__ int lds_byte(int r, int c) { const int st = (r >> 4) * 2 + (c >> 5), rr = r & 15, cc = c & 31, ob = rr * 64 + cc * 2; return st * 1024 + (ob ^ (((ob >> 9) & 1) << 5)); }
__host__ __device__ __forceinline__ void stage_rc(int b, int& R, int& C) { const int st = b / 1024, sb = b % 1024, swz = sb ^ (((sb >> 9) & 1) << 5); R = (st >> 1) * 16 + swz / 64; C = (st & 1) * 32 + (swz % 64) / 2; }
__host__ __device__ __forceinline__ int perm32(int rho) { const int n = rho >> 4, i = rho & 15; return 8 * (i >> 2) + 4 * n + (i & 3); }

struct Unit { const char* A; const char* B; int row0, col0; };

struct DenseOrder {
    const char* A; const char* Bt; size_t tstep; int nM, nN, nwg, G, c;
    __device__ void init(const void* A_, const void* Bt_, int M, int N, int K, int G_, int c_) { A = (const char*)A_; Bt = (const char*)Bt_; tstep = (size_t)BM * K * 2; nM = M / BM; nN = N / BM; nwg = nM * nN; G = G_; c = c_; }
    __device__ bool next(int i, Unit& u) const {
        const long L = (long)i * G + c; if (L >= nwg) return false;
        int wgid = (int)L; { const int q = nwg / NXCD, r = nwg % NXCD, xcd = wgid % NXCD, off = wgid / NXCD; wgid = (xcd < r ? xcd * (q + 1) : r * (q + 1) + (xcd - r) * q) + off; }
        const int nig = WGM * nN, gid = wgid / nig, fm = gid * WGM, gsz = (nM - fm) < WGM ? (nM - fm) : WGM;
        const int pm = fm + ((wgid % nig) % gsz), pn = (wgid % nig) / gsz;
        u.A = A + (size_t)pm * tstep; u.B = Bt + (size_t)pn * tstep; u.row0 = pm * BM; u.col0 = pn * BM; return true;
    }
};
struct MoeOrder {
    const char* A; const char* Bt; size_t rowbytes, ebytes, tstepB; int NT, G, c; const LAS int* pp; const LAS int* sb;
    __device__ bool next(int i, Unit& u) const {
        int pg, pn;
        if ((G & 7) == 0 && ((G >> 3) % NT) == 0) { const int x = c & 7, idx = c >> 3, ppr = (G >> 3) / NT; pn = idx % NT; pg = i * (8 * ppr) + x * ppr + idx / NT; }
        else { const long L = (long)i * G + c; pg = (int)(L / NT); pn = (int)(L % NT); }
        if (pg >= pp[16]) return false;
        int e = 0;
#pragma unroll
        for (int j = 1; j < 16; ++j) e += (pg >= pp[j]) ? 1 : 0;
        e = __builtin_amdgcn_readfirstlane(e);
        const int row0 = __builtin_amdgcn_readfirstlane(sb[e] + (pg - pp[e]) * BM);
        u.A = A + (size_t)row0 * rowbytes; u.B = Bt + (size_t)e * ebytes + (size_t)pn * tstepB; u.row0 = row0; u.col0 = pn * BM; return true;
    }
};

struct EpiBf16 {
    static constexpr bool PERM = true;
    bf16_t* O; int ldc; float sc;
    __device__ __forceinline__ void operator()(const f32x4 (&acc)[2][2][4][2], const Unit& u, int wr, int wc, int fr, int fq) const {
        const int row0 = u.row0 + wr * 64 + fr, col0 = u.col0 + wc * 32 + 8 * fq;
#pragma unroll
        for (int ai = 0; ai < 2; ++ai)
#pragma unroll
            for (int m = 0; m < 4; ++m) { bf16_t* rowp = O + (size_t)(row0 + ai * HALF + m * 16) * ldc + col0;
#pragma unroll
                for (int bj = 0; bj < 2; ++bj) { const f32x4 v0 = acc[ai][bj][m][0] * sc, v1 = acc[ai][bj][m][1] * sc;
                    u32x4 w; w.x = cvt_pk_bf16(v0[0], v0[1]); w.y = cvt_pk_bf16(v0[2], v0[3]); w.z = cvt_pk_bf16(v1[0], v1[1]); w.w = cvt_pk_bf16(v1[2], v1[3]);
                    *(u32x4*)(rowp + bj * HALF) = w; } }
    }
};
struct EpiY8 {
    static constexpr bool PERM = true;
    unsigned char* O;
    __device__ __forceinline__ void operator()(const f32x4 (&acc)[2][2][4][2], const Unit& u, int wr, int wc, int fr, int fq) const {
        const int row0 = u.row0 + wr * 64 + fr, col0 = u.col0 + wc * 32 + 8 * fq;
#pragma unroll
        for (int ai = 0; ai < 2; ++ai)
#pragma unroll
            for (int m = 0; m < 4; ++m) { unsigned char* rowp = O + (size_t)(row0 + ai * HALF + m * 16) * DM + col0;
#pragma unroll
                for (int bj = 0; bj < 2; ++bj) { const f32x4 v0 = acc[ai][bj][m][0], v1 = acc[ai][bj][m][1];
                    u32x2 w; w.x = cvt4_fp8(v0[0], v0[1], v0[2], v0[3]); w.y = cvt4_fp8(v1[0], v1[1], v1[2], v1[3]); *(u32x2*)(rowp + bj * HALF) = w; } }
    }
};
struct EpiSwiGLU {
    static constexpr bool PERM = true;
    unsigned char* O; const float* rs;
    __device__ __forceinline__ void operator()(const f32x4 (&acc)[2][2][4][2], const Unit& u, int wr, int wc, int fr, int fq) const {
        const int row0 = u.row0 + wr * 64 + fr, hid0 = (u.col0 + wc * 32 + 8 * fq) >> 1;
#pragma unroll
        for (int ai = 0; ai < 2; ++ai)
#pragma unroll
            for (int m = 0; m < 4; ++m) { unsigned char* rowp = O + (size_t)(row0 + ai * HALF + m * 16) * DEXP + hid0; const float rsv = rs[row0 + ai * HALF + m * 16] * W8_INV;
#pragma unroll
                for (int bj = 0; bj < 2; ++bj) { const f32x4 g = acc[ai][bj][m][0] * rsv, up = acc[ai][bj][m][1] * (rsv * HE_SCALE); float o[4];
#pragma unroll
                    for (int j = 0; j < 4; ++j) { const float s = g[j] / (1.0f + __expf(-g[j])); o[j] = s * up[j]; }
                    *(unsigned*)(rowp + bj * (HALF / 2)) = cvt4_fp8(o[0], o[1], o[2], o[3]); } }
    }
};
struct EpiResid {
    static constexpr bool PERM = true;
    bf16_t* hb; const float* rms; unsigned char* hb8;
    __device__ __forceinline__ void operator()(const f32x4 (&acc)[2][2][4][2], const Unit& u, int wr, int wc, int fr, int fq) const {
        const int row0 = u.row0 + wr * 64 + fr;
        const size_t off0 = (size_t)row0 * DM + (u.col0 + wc * 32 + 8 * fq);
        u32x4 q[2][4][2]; float sc[2][4];
#pragma unroll
        for (int ai = 0; ai < 2; ++ai)
#pragma unroll
            for (int m = 0; m < 4; ++m) { sc[ai][m] = rms[row0 + ai * HALF + m * 16];
#pragma unroll
                for (int bj = 0; bj < 2; ++bj) q[ai][m][bj] = *(const u32x4*)(hb + off0 + (size_t)(ai * HALF + m * 16) * DM + bj * HALF); }
#pragma unroll
        for (int ai = 0; ai < 2; ++ai)
#pragma unroll
            for (int m = 0; m < 4; ++m)
#pragma unroll
                for (int bj = 0; bj < 2; ++bj) { const u32x4 t = q[ai][m][bj]; const float r = sc[ai][m]; const size_t o = off0 + (size_t)(ai * HALF + m * 16) * DM + bj * HALF;
                    const f32x4 v0 = acc[ai][bj][m][0] + (f32x4){bf_lo(t.x), bf_hi(t.x), bf_lo(t.y), bf_hi(t.y)} * r, v1 = acc[ai][bj][m][1] + (f32x4){bf_lo(t.z), bf_hi(t.z), bf_lo(t.w), bf_hi(t.w)} * r;
                    u32x4 w; w.x = cvt_pk_bf16(v0[0], v0[1]); w.y = cvt_pk_bf16(v0[2], v0[3]); w.z = cvt_pk_bf16(v1[0], v1[1]); w.w = cvt_pk_bf16(v1[2], v1[3]);
                    *(u32x4*)(hb + o) = w;
                    u32x2 w8; w8.x = cvt4_fp8(v0[0], v0[1], v0[2], v0[3]); w8.y = cvt4_fp8(v1[0], v1[1], v1[2], v1[3]); *(u32x2*)(hb8 + o) = w8; }
    }
};

template <class Epi, class Sched, bool ALIGN_EPI = true, bool SP2 = true, bool GATHER = false, bool FP8 = false>
__device__ __forceinline__ void gemm_phase(LAS unsigned char* lds, const int wid, const int Kel, const Sched& S, const Epi& E, const char* Ab = nullptr, const LAS int* idx = nullptr) {
    static_assert(!GATHER || SP2, "gather needs the SP2 loop");
    const int lane = lane_now(), tid = (wid << 6) | lane, wr = wid >> 2, wc = wid & 3, fr = lane & 15, fq = lane >> 4;
    const int K = FP8 ? (Kel >> 1) : Kel;
    int nt = K / BK; asm volatile("" : "+s"(nt));
    unsigned voffA[2], voffB[2];
#pragma unroll
    for (int i = 0; i < 2; ++i) { int R, C; stage_rc(tid * 16 + i * 8192, R, C); const int Rb = Epi::PERM ? ((R & ~31) + perm32(R & 31)) : R;
        voffA[i] = (unsigned)(R * K + C) * 2u; voffB[i] = (unsigned)(Rb * K + C) * 2u; }
    unsigned goff[2][2];
#define PG8_GOFF(dst, unit_i) do { const int tz_ = (wid << 6) | lane_now(); _Pragma("unroll") for (int i_ = 0; i_ < 2; ++i_) { int R_, C_; stage_rc(tz_ * 16 + i_ * 8192, R_, C_); \
        _Pragma("unroll") for (int h_ = 0; h_ < 2; ++h_) dst[h_][i_] = (unsigned)idx[(unit_i) * 256 + 128 * h_ + R_] * (unsigned)(K * 2) + (unsigned)(C_ * 2); } } while (0)
    const size_t kstep = (size_t)(BK * 2);
    const size_t hstep = (size_t)HALF * K * 2;
    const unsigned ldsw = (unsigned)wid * 1024u;
    const int aoff = lds_byte(wr * 64 + fr, fq * 8), boff = lds_byte(wc * 32 + fr, fq * 8);
#define PG8_SA(b, h) (((b) * 2 + (h)) * HTB)
#define PG8_SB(b, h) ((4 + (b) * 2 + (h)) * HTB)
#define PG8_STAGE(bufoff, gbase, voff) do { _Pragma("unroll") for (int _i = 0; _i < 2; ++_i) \
        __builtin_amdgcn_global_load_lds((const unsigned*)((const char*)(gbase) + (voff)[_i]), (LAS unsigned*)(lds + (bufoff) + ldsw + _i * 8192), 16, 0, 0); } while (0)
#define PG8_LDA(dst, b, h) do { _Pragma("unroll") for (int m = 0; m < 4; ++m) _Pragma("unroll") for (int k = 0; k < 2; ++k) dst[m][k] = *(const LAS bf16x8*)(lds + PG8_SA(b, h) + aoff + m * 2048 + k * 1024); } while (0)
#define PG8_LDB(dst, b, h) do { _Pragma("unroll") for (int n = 0; n < 2; ++n) _Pragma("unroll") for (int k = 0; k < 2; ++k) dst[n][k] = *(const LAS bf16x8*)(lds + PG8_SB(b, h) + boff + n * 2048 + k * 1024); } while (0)
#define PG8_CAT(f) __builtin_shufflevector(__builtin_bit_cast(i32x4, f[0]), __builtin_bit_cast(i32x4, f[1]), 0, 1, 2, 3, 4, 5, 6, 7)
#define PG8_MMA(ai, bj, At, Bt) do { __builtin_amdgcn_s_setprio(1); _Pragma("unroll") for (int m = 0; m < 4; ++m) _Pragma("unroll") for (int n = 0; n < 2; ++n) { \
        if constexpr (FP8) acc[ai][bj][m][n] = __builtin_amdgcn_mfma_scale_f32_16x16x128_f8f6f4(PG8_CAT(Bt[n]), PG8_CAT(At[m]), acc[ai][bj][m][n], 0, 0, 0, 0, 0, 0); \
        else { _Pragma("unroll") for (int k = 0; k < 2; ++k) acc[ai][bj][m][n] = __builtin_amdgcn_mfma_f32_16x16x32_bf16(Bt[n][k], At[m][k], acc[ai][bj][m][n], 0, 0, 0); } } \
        __builtin_amdgcn_s_setprio(0); } while (0)
#define PG8_WAIT_V(n) asm volatile("s_waitcnt vmcnt(" #n ")" ::: "memory")
#define PG8_WAIT_L(n) asm volatile("s_waitcnt lgkmcnt(" #n ")" ::: "memory")
#define PG8_BAR __builtin_amdgcn_s_barrier()
#define PG8_SCHED __builtin_amdgcn_sched_barrier(0)
    Unit cur, nxt; int ui = 0;
    if (!S.next(0, cur)) return;
    f32x4 acc[2][2][4][2];
#pragma unroll
    for (int a = 0; a < 2; ++a)
#pragma unroll
        for (int b = 0; b < 2; ++b)
#pragma unroll
            for (int m = 0; m < 4; ++m)
#pragma unroll
                for (int n = 0; n < 2; ++n) acc[a][b][m][n] = (f32x4){0.f, 0.f, 0.f, 0.f};
    bf16x8 At[4][2], B0[2][2], B1[2][2];
    const char* cA = cur.A; const char* cB = cur.B;
    if constexpr (GATHER) {
        PG8_GOFF(goff, 0);
        PG8_STAGE(PG8_SB(0, 0), cB, voffB); PG8_STAGE(PG8_SB(0, 1), cB + hstep, voffB); PG8_STAGE(PG8_SA(0, 0), Ab, goff[0]); PG8_STAGE(PG8_SA(0, 1), Ab, goff[1]);
        if (wr == 1) PG8_BAR;
        PG8_WAIT_V(2); PG8_BAR;
        PG8_STAGE(PG8_SB(1, 0), cB + kstep, voffB); PG8_STAGE(PG8_SA(1, 0), Ab + kstep, goff[0]); PG8_STAGE(PG8_SB(1, 1), cB + hstep + kstep, voffB);
        PG8_WAIT_V(6); PG8_BAR;
    } else if constexpr (SP2) {
        PG8_STAGE(PG8_SB(0, 0), cB, voffB); PG8_STAGE(PG8_SB(0, 1), cB + hstep, voffB); PG8_STAGE(PG8_SA(0, 0), cA, voffA); PG8_STAGE(PG8_SA(0, 1), cA + hstep, voffA);
        if (wr == 1) PG8_BAR;
        PG8_WAIT_V(2); PG8_BAR;
        PG8_STAGE(PG8_SB(1, 0), cB + kstep, voffB); PG8_STAGE(PG8_SA(1, 0), cA + kstep, voffA); PG8_STAGE(PG8_SB(1, 1), cB + hstep + kstep, voffB);
        PG8_WAIT_V(6); PG8_BAR;
    } else {
        PG8_STAGE(PG8_SB(0, 0), cB, voffB); PG8_STAGE(PG8_SA(0, 0), cA, voffA); PG8_STAGE(PG8_SB(0, 1), cB + hstep, voffB); PG8_STAGE(PG8_SA(0, 1), cA + hstep, voffA);
        if (wr == 1) PG8_BAR;
        PG8_WAIT_V(4); PG8_BAR;
        PG8_STAGE(PG8_SB(1, 0), cB + kstep, voffB); PG8_STAGE(PG8_SA(1, 0), cA + kstep, voffA); PG8_STAGE(PG8_SB(1, 1), cB + hstep + kstep, voffB);
        PG8_WAIT_V(6); PG8_BAR;
    }
    for (;;) {
        const bool has_next = S.next(ui + 1, nxt);
        const char* nA = has_next ? nxt.A : cA; const char* nB = has_next ? nxt.B : cB;
#pragma unroll 1
        for (int t = 0; t < nt; t += 2) {
            const bool last = (t == nt - 2);
            asm volatile("" : "+v"(voffA[0]), "+v"(voffA[1]), "+v"(voffB[0]), "+v"(voffB[1]));
            const char* a1 = cA + (size_t)(t + 1) * kstep;
            const char* a2 = last ? nA : cA + (size_t)(t + 2) * kstep; const char* b2 = last ? nB : cB + (size_t)(t + 2) * kstep;
            const char* a3 = a2 + kstep; const char* b3 = b2 + kstep;
            if constexpr (GATHER) {
            const char* g1 = Ab + (size_t)(t + 1) * kstep; const char* g2 = last ? Ab : Ab + (size_t)(t + 2) * kstep; const char* g3 = g2 + kstep;
            PG8_LDB(B0, 0, 0); PG8_LDB(B1, 0, 1); PG8_SCHED; PG8_LDA(At, 0, 0); PG8_STAGE(PG8_SA(1, 1), g1, goff[1]);
            PG8_WAIT_V(8); PG8_WAIT_L(0); PG8_BAR; PG8_MMA(0, 0, At, B0); PG8_MMA(0, 1, At, B1); PG8_BAR; PG8_SCHED;
            if (last && has_next) PG8_GOFF(goff, ui + 1);
            PG8_LDA(At, 0, 1); PG8_STAGE(PG8_SB(0, 0), b2, voffB); PG8_STAGE(PG8_SB(0, 1), b2 + hstep, voffB); PG8_STAGE(PG8_SA(0, 0), g2, goff[0]);
            PG8_WAIT_V(8); PG8_WAIT_L(0); PG8_BAR; PG8_MMA(1, 0, At, B0); PG8_MMA(1, 1, At, B1); PG8_BAR; PG8_SCHED;
            PG8_LDB(B0, 1, 0); PG8_LDB(B1, 1, 1); PG8_SCHED; PG8_LDA(At, 1, 0); PG8_STAGE(PG8_SA(0, 1), g2, goff[1]);
            PG8_WAIT_V(8); PG8_WAIT_L(0); PG8_BAR; PG8_MMA(0, 0, At, B0); PG8_MMA(0, 1, At, B1); PG8_BAR; PG8_SCHED;
            PG8_LDA(At, 1, 1); PG8_STAGE(PG8_SB(1, 0), b3, voffB); PG8_STAGE(PG8_SB(1, 1), b3 + hstep, voffB); PG8_STAGE(PG8_SA(1, 0), g3, goff[0]);
            PG8_WAIT_V(8); PG8_WAIT_L(0); PG8_BAR; PG8_MMA(1, 0, At, B0); PG8_MMA(1, 1, At, B1); PG8_BAR; PG8_SCHED;
            } else if constexpr (SP2) {
            PG8_LDB(B0, 0, 0); PG8_LDB(B1, 0, 1); PG8_SCHED; PG8_LDA(At, 0, 0); PG8_STAGE(PG8_SA(1, 1), a1 + hstep, voffA);
            PG8_WAIT_V(8); PG8_WAIT_L(0); PG8_BAR; PG8_MMA(0, 0, At, B0); PG8_MMA(0, 1, At, B1); PG8_BAR; PG8_SCHED;
            PG8_LDA(At, 0, 1); PG8_STAGE(PG8_SB(0, 0), b2, voffB); PG8_STAGE(PG8_SB(0, 1), b2 + hstep, voffB); PG8_STAGE(PG8_SA(0, 0), a2, voffA);
            PG8_WAIT_V(8); PG8_WAIT_L(0); PG8_BAR; PG8_MMA(1, 0, At, B0); PG8_MMA(1, 1, At, B1); PG8_BAR; PG8_SCHED;
            PG8_LDB(B0, 1, 0); PG8_LDB(B1, 1, 1); PG8_SCHED; PG8_LDA(At, 1, 0); PG8_STAGE(PG8_SA(0, 1), a2 + hstep, voffA);
            PG8_WAIT_V(8); PG8_WAIT_L(0); PG8_BAR; PG8_MMA(0, 0, At, B0); PG8_MMA(0, 1, At, B1); PG8_BAR; PG8_SCHED;
            PG8_LDA(At, 1, 1); PG8_STAGE(PG8_SB(1, 0), b3, voffB); PG8_STAGE(PG8_SB(1, 1), b3 + hstep, voffB); PG8_STAGE(PG8_SA(1, 0), a3, voffA);
            PG8_WAIT_V(8); PG8_WAIT_L(0); PG8_BAR; PG8_MMA(1, 0, At, B0); PG8_MMA(1, 1, At, B1); PG8_BAR; PG8_SCHED;
            } else {
            PG8_LDB(B0, 0, 0); PG8_SCHED; PG8_LDA(At, 0, 0); PG8_STAGE(PG8_SA(1, 1), a1 + hstep, voffA);
            PG8_WAIT_L(8); PG8_BAR; PG8_WAIT_L(0); PG8_MMA(0, 0, At, B0); PG8_BAR; PG8_SCHED;
            PG8_LDB(B1, 0, 1); PG8_STAGE(PG8_SB(0, 0), b2, voffB);
            PG8_BAR; PG8_WAIT_L(0); PG8_MMA(0, 1, At, B1); PG8_BAR;
            PG8_LDA(At, 0, 1); PG8_STAGE(PG8_SA(0, 0), a2, voffA);
            PG8_BAR; PG8_WAIT_L(0); PG8_MMA(1, 0, At, B0); PG8_BAR; PG8_SCHED;
            PG8_STAGE(PG8_SB(0, 1), b2 + hstep, voffB);
            PG8_WAIT_V(6); PG8_BAR; PG8_MMA(1, 1, At, B1); PG8_BAR;
            PG8_LDB(B0, 1, 0); PG8_SCHED; PG8_LDA(At, 1, 0); PG8_STAGE(PG8_SA(0, 1), a2 + hstep, voffA);
            PG8_WAIT_L(8); PG8_BAR; PG8_WAIT_L(0); PG8_MMA(0, 0, At, B0); PG8_BAR; PG8_SCHED;
            PG8_LDB(B1, 1, 1); PG8_STAGE(PG8_SB(1, 0), b3, voffB);
            PG8_BAR; PG8_WAIT_L(0); PG8_MMA(0, 1, At, B1); PG8_BAR;
            PG8_LDA(At, 1, 1); PG8_STAGE(PG8_SA(1, 0), a3, voffA);
            PG8_BAR; PG8_WAIT_L(0); PG8_MMA(1, 0, At, B0); PG8_BAR; PG8_SCHED;
            PG8_STAGE(PG8_SB(1, 1), b3 + hstep, voffB);
            PG8_WAIT_V(6); PG8_BAR; PG8_MMA(1, 1, At, B1); PG8_BAR;
            }
        }
        if constexpr (ALIGN_EPI) { if (wr == 0) PG8_BAR; }
        { const int lz = lane_now(); E(acc, cur, wr, wc, lz & 15, lz >> 4); }
        if (!has_next) break;
#pragma unroll
        for (int a = 0; a < 2; ++a)
#pragma unroll
            for (int b = 0; b < 2; ++b)
#pragma unroll
                for (int m = 0; m < 4; ++m)
#pragma unroll
                    for (int n = 0; n < 2; ++n) acc[a][b][m][n] = (f32x4){0.f, 0.f, 0.f, 0.f};
        cur = nxt; cA = nA; cB = nB; ++ui;
        if constexpr (ALIGN_EPI) { if (wr == 1) PG8_BAR; }
    }
    PG8_WAIT_V(0);
    if constexpr (!ALIGN_EPI) { if (wr == 0) PG8_BAR; }
    PG8_BAR;
#undef PG8_GOFF
#undef PG8_CAT
#undef PG8_SA
#undef PG8_SB
#undef PG8_STAGE
#undef PG8_LDA
#undef PG8_LDB
#undef PG8_MMA
#undef PG8_WAIT_V
#undef PG8_WAIT_L
#undef PG8_BAR
#undef PG8_SCHED
}
}

struct Params {
    const float* in[26];
    float* out;
    unsigned char* ws;
    int ph_lo, ph_hi;
};
struct Frame {
    LAS unsigned char* lds;
    volatile LAS unsigned* LC;
    unsigned* ctl;
    unsigned char* ws;
    int G, bid, wid;
};
#define PHASE_IDS() int wid = F.wid; asm volatile("" : "+s"(wid)); const int lane = lane_now(); const int tid = (wid << 6) | lane; (void)tid

__device__ __forceinline__ void tr_item(const float* W, int K, int N, bf16_t* WT, int item, LAS float* scr, int lane, const float* gk, int qscale, int rowmap) {
    const int nblk = N / 32, kb = item / nblk, nb = item % nblk, k0 = 64 * kb, n0 = 32 * nb;
    float tv[32];
#pragma unroll
    for (int i = 0; i < 32; ++i) { const int kk = 2 * i + (lane >> 5); tv[i] = W[(size_t)(k0 + kk) * N + n0 + (lane & 31)]; }
#pragma unroll
    for (int i = 0; i < 32; ++i) { const int kk = 2 * i + (lane >> 5); const int n = n0 + (lane & 31);
        float v = tv[i]; if (gk) v *= gk[k0 + kk]; if (qscale && n >= OFF_Q && n < OFF_K) v *= QSCALE;
        scr[kk * 33 + (lane & 31)] = v; }
    LDS_WAIT(); asm volatile("" ::: "memory");
    const int c = lane & 7;
#pragma unroll
    for (int j = 0; j < 4; ++j) { const int n = (lane >> 3) + 8 * j; const LAS float* s = scr + (8 * c) * 33 + n;
        u32x4 o; o.x = cvt_pk_bf16(s[0 * 33], s[1 * 33]); o.y = cvt_pk_bf16(s[2 * 33], s[3 * 33]); o.z = cvt_pk_bf16(s[4 * 33], s[5 * 33]); o.w = cvt_pk_bf16(s[6 * 33], s[7 * 33]);
        const int ng = n0 + n; const int dr = rowmap == 0 ? ng : (8 * (ng >> 2) + (ng & 3) + (rowmap == 2 ? 4 : 0));
        *(u32x4*)(WT + (size_t)dr * K + k0 + 8 * c) = o; }
    LDS_WAIT(); asm volatile("" ::: "memory");
}
__device__ __forceinline__ void tr_item8(const float* W, int K, int N, unsigned char* WT, int item, LAS float* scr, int lane, const float* gk, int rowmap) {
    const int nblk = N / 32, kb = item / nblk, nb = item % nblk, k0 = 64 * kb, n0 = 32 * nb;
    float tv[32];
#pragma unroll
    for (int i = 0; i < 32; ++i) { const int kk = 2 * i + (lane >> 5); tv[i] = W[(size_t)(k0 + kk) * N + n0 + (lane & 31)]; }
#pragma unroll
    for (int i = 0; i < 32; ++i) { const int kk = 2 * i + (lane >> 5); float v = tv[i] * W8_SCALE; if (gk) v *= gk[k0 + kk]; scr[kk * 33 + (lane & 31)] = v; }
    LDS_WAIT(); asm volatile("" ::: "memory");
    const int c = lane & 3;
#pragma unroll
    for (int j = 0; j < 2; ++j) { const int n = (lane >> 2) + 16 * j; const LAS float* sp = scr + (16 * c) * 33 + n;
        u32x4 o; o.x = cvt4_fp8(sp[0 * 33], sp[1 * 33], sp[2 * 33], sp[3 * 33]); o.y = cvt4_fp8(sp[4 * 33], sp[5 * 33], sp[6 * 33], sp[7 * 33]);
        o.z = cvt4_fp8(sp[8 * 33], sp[9 * 33], sp[10 * 33], sp[11 * 33]); o.w = cvt4_fp8(sp[12 * 33], sp[13 * 33], sp[14 * 33], sp[15 * 33]);
        const int ng = n0 + n; const int dr = rowmap == 0 ? ng : (8 * (ng >> 2) + (ng & 3) + (rowmap == 2 ? 4 : 0));
        *(u32x4*)(WT + (size_t)dr * K + k0 + 16 * c) = o; }
    LDS_WAIT(); asm volatile("" ::: "memory");
}
__device__ __forceinline__ void norm_row_to_bf16(const float* xrow, bf16_t* orow, float* rinv, int lane) {
    const f32x4* xr = (const f32x4*)xrow + lane;
    f32x4 v[8]; float s = 0.f;
#pragma unroll
    for (int j = 0; j < 8; ++j) { v[j] = xr[64 * j]; s += (v[j].x * v[j].x + v[j].y * v[j].y) + (v[j].z * v[j].z + v[j].w * v[j].w); }
    const float rms = sqrtf(wave_sum(s) * (1.f / DM) + RMS_EPS), rstd = 1.0f / rms;
    if (lane == 0) *rinv = rms;
    u32x2* o8 = (u32x2*)orow + lane;
#pragma unroll
    for (int j = 0; j < 8; ++j) { u32x2 w; w.x = cvt_pk_bf16(v[j].x * rstd, v[j].y * rstd); w.y = cvt_pk_bf16(v[j].z * rstd, v[j].w * rstd); o8[64 * j] = w; }
}
__device__ __forceinline__ void norm_rows2_to_bf16(const float* xrow, bf16_t* orow, float* rinv, int lane) {
    const f32x4* xr = (const f32x4*)xrow + lane;
    f32x4 v[16]; float s0 = 0.f, s1 = 0.f;
#pragma unroll
    for (int j = 0; j < 16; ++j) v[j] = xr[64 * j];
#pragma unroll
    for (int j = 0; j < 8; ++j) { s0 += (v[j].x * v[j].x + v[j].y * v[j].y) + (v[j].z * v[j].z + v[j].w * v[j].w); s1 += (v[8 + j].x * v[8 + j].x + v[8 + j].y * v[8 + j].y) + (v[8 + j].z * v[8 + j].z + v[8 + j].w * v[8 + j].w); }
    const float q0 = sqrtf(wave_sum(s0) * (1.f / DM) + RMS_EPS), q1 = sqrtf(wave_sum(s1) * (1.f / DM) + RMS_EPS), r0 = 1.0f / q0, r1 = 1.0f / q1;
    if (lane == 0) { rinv[0] = q0; rinv[1] = q1; }
    u32x2* o8 = (u32x2*)orow + lane;
#pragma unroll
    for (int j = 0; j < 16; ++j) { const float r = j < 8 ? r0 : r1; u32x2 w; w.x = cvt_pk_bf16(v[j].x * r, v[j].y * r); w.y = cvt_pk_bf16(v[j].z * r, v[j].w * r); o8[64 * j] = w; }
}
__device__ __forceinline__ void p0_prologue(Frame& F, const Params& p) {
    PHASE_IDS();
    LAS float* scr = (LAS float*)(F.lds + wid * 16384);
    const int gw = F.bid * 8 + wid, NGW = F.G * 8;
    constexpr int I_IN = 32 * 160, I_OUT = 32 * 64, I_GU = 32 * 16, I_D = 8 * 64, I_G = 2 * 4;
    constexpr int N_IN = 2 * I_IN, N_OUT = 2 * I_OUT, N_GU = 2 * 16 * 2 * I_GU, N_D = 2 * 16 * I_D, N_G = 2 * 2 * 8 * I_G;
    constexpr int NITEMS = N_IN + N_OUT + N_GU + N_D + N_G;
    unsigned char* ws = F.ws;
    for (int it = gw; it < NITEMS; it += NGW) {
        int r = it;
        if (r < N_IN) { const int l = r / I_IN; tr_item(p.in[3] + (size_t)l * DM * NPROJ, DM, NPROJ, (bf16_t*)(ws + WS_WIN) + (size_t)l * NPROJ * DM, r % I_IN, scr, lane, p.in[2] + l * DM, 1, 0); continue; } r -= N_IN;
        if (r < N_OUT) { const int l = r / I_OUT; tr_item(p.in[16] + (size_t)l * DM * DM, DM, DM, (bf16_t*)(ws + WS_WOUT) + (size_t)l * DM * DM, r % I_OUT, scr, lane, nullptr, 0, 0); continue; } r -= N_OUT;
        if (r < N_GU) { const int le = r / (2 * I_GU), rr = r % (2 * I_GU), which = rr / I_GU; const int l = le >> 4;
            tr_item8(p.in[which ? 23 : 22] + (size_t)le * DM * DEXP, DM, DEXP, (unsigned char*)(ws + WS_WGU) + (size_t)le * 1024 * DM, rr % I_GU, scr, lane, p.in[17] + l * DM, which ? 2 : 1); continue; } r -= N_GU;
        if (r < N_D) { const int le = r / I_D; tr_item8(p.in[24] + (size_t)le * DEXP * DM, DEXP, DM, (unsigned char*)(ws + WS_WD) + (size_t)le * DM * DEXP, r % I_D, scr, lane, nullptr, 0); continue; } r -= N_D;
        { const int mi = r / I_G; const int l = mi >> 4, which = (mi >> 3) & 1, g = mi & 7;
          tr_item(p.in[which ? 8 : 6] + (size_t)(l * 8 + g) * 128 * 128, 128, 128, (bf16_t*)(ws + WS_WGATES) + (size_t)((l * 2 + which) * 8 + g) * 128 * 128, r % I_G, scr, lane, nullptr, 0, 0); }
    }
    bf16_t* wr = (bf16_t*)(ws + WS_WR);
    for (int i = F.bid * 512 + tid; i < 2 * 32 * DM; i += F.G * 512) { const int l = i / (32 * DM), o = (i / DM) % 32, k = i % DM;
        const float w0 = o < 4 ? p.in[18][((size_t)l * DM + k) * 4 + o] : o < 20 ? p.in[20][((size_t)l * DM + k) * 16 + (o - 4)] : 0.f;
        const float w = w0 * p.in[17][l * DM + k];
        const unsigned hb_ = cvt_pk_bf16(w, 0.f) & 0xffffu; const float whi = __uint_as_float(hb_ << 16);
        wr[((size_t)(l * 2 + 0) * 32 + o) * DM + k] = (bf16_t)hb_; wr[((size_t)(l * 2 + 1) * 32 + o) * DM + k] = (bf16_t)(cvt_pk_bf16(w - whi, 0.f) & 0xffffu); }
    { float* pb = (float*)(ws + WS_PB);
      for (int i = F.bid * 512 + tid; i < 2 * PBL + DM; i += F.G * 512) {
          if (i >= 2 * PBL) { pb[i] = p.in[25][i - 2 * PBL]; continue; }
          const int l = i / PBL, o = i % PBL; float v = 0.f;
          if (o < PB_CB) v = p.in[4][l * 4096 + o];
          else if (o < PB_BA) v = p.in[5][l * LRUW + o - PB_CB];
          else if (o < PB_BX) v = p.in[7][l * LRUW + o - PB_BA];
          else if (o < PB_SP8) v = p.in[9][l * LRUW + o - PB_BX];
          else if (o < PB_SUBG) v = -8.0f * log1pf(__expf(-p.in[10][l * LRUW + o - PB_SP8]));
          else if (o < PB_RGB) v = p.in[15][l * 128 + o - PB_SUBG];
          else if (o < PB_REB) v = p.in[19][l * 4 + o - PB_RGB];
          else if (o < PB_REB + 16) v = p.in[21][l * 16 + o - PB_REB];
          else if (o == PB_LAM || o == PB_LAM + 1) continue;
          pb[i] = v; }
      if (F.bid == 0 && wid < DEPTH) {
          const int l = wid; const float s1 = wave_sum(p.in[11][l * 64 + lane] * p.in[12][l * 64 + lane]), s2 = wave_sum(p.in[13][l * 64 + lane] * p.in[14][l * 64 + lane]);
          const float lam_init = 0.8f - 0.6f * expf(-0.3f * (float)l);
          if (lane == 0) { pb[l * PBL + PB_LAM] = expf(s1) - expf(s2) + lam_init; pb[l * PBL + PB_LAM + 1] = lam_init; } } }
    bf16_t* xn = (bf16_t*)(ws + WS_XN);
    for (int m = 2 * gw; m < NREAL; m += 2 * NGW) norm_rows2_to_bf16(p.in[0] + (size_t)m * DM, xn + (size_t)m * DM, (float*)(ws + WS_RINV) + m, lane);
    for (int m = NREAL + gw; m < RPAD; m += NGW) {
        if (m < NTOK) norm_row_to_bf16(p.in[1] + (size_t)((m - NREAL) & 15) * DM, xn + (size_t)m * DM, (float*)(ws + WS_RINV) + m, lane);
        else { u32x4* o = (u32x4*)(xn + (size_t)m * DM) + lane;
#pragma unroll
            for (int j = 0; j < 4; ++j) o[64 * j] = (u32x4){0u, 0u, 0u, 0u}; }
    }
}

__device__ __forceinline__ float sigmoidf_(float x) { return __builtin_amdgcn_rcpf(1.0f + __builtin_amdgcn_exp2f(-LOG2E * x)); }
__device__ __forceinline__ float gelu_tanh(float x) { const float z = 0.7978845608028654f * (x + 0.044715f * x * x * x); return x * sigmoidf_(2.0f * z); }
__device__ __forceinline__ float one_minus_exp(float x) {
    const float ser = -x * (1.0f + x * (0.5f + x * (0.16666667f + x * (0.041666668f + x * 0.0083333338f))));
    const float dir = 1.0f - __builtin_amdgcn_exp2f(LOG2E * x);
    return x > -0.25f ? ser : dir;
}
constexpr int LRU_XCB = 0;
constexpr int LRU_ABP = 272;
constexpr int LRU_AS = 17408;
constexpr int LRU_BS = LRU_AS + 128 * LRU_ABP;
constexpr int LRU_XC = LRU_BS + 128 * LRU_ABP;
constexpr int LRU_SEG = LRU_XC + 32768;
template <int PASS>
__device__ __forceinline__ void lru_unit(Frame& F, const Params& p, int l, int unit) {
    const int b = unit >> 7, g = (unit >> 4) & 7, st = unit & 15;
    PHASE_IDS(); const int hi = lane >> 5, r32 = lane & 31;
    const bf16_t* proj = (const bf16_t*)(F.ws + WS_PROJ);
    bf16_t* mix = (bf16_t*)(F.ws + WS_MIX);
    float* lsum = (float*)(F.ws + WS_LRUSUM);
    LAS unsigned char* L = F.lds;
    const int cc = tid & 63, rg = wid;
    const float* pbl = (const float*)(F.ws + WS_PB) + l * PBL;
    const float* cw = pbl + PB_CW + g * 128 + 2 * cc; const float* cbp = pbl + PB_CB + g * 128 + 2 * cc;
    const f32x2 w0 = *(const f32x2*)(cw), w1 = *(const f32x2*)(cw + LRUW), w2 = *(const f32x2*)(cw + 2 * LRUW), w3 = *(const f32x2*)(cw + 3 * LRUW), cb = *(const f32x2*)cbp;
    const int tm = wid >> 2, tn = wid & 3; const int chl = tn * 32 + r32, chg = g * 128 + chl;
    const bf16_t* wat = (const bf16_t*)(F.ws + WS_WGATES) + (size_t)((l * 2 + 0) * 8 + g) * 128 * 128 + (size_t)chl * 128 + 8 * hi;
    const bf16_t* wxt = (const bf16_t*)(F.ws + WS_WGATES) + (size_t)((l * 2 + 1) * 8 + g) * 128 * 128 + (size_t)chl * 128 + 8 * hi;
    bf16x8 waf[8], wxf[8];
#pragma unroll
    for (int s = 0; s < 8; ++s) { waf[s] = *(const bf16x8*)(wat + 16 * s); wxf[s] = *(const bf16x8*)(wxt + 16 * s); }
    const float ba = pbl[PB_BA + chg], bx = pbl[PB_BX + chg];
    const float sp8 = pbl[PB_SP8 + chg];
    const int sc = tid & 127, sg = tid >> 7; const int scg = g * 128 + sc;
    float hstate = 0.f, pstate = 1.f;
    if (PASS == 2) {
#pragma unroll 1
        for (int s0 = 0; s0 < st; s0 += 8) { f32x2 ph[8];
#pragma unroll
            for (int j = 0; j < 8; ++j) ph[j] = *(const f32x2*)(lsum + ((size_t)(b * 16 + (s0 + j < st ? s0 + j : 0)) * LRUW + scg) * 2);
#pragma unroll
            for (int j = 0; j < 8; ++j) asm volatile("" : "+v"(ph[j]));
#pragma unroll
            for (int j = 0; j < 8; ++j) if (s0 + j < st) hstate = ph[j].x * hstate + ph[j].y; } }
    const int ntile = st == 0 ? 17 : 16;
    auto tile_pos0 = [&](int i) { return st == 0 ? (i == 0 ? 0 : NMETA + 64 * (i - 1)) : NMETA + 1024 * st + 64 * i; };
    auto load_u = [&](unsigned (&uu)[11], int i) {
        const int pos0 = tile_pos0(i), nv = (st == 0 && i == 0) ? 16 : 64;
#pragma unroll
        for (int k = 0; k < 11; ++k) { const int pos = pos0 + 8 * rg + k - 3;
            uu[k] = *(const unsigned*)(proj + (size_t)tok_row(b, pos < 0 ? 0 : pos) * NPROJ + OFF_U + g * 128 + 2 * cc); }
#pragma unroll
        for (int k = 0; k < 11; ++k) asm volatile("" : "+v"(uu[k]));
#pragma unroll
        for (int k = 0; k < 11; ++k) { const int rr = 8 * rg + k - 3; if (!(pos0 + rr >= 0 && rr < nv)) uu[k] = 0u; }
    };
    unsigned ucur[11]; load_u(ucur, 0);
#define LT(k) do { } while (0)
    for (int i = 0; i < ntile; ++i) {
        LT(0);
        const int pos0 = tile_pos0(i), nvalid = (st == 0 && i == 0) ? 16 : 64;
        unsigned short ygv[16];
        if (PASS == 2) {
#pragma unroll
            for (int k = 0; k < 16; ++k) { const int tt = 16 * sg + k; ygv[k] = proj[(size_t)tok_row(b, pos0 + tt) * NPROJ + OFF_YG + scg]; }
        }
        {
            float ux[11], uy[11];
#pragma unroll
            for (int k = 0; k < 11; ++k) { ux[k] = bf_lo(ucur[k]); uy[k] = bf_hi(ucur[k]); }
#pragma unroll
            for (int k = 0; k < 8; ++k) { const int rr = 8 * rg + k;
                const float xa = cb.x + w0.x * ux[k + 3] + w1.x * ux[k + 2] + w2.x * ux[k + 1] + w3.x * ux[k];
                const float xb = cb.y + w0.y * uy[k + 3] + w1.y * uy[k + 2] + w2.y * uy[k + 1] + w3.y * uy[k];
                *(LAS unsigned*)(L + LRU_XCB + rr * 272 + 4 * cc) = cvt_pk_bf16(xa, xb);
                *(LAS f32x2*)(L + LRU_XC + rr * 512 + 8 * cc) = (f32x2){xa, xb}; }
        }
        if (i + 1 < ntile) load_u(ucur, i + 1);
        LDS_BARRIER(); LT(1);
        {
            f32x16 aa = {}, ax = {};
#pragma unroll
            for (int s = 0; s < 8; ++s) { const bf16x8 af = *(const LAS bf16x8*)(L + LRU_XCB + (32 * tm + r32) * 272 + 32 * s + 16 * hi);
                aa = __builtin_amdgcn_mfma_f32_32x32x16_bf16(af, waf[s], aa, 0, 0, 0); ax = __builtin_amdgcn_mfma_f32_32x32x16_bf16(af, wxf[s], ax, 0, 0, 0); }
            f32x4 av[4], bv[4];
#pragma unroll
            for (int r = 0; r < 16; ++r) { const int tt = 32 * tm + crow(r, hi);
                const float ra = sigmoidf_(aa[r] + ba), ix = sigmoidf_(ax[r] + bx);
                const float xcv = *(const LAS float*)(L + LRU_XC + tt * 512 + 4 * chl);
                const float la = sp8 * ra; float a = __builtin_amdgcn_exp2f(LOG2E * la);
                float bb = __builtin_amdgcn_sqrtf(1.0f - __builtin_amdgcn_exp2f((2.0f * LOG2E) * la)) * (ix * xcv);
                if (nvalid < 64 && tt >= nvalid) { a = 1.f; bb = 0.f; }
                av[r >> 2][r & 3] = a; bv[r >> 2][r & 3] = bb; }
#pragma unroll
            for (int k = 0; k < 4; ++k) { const int o = chl * LRU_ABP + (32 * tm + 8 * k + 4 * hi) * 4; *(LAS f32x4*)(L + LRU_AS + o) = av[k]; *(LAS f32x4*)(L + LRU_BS + o) = bv[k]; }
        }
        LDS_BARRIER(); LT(2);
        float H = 0.f, P = 1.f;
        f32x4 a4[4], b4[4];
#pragma unroll
        for (int j = 0; j < 4; ++j) { const int o = sc * LRU_ABP + (16 * sg + 4 * j) * 4; a4[j] = *(const LAS f32x4*)(L + LRU_AS + o); b4[j] = *(const LAS f32x4*)(L + LRU_BS + o); }
#pragma unroll
        for (int k = 0; k < 16; ++k) { const float a = a4[k >> 2][k & 3], bb = b4[k >> 2][k & 3];
            H = a * H + bb; P *= a; }
        *(LAS f32x2*)(L + LRU_SEG + (sg * 128 + sc) * 8) = (f32x2){P, H};
        LDS_BARRIER(); LT(3);
        float cin = hstate;
#pragma unroll
        for (int s2 = 0; s2 < 4; ++s2) { const f32x2 ph = *(const LAS f32x2*)(L + LRU_SEG + (s2 * 128 + sc) * 8);
            if (s2 < sg) cin = ph.x * cin + ph.y;
            hstate = ph.x * hstate + ph.y; pstate *= ph.x; }
        if (PASS == 2) {
#pragma unroll
            for (int k = 0; k < 16; ++k) { const int tt = 16 * sg + k;
                const float a = a4[k >> 2][k & 3], bb = b4[k >> 2][k & 3];
                cin = a * cin + bb;
                if (tt < nvalid) { const float hv = cin; const float y = __uint_as_float((unsigned)ygv[k] << 16);
                    const float o = hv * gelu_tanh(y); mix[(size_t)tok_row(b, pos0 + tt) * DM + scg] = (bf16_t)(cvt_pk_bf16(o, 0.f) & 0xffffu); } }
        }
    }
#undef LT
    if (PASS == 1 && sg == 0) *(f32x2*)(lsum + ((size_t)(b * 16 + st) * LRUW + scg) * 2) = (f32x2){pstate, hstate};
    __syncthreads();
}


__device__ __forceinline__ void kmax_phase(Frame& F, int l) {
    PHASE_IDS();
    const bf16_t* proj = (const bf16_t*)(F.ws + WS_PROJ);
    const int gw = F.bid * 8 + wid, NGW = F.G * 8;
    for (int b = 0; b < BATCH; ++b) {
        float mx = 0.f;
        for (int i0 = gw; i0 < TLEN; i0 += 4 * NGW) {
            u32x4 a[4], c[4];
#pragma unroll
            for (int u = 0; u < 4; ++u) { const int i = min(i0 + u * NGW, TLEN - 1); const u32x4* kp = (const u32x4*)(proj + (size_t)tok_row(b, i) * NPROJ + OFF_K + lane * 16); a[u] = kp[0]; c[u] = kp[1]; }
#pragma unroll
            for (int u = 0; u < 4; ++u) { float s = 0.f;
#pragma unroll
                for (int j = 0; j < 4; ++j) { const unsigned x = a[u][j], y = c[u][j]; s += bf_lo(x) * bf_lo(x) + bf_hi(x) * bf_hi(x) + bf_lo(y) * bf_lo(y) + bf_hi(y) * bf_hi(y); }
                s += shx1(s); s += shx2(s);
                mx = fmaxf(mx, s); }
        }
        if ((lane & 3) == 0) atomicMax(F.ctl + CW_KMAX + l * 64 + b * 16 + (lane >> 2), __float_as_uint(mx));
    }
}
constexpr int AT_KSTR = 144, AT_VSTR = 320;
constexpr float ATT_THRESH = 24.0f;
constexpr int AD_K1 = 0, AD_K2 = 8192, AD_V = 16384, AD_SUB = 32768, AD_STAGE = 65536;
constexpr int AT_EX = 0, AT_OS = 65536, AT_OSTR = 272;
static_assert(2 * AD_STAGE <= RING_BYTES && AT_OS + 128 * AT_OSTR <= RING_BYTES, "attention LDS");
__device__ __forceinline__ s16x4 ds_tr16(const LAS unsigned char* p) { typedef short v4i16_t __attribute__((ext_vector_type(4))); return __builtin_bit_cast(s16x4, __builtin_amdgcn_ds_read_tr16_b64_v4i16((LAS v4i16_t*)p)); }

__device__ __forceinline__ void attn_unit(Frame& F, const Params& p, int l, int b, int h, int qb) {
    PHASE_IDS(); const int hi = lane >> 5, r32 = lane & 31, map = wid >> 2, qs = wid & 3;
    const bf16_t* proj = (const bf16_t*)(F.ws + WS_PROJ);
    bf16_t* mix = (bf16_t*)(F.ws + WS_MIX);
    LAS unsigned char* L = F.lds;
    const float slope2 = exp2f(-(float)(h + 1)) * LOG2E;
    const int qi = qs * 32 + r32;
    int qrow, qpos; if (qb >= 0) { qrow = b * SEQ + 128 * qb + qi; qpos = NMETA + 128 * qb + qi; } else { qrow = NREAL + b * NMETA + (qi & 15); qpos = qi & 15; }
    bf16x8 qf[4];
#pragma unroll
    for (int s = 0; s < 4; ++s) qf[s] = *(const bf16x8*)(proj + (size_t)qrow * NPROJ + OFF_Q + h * 128 + map * 64 + 16 * s + 8 * hi);
    const int nreal = qb >= 0 ? 2 * qb + 2 : 0, ntile = nreal + 1;
    float qbound;
    { float s = 0.f;
#pragma unroll
      for (int ss = 0; ss < 4; ++ss)
#pragma unroll
          for (int j = 0; j < 8; ++j) { const float v = __uint_as_float(((unsigned)(unsigned short)qf[ss][j]) << 16); s += v * v; }
      s = sum32(s);
      const float kmx = __uint_as_float(xb_ld(F.ctl + CW_KMAX + l * 64 + b * 16 + h * 2 + map));
      qbound = sqrtf(s * kmx) * 1.0001f + 1e-3f; }
    volatile LAS unsigned* DW = F.LC + 112;
    if (lane == 0) DW[wid] = 0x7fffffffu;
    bool wdone = false;
    const int dk_row = 8 * wid + (lane >> 3), dk_ch = (lane & 7) ^ ((dk_row >> 1) & 7);
    const int dv_row0 = 4 * wid + (lane >> 4), dv_ch = (lane & 15) ^ (4 * (dv_row0 & 3));
    auto dma_tile = [&](int kt, int boff) {
        const int r0 = kt >= 0 ? b * SEQ + 64 * kt : NREAL + b * NMETA;
        const bf16_t* rk = proj + (size_t)(kt >= 0 ? r0 + dk_row : r0 + (dk_row & 15)) * NPROJ + OFF_K + h * 128 + dk_ch * 8;
        const bf16_t* rv0 = proj + (size_t)(kt >= 0 ? r0 + dv_row0 : r0 + (dv_row0 & 15)) * NPROJ + OFF_V + h * 128 + dv_ch * 8;
        const bf16_t* rv1 = proj + (size_t)(kt >= 0 ? r0 + dv_row0 + 32 : r0 + (dv_row0 & 15)) * NPROJ + OFF_V + h * 128 + dv_ch * 8;
        LAS unsigned char* Bd = L + boff;
        __builtin_amdgcn_global_load_lds((const unsigned*)rk, (LAS unsigned*)(Bd + AD_K1 + wid * 1024), 16, 0, 0);
        __builtin_amdgcn_global_load_lds((const unsigned*)(rk + 64), (LAS unsigned*)(Bd + AD_K2 + wid * 1024), 16, 0, 0);
        __builtin_amdgcn_global_load_lds((const unsigned*)rv0, (LAS unsigned*)(Bd + AD_V + wid * 1024), 16, 0, 0);
        __builtin_amdgcn_global_load_lds((const unsigned*)rv1, (LAS unsigned*)(Bd + AD_V + 8192 + wid * 1024), 16, 0, 0);
    };
    const int npair = qb >= 0 ? qb + 1 : 0, niter = npair + 1;
    auto dma_iter = [&](int it, int stage) { if (it < npair) { dma_tile(2 * (npair - 1 - it) + 1, stage); dma_tile(2 * (npair - 1 - it), stage + AD_SUB); } else dma_tile(-1, stage); };
    float m_run = -1e30f, l_run = 0.f;
    f32x16 O[4]; O[0] = f32x16{}; O[1] = f32x16{}; O[2] = f32x16{}; O[3] = f32x16{};
    f32x16 CB;
#pragma unroll
    for (int r = 0; r < 16; ++r) CB[r] = slope2 * (float)((r & 3) + 8 * (r >> 2));
    const f32x16 Z16 = {};
    const int vq = (lane & 15) >> 2, vp = lane & 3, vblk = (lane >> 4) & 1;
    const int vrow_off = (4 * hi + vq) * 256 + 32 * vblk + 8 * vp;
    const int kswz = (r32 >> 1) & 7;
    const int diag_kt = 2 * qb + (qs >> 1);
    bf16x8 pk[4];
#define AT_VRD2(dst, g_) do { _Pragma("unroll") for (int j_ = 0; j_ < 2; ++j_) { const int c_ = 2 * ((g_) & 1) + j_; \
            const s16x4 t0_ = ds_tr16(Vb_ + (16 * ((g_) >> 1)) * 256 + 64 * (c_ ^ vq)), t1_ = ds_tr16(Vb_ + (16 * ((g_) >> 1) + 8) * 256 + 64 * (c_ ^ vq)); \
            dst[j_] = (bf16x8){t0_[0], t0_[1], t0_[2], t0_[3], t1_[0], t1_[1], t1_[2], t1_[3]}; } } while (0)
#define AT_VMM(src, g_) do { O[2 * ((g_) & 1)] = __builtin_amdgcn_mfma_f32_32x32x16_bf16(src[0], pk[(g_) >> 1], O[2 * ((g_) & 1)], 0, 0, 0); \
            O[2 * ((g_) & 1) + 1] = __builtin_amdgcn_mfma_f32_32x32x16_bf16(src[1], pk[(g_) >> 1], O[2 * ((g_) & 1) + 1], 0, 0, 0); __builtin_amdgcn_sched_barrier(0); } while (0)
#define AT_WAIT_BAR() do { asm volatile("s_waitcnt vmcnt(0) lgkmcnt(0)" ::: "memory"); __builtin_amdgcn_s_barrier(); asm volatile("" ::: "memory"); } while (0)
    auto tile = [&](int kt, int boff) {
        const bool is_meta = kt < 0;
        const bool vis = (is_meta || (kt <= diag_kt)) && !wdone;
        if (vis) {
            const bool general = is_meta || (kt == diag_kt);
            f32x16 S0 = general ? Z16 : CB, S1 = S0;
            { const LAS unsigned char* Kb = L + boff + (map ? AD_K2 : AD_K1) + r32 * 128; bf16x8 ka[2], kb[2];
#define AT_KRD(dst, s_) do { dst[0] = *(const LAS bf16x8*)(Kb + 16 * ((2 * (s_) + hi) ^ kswz)); dst[1] = *(const LAS bf16x8*)(Kb + 32 * 128 + 16 * ((2 * (s_) + hi) ^ kswz)); } while (0)
#define AT_KMM(src, s_) do { S0 = __builtin_amdgcn_mfma_f32_32x32x16_bf16(src[0], qf[s_], S0, 0, 0, 0); S1 = __builtin_amdgcn_mfma_f32_32x32x16_bf16(src[1], qf[s_], S1, 0, 0, 0); __builtin_amdgcn_sched_barrier(0); } while (0)
              AT_KRD(ka, 0); AT_KRD(kb, 1); __builtin_amdgcn_sched_barrier(0);
              AT_KMM(ka, 0); AT_KRD(ka, 2); __builtin_amdgcn_sched_barrier(0);
              AT_KMM(kb, 1); AT_KRD(kb, 3); __builtin_amdgcn_sched_barrier(0);
              AT_KMM(ka, 2); AT_KMM(kb, 3);
#undef AT_KRD
#undef AT_KMM
            }
            float c0, c1;
            if (general) {
                const float kpos0 = is_meta ? 0.f : (float)(NMETA + 64 * kt);
                const float dq = (float)qpos - kpos0 - (float)(4 * hi);
#pragma unroll
                for (int r = 0; r < 16; ++r) { const float kc = (float)((r & 3) + 8 * (r >> 2));
                    S0[r] = S0[r] - slope2 * fabsf(dq - kc); S1[r] = S1[r] - slope2 * fabsf(dq - kc - 32.f);
                    if (is_meta) { if (r >= 8) S0[r] = -1e30f; S1[r] = -1e30f; } }
                c0 = 0.f; c1 = 0.f;
            } else {
                c0 = slope2 * (float)(NMETA + 64 * kt + 4 * hi - qpos); c1 = c0 + 32.f * slope2;
            }
            bool skip = false;
            { float mA, mB;
              asm("v_max3_f32 %0, %1, %2, %3" : "=v"(mA) : "v"(S0[0]), "v"(S0[1]), "v"(S0[2])); asm("v_max3_f32 %0, %1, %2, %3" : "=v"(mB) : "v"(S1[0]), "v"(S1[1]), "v"(S1[2]));
#pragma unroll
              for (int r = 3; r < 15; r += 2) { asm("v_max3_f32 %0, %1, %2, %3" : "=v"(mA) : "v"(mA), "v"(S0[r]), "v"(S0[r + 1])); asm("v_max3_f32 %0, %1, %2, %3" : "=v"(mB) : "v"(mB), "v"(S1[r]), "v"(S1[r + 1])); }
              mA = fmaxf(mA, S0[15]); mB = fmaxf(mB, S1[15]);
              float mt = fmaxf(mA + c0, mB + c1);
              if (!general && __all(mt < m_run - ATT_THRESH)) skip = true;
              else {
                mt = max32(mt);
                if (__any(mt > m_run + 8.0f)) {
                    const float m_new = fmaxf(m_run, mt);
                    const float alpha = __builtin_amdgcn_exp2f(m_run - m_new);
                    m_run = m_new; l_run *= alpha;
#pragma unroll
                    for (int c = 0; c < 4; ++c) O[c] *= alpha;
                }
              } }
            if (!skip) {
            const float e0 = c0 - m_run, e1 = c1 - m_run;
            float ps0 = 0.f, ps1 = 0.f;
#pragma unroll
            for (int r = 0; r < 16; ++r) { S0[r] = __builtin_amdgcn_exp2f(S0[r] + e0); S1[r] = __builtin_amdgcn_exp2f(S1[r] + e1); ps0 += S0[r]; ps1 += S1[r]; }
            l_run += ps0 + ps1;
#pragma unroll
            for (int s2 = 0; s2 < 2; ++s2) {
                u32x4 w0, w1;
                w0.x = cvt_pk_bf16(S0[8 * s2 + 0], S0[8 * s2 + 1]); w0.y = cvt_pk_bf16(S0[8 * s2 + 2], S0[8 * s2 + 3]); w0.z = cvt_pk_bf16(S0[8 * s2 + 4], S0[8 * s2 + 5]); w0.w = cvt_pk_bf16(S0[8 * s2 + 6], S0[8 * s2 + 7]);
                w1.x = cvt_pk_bf16(S1[8 * s2 + 0], S1[8 * s2 + 1]); w1.y = cvt_pk_bf16(S1[8 * s2 + 2], S1[8 * s2 + 3]); w1.z = cvt_pk_bf16(S1[8 * s2 + 4], S1[8 * s2 + 5]); w1.w = cvt_pk_bf16(S1[8 * s2 + 6], S1[8 * s2 + 7]);
                pk[s2] = __builtin_bit_cast(bf16x8, w0); pk[2 + s2] = __builtin_bit_cast(bf16x8, w1);
            }
            __builtin_amdgcn_sched_barrier(0);
            { const LAS unsigned char* Vb_ = L + boff + AD_V + vrow_off; bf16x8 va_[2], vb_[2], vc_[2];
              AT_VRD2(va_, 0); AT_VRD2(vb_, 1); __builtin_amdgcn_sched_barrier(0);
              AT_VRD2(vc_, 2); __builtin_amdgcn_sched_barrier(0); AT_VMM(va_, 0);
              AT_VRD2(va_, 3); __builtin_amdgcn_sched_barrier(0); AT_VMM(vb_, 1);
              AT_VRD2(vb_, 4); __builtin_amdgcn_sched_barrier(0); AT_VMM(vc_, 2);
              AT_VRD2(vc_, 5); __builtin_amdgcn_sched_barrier(0); AT_VMM(va_, 3);
              AT_VRD2(va_, 6); __builtin_amdgcn_sched_barrier(0); AT_VMM(vb_, 4);
              AT_VRD2(vb_, 7); __builtin_amdgcn_sched_barrier(0); AT_VMM(vc_, 5);
              AT_VMM(va_, 6); AT_VMM(vb_, 7); }
            }
        }
        if (!wdone && !is_meta) {
            const float dmin = (float)(qpos - (NMETA + 64 * kt) + 1);
            const bool c = qbound - slope2 * dmin < m_run - ATT_THRESH;
            if (__all(c)) wdone = true;
        }
    };
    asm volatile("s_waitcnt vmcnt(0)" ::: "memory");
    dma_iter(0, 0);
    AT_WAIT_BAR();
    int stage = 0;
    for (int it = 0; it < niter; ++it) {
        if (it + 1 < niter) dma_iter(it + 1, stage ^ AD_STAGE);
        { const int nsub = it < npair ? 2 : 1, kt0 = it < npair ? 2 * (npair - 1 - it) + 1 : -1;
#pragma unroll 1
          for (int sub = 0; sub < nsub; ++sub) { tile(kt0 - sub, stage + sub * AD_SUB); __builtin_amdgcn_sched_barrier(0); } }
        if (wdone && lane == 0 && DW[wid] == 0x7fffffffu) DW[wid] = (unsigned)it;
        stage ^= AD_STAGE;
        AT_WAIT_BAR();
        { const u32x4 d0 = *(const LAS u32x4*)(F.lds + LCTL_OFF + 112 * 4), d1 = *(const LAS u32x4*)(F.lds + LCTL_OFF + 116 * 4);
          const unsigned dm = max(max(max(d0.x, d0.y), max(d0.z, d0.w)), max(max(d1.x, d1.y), max(d1.z, d1.w)));
          if (dm <= (unsigned)it) break; }
    }
#undef AT_VRD2
#undef AT_VMM
#undef AT_WAIT_BAR
    __syncthreads();
    const float lt = sum32(l_run);
    const float inv = 1.0f / lt;
    if (map == 1) {
#pragma unroll
        for (int c = 0; c < 4; ++c)
#pragma unroll
            for (int r = 0; r < 16; ++r) *(LAS float*)(L + AT_EX + ((32 * c + crow(r, hi)) * 128 + qi) * 4) = O[c][r] * inv;
    }
    __syncthreads();
    if (map == 0) {
        const float* pbl = (const float*)(F.ws + WS_PB) + l * PBL;
        const float lam = pbl[PB_LAM], lam_init = pbl[PB_LAM + 1];
        float ss = 0.f;
#pragma unroll
        for (int c = 0; c < 4; ++c)
#pragma unroll
            for (int r = 0; r < 16; ++r) { const float o2 = *(const LAS float*)(L + AT_EX + ((32 * c + crow(r, hi)) * 128 + qi) * 4); const float o = O[c][r] * inv - lam * o2; O[c][r] = o; ss += o * o; }
        ss = sum32(ss);
        const float rn = (1.0f / sqrtf(ss * (1.f / 128.f) + RMS_EPS)) * (1.0f - lam_init);
#pragma unroll
        for (int c = 0; c < 4; ++c)
#pragma unroll
            for (int r = 0; r < 16; r += 2) { const int dv = 32 * c + crow(r, hi);
                const float g0 = pbl[PB_SUBG + dv], g1 = pbl[PB_SUBG + dv + 1];
                *(LAS unsigned*)(L + AT_OS + qi * AT_OSTR + dv * 2) = cvt_pk_bf16(O[c][r] * rn * g0, O[c][r + 1] * rn * g1); }
    }
    __syncthreads();
#pragma unroll
    for (int i = 0; i < 4; ++i) { const int idx = tid + 512 * i, row = idx >> 4, ch = idx & 15;
        const bool ok = qb >= 0 || row < 16;
        if (ok) { const int orow = qb >= 0 ? b * SEQ + 128 * qb + row : NREAL + b * NMETA + row;
            *(u32x4*)(mix + (size_t)orow * DM + LRUW + h * 128 + ch * 8) = *(const LAS u32x4*)(L + AT_OS + row * AT_OSTR + ch * 16); } }
    __syncthreads();
}


constexpr int NT32 = (NTOK + 31) / 32;
constexpr int RT_PART = 0;
constexpr int RT_SSQ = 2 * 4 * 32 * 33 * 4;
__device__ __forceinline__ void router_phase(Frame& F, const Params& p, int l) {
    const bool count = true;
    PHASE_IDS(); const int hi = lane >> 5, r32 = lane & 31;
    const int ntile_b = F.bid < NT32 ? (NT32 - F.bid + F.G - 1) / F.G : 0;
    volatile LAS unsigned* hist = F.LC + 16;
    if (tid < 16) hist[tid] = 0u;
    __syncthreads();
    const bf16_t* wrh = (const bf16_t*)(F.ws + WS_WR) + (size_t)(l * 2) * 32 * DM; const bf16_t* wrl = wrh + (size_t)32 * DM;
    const bf16_t* hbp = (const bf16_t*)(F.ws + WS_XN);
    const float* rgb = (const float*)(F.ws + WS_PB) + l * PBL + PB_RGB; const float* reb = (const float*)(F.ws + WS_PB) + l * PBL + PB_REB;
    u32x4* tokinfo = (u32x4*)(F.ws + WS_TOKINFO);
    LAS float* part = (LAS float*)(F.lds + RT_PART); LAS float* ssqp = (LAS float*)(F.lds + RT_SSQ);
    for (int k0 = 0; k0 < ntile_b; k0 += 4) {
        const bool lone = (ntile_b - k0 == 1);
        const int ts = lone ? 0 : (wid & 3), ksl = lone ? wid : (wid >> 2), klen = lone ? 256 : 1024;
        if (k0 + ts < ntile_b) {
            int row = 32 * (F.bid + F.G * (k0 + ts)) + r32; row = row < NTOK ? row : NTOK - 1;
            const bf16_t* hp = hbp + (size_t)row * DM + ksl * klen + 8 * hi;
            const bf16_t* wph = wrh + (size_t)r32 * DM + ksl * klen + 8 * hi; const bf16_t* wpl = wrl + (size_t)r32 * DM + ksl * klen + 8 * hi;
            f32x16 acc = {}; float ssq = 0.f;
#pragma unroll 1
            for (int c0 = 0; c0 < klen / 16; c0 += 8) {
                bf16x8 av[8], wh[8], wl[8];
#pragma unroll
                for (int u = 0; u < 8; ++u) { av[u] = *(const bf16x8*)(hp + 16 * (c0 + u)); wh[u] = *(const bf16x8*)(wph + 16 * (c0 + u)); wl[u] = *(const bf16x8*)(wpl + 16 * (c0 + u)); }
                __builtin_amdgcn_sched_barrier(0);
#pragma unroll
                for (int u = 0; u < 8; ++u) {
#pragma unroll
                    for (int j = 0; j < 8; ++j) { const float v = __uint_as_float(((unsigned)(unsigned short)av[u][j]) << 16); ssq += v * v; }
                    acc = __builtin_amdgcn_mfma_f32_32x32x16_bf16(av[u], wh[u], acc, 0, 0, 0); acc = __builtin_amdgcn_mfma_f32_32x32x16_bf16(av[u], wl[u], acc, 0, 0, 0); }
                __builtin_amdgcn_sched_barrier(0);
            }
            ssq = sum32(ssq);
#pragma unroll
            for (int r = 0; r < 16; ++r) part[(wid * 32 + crow(r, hi)) * 33 + r32] = acc[r];
            if (hi == 0) ssqp[wid * 32 + r32] = ssq;
        }
        __syncthreads();
        if (tid < 128) {
            const int ts2 = tid >> 5, i = tid & 31; const int row = 32 * (F.bid + F.G * (k0 + ts2)) + i;
            if (k0 + ts2 < ntile_b && row < NTOK && !(lone && ts2 > 0)) {
                const int nsl = lone ? 8 : 2, sst = lone ? 1 : 4;
                float sq = 0.f; for (int sl = 0; sl < nsl; ++sl) sq += ssqp[(ts2 + sst * sl) * 32 + i];
                const float rstd = 1.0f / sqrtf(sq * (1.f / DM) + RMS_EPS);
                float lg[20];
#pragma unroll
                for (int o = 0; o < 20; ++o) { float a = 0.f; for (int sl = 0; sl < nsl; ++sl) a += part[((ts2 + sst * sl) * 32 + i) * 33 + o]; lg[o] = a * rstd + (o < 4 ? rgb[o] : reb[o - 4]); }
                int gi = 0; float gm = lg[0];
#pragma unroll
                for (int o = 1; o < 4; ++o) if (lg[o] > gm) { gm = lg[o]; gi = o; }
                float gs = 0.f;
#pragma unroll
                for (int o = 0; o < 4; ++o) gs += __expf(lg[o] - gm);
                const float gprob = 1.0f / gs;
                float li[4];
#pragma unroll
                for (int j = 0; j < 4; ++j) li[j] = gi == 0 ? lg[4 + j] : gi == 1 ? lg[8 + j] : gi == 2 ? lg[12 + j] : lg[16 + j];
                int i1 = 0; float v1 = li[0];
#pragma unroll
                for (int j = 1; j < 4; ++j) if (li[j] > v1) { v1 = li[j]; i1 = j; }
                int i2 = -1; float v2 = -3.0e38f;
#pragma unroll
                for (int j = 0; j < 4; ++j) if (j != i1 && li[j] > v2) { v2 = li[j]; i2 = j; }
                const float e2 = __expf(v2 - v1); const float p1 = 1.0f / (1.0f + e2), p2 = e2 / (1.0f + e2);
                const int ea = gi * 4 + i1, eb = gi * 4 + i2;
                u32x4 ti; ti.x = (unsigned)ea | ((unsigned)eb << 8); ti.y = __float_as_uint(p1 * gprob); ti.z = __float_as_uint(p2 * gprob); ti.w = __float_as_uint(rstd);
                tokinfo[row] = ti;
                if (count) { lds_add((LAS unsigned*)&hist[ea], 1u); lds_add((LAS unsigned*)&hist[eb], 1u); }
            }
        }
        __syncthreads();
    }
    if (tid < 16 && count) { const unsigned hc = hist[tid]; ((unsigned*)(F.ws + WS_HIST))[F.bid * 16 + tid] = hc; if (hc) atomicAdd(F.ctl + CW_CNT + l * 16 + tid, hc); }
    __syncthreads();
}

__device__ __forceinline__ void moe_tables(Frame& F, int l) {
    const int tz = (F.wid << 6) | lane_now();
    if (tz < 64) {
        const int ln = tz & 63; const int c = ln < 16 ? (int)xb_ld(F.ctl + CW_CNT + l * 16 + ln) : 0; const int np = (c + 255) >> 8;
        int inc = np;
#pragma unroll
        for (int o = 1; o < 16; o <<= 1) { const int t = __builtin_amdgcn_ds_bpermute((ln - o) << 2, inc); if (ln >= o) inc += t; }
        if (ln < 16) { F.LC[32 + ln] = (unsigned)(inc - np); F.LC[64 + ln] = (unsigned)((inc - np) * 256); }
        if (ln == 15) { F.LC[48] = (unsigned)inc; F.LC[80] = (unsigned)(inc * 256); } }
    __syncthreads();
}

__device__ __forceinline__ void slots_phase(Frame& F, const Params& p, int l) {
    PHASE_IDS();
    const int ntile_b = F.bid < NT32 ? (NT32 - F.bid + F.G - 1) / F.G : 0;
    moe_tables(F, l);
    volatile LAS unsigned* boff = F.LC + 96;
    if (tid < 16) boff[tid] = 0u;
    __syncthreads();
    { const unsigned* hg = (const unsigned*)(F.ws + WS_HIST); const int e = tid & 15; unsigned sacc = 0;
#pragma unroll 8
      for (int bb = tid >> 4; bb < F.bid; bb += 32) sacc += hg[bb * 16 + e];
      if (sacc) lds_add((LAS unsigned*)&boff[e], sacc); }
    __syncthreads();
    const u32x4* tokinfo = (const u32x4*)(F.ws + WS_TOKINFO);
    u32x2* tokslot = (u32x2*)(F.ws + WS_TOKSLOT);
    int* tokmap = (int*)(F.ws + WS_TOKMAP); float* rslot = (float*)(F.ws + WS_RSLOT);
    if (wid == 0) {
        volatile LAS unsigned* run = F.LC + 128;
        if (lane < 16) run[lane] = F.LC[64 + lane] + boff[lane];
        for (int k0 = 0; k0 < ntile_b; k0 += 2) {
            const int kk = k0 + (lane >> 5); const int row = 32 * (F.bid + F.G * kk) + (lane & 31); const bool ok = kk < ntile_b && row < NTOK;
            u32x4 ti = (u32x4){0xffffu, 0u, 0u, 0u}; if (ok) ti = tokinfo[row];
            const unsigned ea = ti.x & 0xffu, eb = (ti.x >> 8) & 0xffu;
            unsigned sa = 0, sb2 = 0;
#pragma unroll 1
            for (int e = 0; e < 16; ++e) {
                const bool hit = ok && (ea == (unsigned)e || eb == (unsigned)e);
                const unsigned long long mk = __ballot(hit);
                const unsigned rank = __popcll(mk & ((1ull << lane) - 1ull));
                const unsigned cur = run[e];
                if (ea == (unsigned)e) sa = cur + rank;
                if (eb == (unsigned)e) sb2 = cur + rank;
                if (lane == 0) run[e] = cur + (unsigned)__popcll(mk);
            }
            if (ok) { tokslot[row] = (u32x2){sa, sb2}; tokmap[sa] = row; tokmap[sb2] = row; const float rs = __uint_as_float(ti.w); rslot[sa] = rs; rslot[sb2] = rs; }
        }
    }
    if (F.bid < 16) {
        const int e = F.bid; const int c = (int)xb_ld(F.ctl + CW_CNT + l * 16 + e), base = (int)F.LC[64 + e], pc = ((c + 255) >> 8) << 8;
        for (int i = c + tid; i < pc; i += 512) { tokmap[base + i] = 0; rslot[base + i] = 0.f; }
    }
    __syncthreads();
}

__device__ __forceinline__ void combine_phase(Frame& F, const Params& p, int l) {
    PHASE_IDS(); const int gw = F.bid * 8 + wid, NGW = F.G * 8;
    const u32x4* tokinfo = (const u32x4*)(F.ws + WS_TOKINFO);
    const u32x2* tokslot = (const u32x2*)(F.ws + WS_TOKSLOT);
    const unsigned char* y = (const unsigned char*)(F.ws + WS_PROJ);
    bf16_t* xn = (bf16_t*)(F.ws + WS_XN);
    const bool lastl = (l == DEPTH - 1);
    const int nrows = lastl ? NREAL : NTOK;
    u32x4 ti_n = (u32x4){0u, 0u, 0u, 0u}; u32x2 ts_n = (u32x2){0u, 0u};
    if (gw < nrows) { ti_n = tokinfo[gw]; ts_n = tokslot[gw]; }
    for (int row = gw; row < nrows; row += NGW) {
        const u32x4 ti = ti_n; const u32x2 ts = ts_n;
        { const int nr = row + NGW < nrows ? row + NGW : row; ti_n = tokinfo[nr]; ts_n = tokslot[nr]; }
        asm volatile("" ::: "memory");
        const float wa = __uint_as_float(ti.y) * Y8_INV, wb = __uint_as_float(ti.z) * Y8_INV;
        const u32x4* hb = (const u32x4*)(xn + (size_t)row * DM) + lane;
        const u32x2* ya = (const u32x2*)(y + (size_t)ts.x * DM) + lane; const u32x2* yb = (const u32x2*)(y + (size_t)ts.y * DM) + lane;
        u32x4 hq[4]; u32x2 aq[4], bq[4];
#pragma unroll
        for (int j = 0; j < 4; ++j) { hq[j] = hb[64 * j]; aq[j] = ya[64 * j]; bq[j] = yb[64 * j]; }
        float v[4][8]; float s = 0.f;
#pragma unroll
        for (int j = 0; j < 4; ++j)
#pragma unroll
            for (int w2 = 0; w2 < 2; ++w2) {
                const auto a0 = __builtin_amdgcn_cvt_pk_f32_fp8((int)aq[j][w2], false), a1 = __builtin_amdgcn_cvt_pk_f32_fp8((int)aq[j][w2], true);
                const auto b0 = __builtin_amdgcn_cvt_pk_f32_fp8((int)bq[j][w2], false), b1 = __builtin_amdgcn_cvt_pk_f32_fp8((int)bq[j][w2], true);
                const unsigned h0 = hq[j][2 * w2], h1 = hq[j][2 * w2 + 1];
                const float v0 = bf_lo(h0) + wa * a0[0] + wb * b0[0], v1 = bf_hi(h0) + wa * a0[1] + wb * b0[1], v2 = bf_lo(h1) + wa * a1[0] + wb * b1[0], v3 = bf_hi(h1) + wa * a1[1] + wb * b1[1];
                v[j][4 * w2] = v0; v[j][4 * w2 + 1] = v1; v[j][4 * w2 + 2] = v2; v[j][4 * w2 + 3] = v3; s += (v0 * v0 + v1 * v1) + (v2 * v2 + v3 * v3); }
        const float rms = sqrtf(wave_sum(s) * (1.f / DM) + RMS_EPS), rstd = 1.0f / rms;
        if (!lastl) {
            if (lane == 0) ((float*)(F.ws + WS_RINV))[row] = rms;
            u32x4* o8 = (u32x4*)(xn + (size_t)row * DM) + lane;
#pragma unroll
            for (int j = 0; j < 4; ++j) { u32x4 wn;
#pragma unroll
                for (int e = 0; e < 4; ++e) wn[e] = cvt_pk_bf16(v[j][2 * e] * rstd, v[j][2 * e + 1] * rstd);
                o8[64 * j] = wn; }
        } else {
            const float* gp = (const float*)(F.ws + WS_PB) + PB_FING + lane * 8; float* op = p.out + (size_t)row * DM + lane * 8;
#pragma unroll
            for (int j = 0; j < 4; ++j) { const f32x4 g0 = *(const f32x4*)(gp + 512 * j), g1 = *(const f32x4*)(gp + 512 * j + 4);
                { *(f32x4*)(op + 512 * j) = (f32x4){v[j][0] * rstd * g0.x, v[j][1] * rstd * g0.y, v[j][2] * rstd * g0.z, v[j][3] * rstd * g0.w};
                            *(f32x4*)(op + 512 * j + 4) = (f32x4){v[j][4] * rstd * g1.x, v[j][5] * rstd * g1.y, v[j][6] * rstd * g1.z, v[j][7] * rstd * g1.w}; } }
        }
    }
}

template <class Sink>
__device__ __forceinline__ void meta_gemm_group(LAS unsigned char* lds, int wid, const bf16_t* A, const bf16_t* Bt, int K, const Sink& sink) {
    asm volatile("" : "+s"(wid)); const int lane = lane_now(), tid = (wid << 6) | lane; const int hi = lane >> 5, r32 = lane & 31;
    const int kper = K >> 3;
    const bf16_t* ap = A + (size_t)r32 * K + wid * kper + 8 * hi; const bf16_t* bp = Bt + (size_t)r32 * K + wid * kper + 8 * hi;
    f32x16 acc = {};
#pragma unroll 8
    for (int sidx = 0; sidx < kper / 16; ++sidx) { const bf16x8 a = *(const bf16x8*)(ap + 16 * sidx), bq = *(const bf16x8*)(bp + 16 * sidx); acc = __builtin_amdgcn_mfma_f32_32x32x16_bf16(a, bq, acc, 0, 0, 0); }
    LAS float* part = (LAS float*)lds;
#pragma unroll
    for (int r = 0; r < 16; ++r) part[(wid * 32 + crow(r, hi)) * 33 + r32] = acc[r];
    __syncthreads();
#pragma unroll
    for (int o = 0; o < 2; ++o) { const int e = tid + 512 * o, row = e >> 5, col = e & 31; float v = 0.f;
#pragma unroll
        for (int w = 0; w < 8; ++w) v += part[(w * 32 + row) * 33 + col];
        sink(row, col, v); }
    __syncthreads();
}

constexpr int PH_PER_LAYER = 9, N_PHASES = 1 + DEPTH * PH_PER_LAYER;
__global__ void __launch_bounds__(512, 2) mega_fwd(Params p) {
    extern __shared__ __attribute__((aligned(16))) unsigned char lds_raw[];
    Frame F;
    F.lds = (LAS unsigned char*)lds_raw; F.LC = (volatile LAS unsigned*)(F.lds + LCTL_OFF);
    F.G = gridDim.x; F.bid = blockIdx.x; F.wid = __builtin_amdgcn_readfirstlane(threadIdx.x >> 6);
    F.ws = p.ws; F.ctl = (unsigned*)(p.ws + WS_CTL);
    for (int u = threadIdx.x; u < (LDS_BYTES - LCTL_OFF) / 4; u += 512) F.LC[u] = 0u;
    __syncthreads();
    XcdBarrier bar; bar.bar = F.ctl + CW_BAR; bar.x = 0; bar.st = nullptr; bar.wid = F.wid;
    const int lo = p.ph_lo, hi = p.ph_hi;
    if (hi - lo > 1) { bar = xcd_barrier_post(F.ctl + CW_BAR, F.LC + 8, F.wid); xcd_barrier_census(bar); }
#define IN(k) (lo <= (k) && (k) < hi)
#define REBASE() do { unsigned char* w_ = p.ws; asm volatile("" : "+s"(w_)); F.ws = w_; F.ctl = (unsigned*)(w_ + WS_CTL); } while (0)
#define SEAM(k) do { if (IN(k) && IN((k) + 1)) xcd_barrier(bar); } while (0)
    if (IN(0)) p0_prologue(F, p);
    SEAM(0);
    for (int l = 0; l < DEPTH; ++l) {
        const int pb = 1 + l * PH_PER_LAYER;
        if (IN(pb + 0)) { REBASE();
            { bf16_t* projm = (bf16_t*)(F.ws + WS_PROJ) + (size_t)NREAL * NPROJ;
              for (int g = F.bid; g < NPROJ / 32; g += F.G)
                  meta_gemm_group(F.lds, F.wid, (const bf16_t*)(F.ws + WS_XN) + (size_t)NREAL * DM, (const bf16_t*)(F.ws + WS_WIN) + ((size_t)l * NPROJ + 32 * g) * DM, DM,
                                  [&](int row, int col, float v) { projm[(size_t)row * NPROJ + 32 * g + col] = (bf16_t)(cvt_pk_bf16(v, 0.f) & 0xffffu); }); }
            pg8::DenseOrder S; S.init(F.ws + WS_XN, F.ws + WS_WIN + (size_t)l * NPROJ * DM * 2, NREAL, NPROJ, DM, F.G, F.bid);
            pg8::EpiBf16 E{(bf16_t*)(F.ws + WS_PROJ), NPROJ, 1.0f};
            pg8::gemm_phase<pg8::EpiBf16, pg8::DenseOrder>(F.lds, F.wid, DM, S, E);
        }
        SEAM(pb + 0);
        if (IN(pb + 1)) { REBASE();
            for (int u = F.bid; u < 256; u += F.G) lru_unit<1>(F, p, l, u);
            kmax_phase(F, l); }
        SEAM(pb + 1);
        if (IN(pb + 2)) { REBASE();
            for (int u = F.bid; u < 256; u += F.G) lru_unit<2>(F, p, l, u);
            for (;;) {
                __syncthreads();
                if (F.wid == 0 && lane_now() == 0) F.LC[0] = atomicAdd(F.ctl + CW_QUEUE + l * 64, 1u);
                __syncthreads();
                const int u = (int)F.LC[0];
                if (u >= 16 * 129) break;
                const int qb = 127 - (u >> 4), bh = u & 15;
                attn_unit(F, p, l, bh >> 3, bh & 7, qb);
            }
        }
        SEAM(pb + 2);
        if (IN(pb + 3)) { REBASE();
            { bf16_t* hbm = (bf16_t*)(F.ws + WS_XN) + (size_t)NREAL * DM; unsigned char* hbm8 = (unsigned char*)(F.ws + WS_HB8) + (size_t)NREAL * DM; const float* rmsm = (const float*)(F.ws + WS_RINV) + NREAL;
              for (int g = F.bid; g < DM / 32; g += F.G)
                  meta_gemm_group(F.lds, F.wid, (const bf16_t*)(F.ws + WS_MIX) + (size_t)NREAL * DM, (const bf16_t*)(F.ws + WS_WOUT) + ((size_t)l * DM + 32 * g) * DM, DM,
                                  [&](int row, int col, float v) { const int c = 32 * g + col;
                                      const float bs = __uint_as_float((unsigned)hbm[(size_t)row * DM + c] << 16) * rmsm[row];
                                      hbm[(size_t)row * DM + c] = (bf16_t)(cvt_pk_bf16(bs + v, 0.f) & 0xffffu); hbm8[(size_t)row * DM + c] = (unsigned char)(cvt4_fp8(bs + v, 0.f, 0.f, 0.f) & 0xffu); }); }
            pg8::DenseOrder S; S.init(F.ws + WS_MIX, F.ws + WS_WOUT + (size_t)l * DM * DM * 2, NREAL, DM, DM, F.G, F.bid);
            pg8::EpiResid E{(bf16_t*)(F.ws + WS_XN), (const float*)(F.ws + WS_RINV), (unsigned char*)(F.ws + WS_HB8)};
            pg8::gemm_phase<pg8::EpiResid, pg8::DenseOrder>(F.lds, F.wid, DM, S, E);
        }
        SEAM(pb + 3);
        if (IN(pb + 4)) { REBASE(); router_phase(F, p, l); }
        SEAM(pb + 4);
        if (IN(pb + 5)) { REBASE(); slots_phase(F, p, l); }
        SEAM(pb + 5);
        if (IN(pb + 6)) { REBASE();
            moe_tables(F, l);
            pg8::MoeOrder S{(const char*)(F.ws + WS_HB8), (const char*)(F.ws + WS_WGU + (size_t)l * 16 * 1024 * DM), (size_t)0, (size_t)1024 * DM, (size_t)256 * DM, 4, F.G, F.bid,
                            (const LAS int*)(F.lds + LCTL_OFF + 32 * 4), (const LAS int*)(F.lds + LCTL_OFF + 64 * 4)};
            pg8::EpiSwiGLU E{(unsigned char*)(F.ws + WS_HE), (const float*)(F.ws + WS_RSLOT)};
            { LAS int* idxt = (LAS int*)(F.lds + LIDX_OFF); const int* tokmap = (const int*)(F.ws + WS_TOKMAP); pg8::Unit uu;
              const int tz = (F.wid << 6) | lane_now();
#pragma unroll 1
              for (int i = 0; i < MAXGU; ++i) { if (!S.next(i, uu)) break; if (tz < 256) idxt[i * 256 + tz] = tokmap[uu.row0 + tz]; }
              __syncthreads(); }
            pg8::gemm_phase<pg8::EpiSwiGLU, pg8::MoeOrder, true, true, true, true>(F.lds, F.wid, DM, S, E, (const char*)(F.ws + WS_HB8), (const LAS int*)(F.lds + LIDX_OFF));
        }
        SEAM(pb + 6);
        if (IN(pb + 7)) { REBASE();
            moe_tables(F, l);
            pg8::MoeOrder S{(const char*)(F.ws + WS_HE), (const char*)(F.ws + WS_WD + (size_t)l * 16 * DM * DEXP), (size_t)DEXP, (size_t)DM * DEXP, (size_t)256 * DEXP, 8, F.G, F.bid,
                            (const LAS int*)(F.lds + LCTL_OFF + 32 * 4), (const LAS int*)(F.lds + LCTL_OFF + 64 * 4)};
            pg8::EpiY8 E{(unsigned char*)(F.ws + WS_PROJ)};
            pg8::gemm_phase<pg8::EpiY8, pg8::MoeOrder, true, true, false, true>(F.lds, F.wid, DEXP, S, E);
        }
        SEAM(pb + 7);
        if (IN(pb + 8)) { REBASE(); combine_phase(F, p, l); }
        SEAM(pb + 8);
    }
#undef IN
#undef REBASE
#undef SEAM
}

extern "C" void kernel_launch(void* const* d_in, const int* in_sizes, int n_in, void* d_out, int out_size, void* d_ws, size_t ws_size, hipStream_t stream) {
    static int grid = 0;
    if (grid == 0) {
        if (n_in != 26 || out_size != NREAL * DM || ws_size < WS_END) { fprintf(stderr, "kernel_launch: unexpected shapes (n_in %d out %d ws %zu)\n", n_in, out_size, ws_size); grid = -1; return; }
        int dev = 0, cus = 0, per_cu = 0;
        if (hipGetDevice(&dev) != hipSuccess || hipDeviceGetAttribute(&cus, hipDeviceAttributeMultiprocessorCount, dev) != hipSuccess) { grid = -1; return; }
        if (hipFuncSetAttribute((const void*)mega_fwd, hipFuncAttributeMaxDynamicSharedMemorySize, LDS_BYTES) != hipSuccess) { fprintf(stderr, "kernel_launch: hipFuncSetAttribute failed\n"); grid = -1; return; }
        if (hipOccupancyMaxActiveBlocksPerMultiprocessor(&per_cu, (const void*)mega_fwd, 512, LDS_BYTES) != hipSuccess || per_cu < 1) { fprintf(stderr, "kernel_launch: occupancy query says %d\n", per_cu); (void)hipGetLastError(); }
        grid = cus;
        if (grid > 1024) grid = 1024;
    }
    if (grid < 0) return;
    if (hipMemsetAsync((char*)d_ws + WS_CTL, 0, CTL_BYTES, stream) != hipSuccess) return;
    Params p{};
    for (int i = 0; i < 26; ++i) p.in[i] = (const float*)d_in[i];
    p.out = (float*)d_out; p.ws = (unsigned char*)d_ws;
#if MK_N_LAUNCHES == 1
    p.ph_lo = 0; p.ph_hi = N_PHASES;
    hipLaunchKernelGGL(mega_fwd, dim3(grid), dim3(512), LDS_BYTES, stream, p);
#else
    for (int k = 0; k < N_PHASES; ++k) { p.ph_lo = k; p.ph_hi = k + 1; hipLaunchKernelGGL(mega_fwd, dim3(grid), dim3(512), LDS_BYTES, stream, p); }
#endif
}
```

```cpp
#include <hip/hip_runtime.h>
#include <cstdio>
#include <cstdint>

#ifndef MK_N_LAUNCHES
#define MK_N_LAUNCHES 1
#endif

#define LAS __attribute__((address_space(3)))
typedef unsigned short bf16_t;
typedef short bf16x8 __attribute__((ext_vector_type(8)));
typedef short s16x4 __attribute__((ext_vector_type(4)));
typedef float f32x2 __attribute__((ext_vector_type(2)));
typedef float f32x4 __attribute__((ext_vector_type(4)));
typedef float f32x16 __attribute__((ext_vector_type(16)));
typedef unsigned u32x2 __attribute__((ext_vector_type(2)));
typedef unsigned u32x4 __attribute__((ext_vector_type(4)));
typedef int i32x8 __attribute__((ext_vector_type(8)));
typedef int i32x4 __attribute__((ext_vector_type(4)));

constexpr int BATCH = 2, SEQ = 16384, NMETA = 16, TLEN = SEQ + NMETA, DM = 2048, NPROJ = 5120, DEPTH = 2;
constexpr int NREAL = BATCH * SEQ;
constexpr int NTOK = NREAL + BATCH * NMETA;
constexpr int RPAD = 33024, NPAN = RPAD / 256;
constexpr int LRUW = 1024, NEXP = 16, DEXP = 512, NHEAD = 8;
constexpr int XS_ROWS = 2 * NTOK + NEXP * 256;
constexpr int OFF_U = 0, OFF_YG = 1024, OFF_Q = 2048, OFF_K = 3072, OFF_V = 4096;
constexpr float RMS_EPS = 1e-6f;
constexpr float LOG2E = 1.4426950408889634f;
constexpr float QSCALE = 0.125f * LOG2E;

constexpr size_t MiB = 1u << 20;
constexpr size_t WS_CTL = 0, CTL_BYTES = 1 * MiB;
constexpr size_t WS_TOKINFO = 1 * MiB;
constexpr size_t WS_TOKSLOT = WS_TOKINFO + 640 * 1024;
constexpr size_t WS_HIST = WS_TOKSLOT + 320 * 1024;
constexpr size_t WS_LRUSUM = WS_HIST + 64 * 1024;
constexpr size_t WS_HMETA = WS_LRUSUM + 256 * 1024;
constexpr size_t WS_WR = WS_HMETA + 256 * 1024;
constexpr size_t WS_PB = WS_WR + 512 * 1024;
constexpr size_t WS_TOKMAP = WS_PB + 256 * 1024;
constexpr size_t WS_RSLOT = WS_TOKMAP + 288 * 1024;
constexpr size_t WS_RINV = WS_RSLOT + 288 * 1024;
constexpr size_t WS_WGATES = 4 * MiB;
constexpr size_t WS_WIN = 6 * MiB;
constexpr size_t WS_WOUT = 46 * MiB;
constexpr size_t WS_WGU = 62 * MiB;
constexpr size_t WS_WD = 190 * MiB;
constexpr size_t WS_XN = 254 * MiB;
constexpr size_t WS_MIX = 383 * MiB;
constexpr size_t WS_HE = 512 * MiB;
constexpr size_t WS_PROJ = 581 * MiB;
constexpr size_t WS_HB8 = 904 * MiB;
constexpr size_t WS_END = 970 * MiB;
static_assert(WS_WR + 2 * 32 * 2048 * 4 <= WS_PB && WS_PB + 3 * 16384 * 4 <= WS_TOKMAP && (size_t)XS_ROWS * 4 <= 288 * 1024 && WS_RINV + (size_t)RPAD * 4 <= WS_WGATES && WS_PROJ + (size_t)RPAD * NPROJ * 2 <= WS_HB8 && WS_HB8 + (size_t)RPAD * DM <= WS_END && WS_HE + (size_t)XS_ROWS * DEXP * 2 <= WS_PROJ, "ws map");
constexpr int PBL = 16384, PB_CW = 0, PB_CB = 4096, PB_BA = 5120, PB_BX = 6144, PB_SP8 = 7168, PB_SUBG = 8192, PB_RGB = 8320, PB_REB = 8324, PB_LAM = 8352, PB_FING = 2 * PBL;
constexpr int CW_BAR = 4096;
constexpr int CW_QUEUE = 8192;
constexpr int CW_CNT = 8192 + 256;
constexpr int CW_LRUF = 16384;
constexpr int CW_KMAX = 8192 + 512;

constexpr int RING_BYTES = 131072;
constexpr int LCTL_OFF = RING_BYTES;
constexpr int LIDX_OFF = LCTL_OFF + 1024;
constexpr int MAXGU = 12;
constexpr int LDS_BYTES = 147456;
static_assert(LIDX_OFF + MAXGU * 1024 <= LDS_BYTES, "LDS map");

__device__ __forceinline__ unsigned cvt_pk_bf16(float lo, float hi) { unsigned r; asm volatile("v_cvt_pk_bf16_f32 %0, %1, %2" : "=v"(r) : "v"(lo), "v"(hi)); return r; }
constexpr float HE_SCALE = 0.5f, Y8_INV = 1.0f / (64.0f * 0.5f);
constexpr float W8_SCALE = 64.0f, W8_INV = 1.0f / 64.0f;
__device__ __forceinline__ unsigned cvt4_fp8(float a, float b, float c, float d) { int w = __builtin_amdgcn_cvt_pk_fp8_f32(a, b, 0, false); w = __builtin_amdgcn_cvt_pk_fp8_f32(c, d, w, true); return (unsigned)w; }
__device__ __forceinline__ float bf_lo(unsigned u) { return __uint_as_float(u << 16); }
__device__ __forceinline__ float bf_hi(unsigned u) { return __uint_as_float(u & 0xffff0000u); }
__device__ __forceinline__ float shx1(float v) { return __int_as_float(__builtin_amdgcn_mov_dpp(__float_as_int(v), 0xB1, 0xf, 0xf, true)); }
__device__ __forceinline__ float shx2(float v) { return __int_as_float(__builtin_amdgcn_mov_dpp(__float_as_int(v), 0x4E, 0xf, 0xf, true)); }
template <int M> __device__ __forceinline__ float shxs(float v) { return __int_as_float(__builtin_amdgcn_ds_swizzle(__float_as_int(v), (M << 10) | 0x1f)); }
__device__ __forceinline__ float sum32(float v) { const auto r = __builtin_amdgcn_permlane32_swap(__float_as_int(v), __float_as_int(v), false, false); return __int_as_float(r[0]) + __int_as_float(r[1]); }
__device__ __forceinline__ float max32(float v) { const auto r = __builtin_amdgcn_permlane32_swap(__float_as_int(v), __float_as_int(v), false, false); return fmaxf(__int_as_float(r[0]), __int_as_float(r[1])); }
__device__ __forceinline__ float wave_sum(float v) { v += shx1(v); v += shx2(v); v += shxs<4>(v); v += shxs<8>(v); v += shxs<16>(v); return sum32(v); }
__device__ __forceinline__ int crow(int r, int hi) { return (r & 3) + 8 * (r >> 2) + 4 * hi; }
__device__ __forceinline__ int tok_row(int b, int pos) { return pos < NMETA ? NREAL + b * NMETA + pos : b * SEQ + pos - NMETA; }
#define LDS_WAIT() asm volatile("s_waitcnt lgkmcnt(0)" ::: "memory")
#define LDS_BARRIER() do { asm volatile("s_waitcnt lgkmcnt(0)" ::: "memory"); __builtin_amdgcn_s_barrier(); asm volatile("" ::: "memory"); } while (0)
__device__ __forceinline__ void lds_add(LAS unsigned* p, unsigned v) { (void)__hip_atomic_fetch_add(p, v, __ATOMIC_RELAXED, __HIP_MEMORY_SCOPE_WORKGROUP); }

#define XB_TMO      128
#define XB_XCNT(j)  (256  + 64 * (j))
#define XB_XSUB(j)  (1280 + 64 * (j))
#define XB_XGEN(j)  (2304 + 64 * (j))
#define XB_TOP      3328
#define XB_TOPGEN   3392
#define XCD_BAR_WORDS 3456
#define XB_SPIN_CAP (1u << 24)
__device__ __forceinline__ unsigned xb_ld(unsigned* p)              { return __hip_atomic_load(p, __ATOMIC_RELAXED, __HIP_MEMORY_SCOPE_AGENT); }
__device__ __forceinline__ unsigned xb_add(unsigned* p, unsigned v) { return __hip_atomic_fetch_add(p, v, __ATOMIC_RELAXED, __HIP_MEMORY_SCOPE_AGENT); }
__device__ __forceinline__ unsigned xb_xcc_id() { return (unsigned)__builtin_amdgcn_s_getreg((3 << 11) | 20) & 0xFu; }
#define XB_SPIN(cond, bar) do { unsigned _sp = 0; while (cond) { __builtin_amdgcn_s_sleep(1); \
    if ((++_sp & 255u) == 0u) { if (xb_ld(&(bar)[XB_TMO])) break; if (_sp > XB_SPIN_CAP) { atomicAdd(&(bar)[XB_TMO], 1u); break; } } } } while (0)
__device__ __forceinline__ int lane_now() { int l; asm volatile("v_mbcnt_lo_u32_b32 %0, -1, 0\n\tv_mbcnt_hi_u32_b32 %0, -1, %0" : "=v"(l)); return l; }
struct XcdBarrier { unsigned* bar; unsigned x; volatile LAS unsigned* st; int wid; };
__device__ __forceinline__ XcdBarrier xcd_barrier_post(unsigned* bar, volatile LAS unsigned* st, int wid) {
    XcdBarrier b; b.bar = bar; b.x = xb_xcc_id(); b.st = st; b.wid = wid;
    if (wid == 0 && lane_now() == 0) (void)xb_add(&bar[XB_XCNT(b.x)], 1u);
    return b;
}
__device__ __forceinline__ void xcd_barrier_complete(unsigned* bar, unsigned x, unsigned& nloc, unsigned& nx) {
    const unsigned G = gridDim.x * gridDim.y * gridDim.z;
    unsigned sum, cnt, mine, sp = 0u;
    for (;;) {
        sum = 0u; cnt = 0u; mine = 0u;
#pragma unroll
        for (unsigned j = 0; j < 16; ++j) { const unsigned c = xb_ld(&bar[XB_XCNT(j)]); sum += c; cnt += (c > 0u) ? 1u : 0u; mine = (j == x) ? c : mine; }
        if (sum == G) break;
        __builtin_amdgcn_s_sleep(1);
        if ((++sp & 255u) == 0u) { if (xb_ld(&bar[XB_TMO])) break; if (sp > XB_SPIN_CAP) { atomicAdd(&bar[XB_TMO], 1u); break; } }
    }
    nloc = mine > 0u ? mine : 1u; nx = cnt > 0u ? cnt : 1u;
}
__device__ __forceinline__ void xcd_barrier_census(const XcdBarrier& b) {
    if (b.wid == 0 && lane_now() == 0) { unsigned nloc, nx; xcd_barrier_complete(b.bar, b.x, nloc, nx); b.st[0] = nloc; b.st[1] = nx; }
    __syncthreads();
}
__device__ __forceinline__ void xcd_barrier(const XcdBarrier& b) {
    asm volatile("s_waitcnt vmcnt(0)" ::: "memory");
    __syncthreads();
    if (b.wid == 0 && lane_now() == 0) {
        unsigned* bar = b.bar;
        __builtin_amdgcn_s_waitcnt(0);
        const unsigned nloc = b.st[0], nx = b.st[1];
        const unsigned old = xb_add(&bar[XB_XSUB(b.x)], 1u);
        const unsigned gen = old / nloc;
        if (old + 1u == (gen + 1u) * nloc) {
            __builtin_amdgcn_fence(__ATOMIC_RELEASE, "agent");
            asm volatile("s_waitcnt vmcnt(0)" ::: "memory");
            const unsigned og = xb_add(&bar[XB_TOP], 1u);
            const unsigned tg = og / nx;
            if (og + 1u == (tg + 1u) * nx) xb_add(&bar[XB_TOPGEN], 1u);
            else XB_SPIN(xb_ld(&bar[XB_TOPGEN]) == tg, bar);
            __builtin_amdgcn_fence(__ATOMIC_ACQUIRE, "agent");
            xb_add(&bar[XB_XGEN(b.x)], 1u);
            asm volatile("s_waitcnt vmcnt(0)" ::: "memory");
        } else {
            XB_SPIN(xb_ld(&bar[XB_XGEN(b.x)]) == gen, bar);
            __builtin_amdgcn_fence(__ATOMIC_ACQUIRE, "agent");
            asm volatile("s_waitcnt vmcnt(0)" ::: "memory");
        }
    }
    __syncthreads();
}

namespace pg8 {
constexpr int BM = 256, BK = 64, HALF = 128, HTB = HALF * BK * 2, STAGE_BYTES = 8 * HTB, NXCD = 8, WGM = 8;
__host__ __device__ __forceinline__ int lds_byte(int r, int c) { const int st = (r >> 4) * 2 + (c >> 5), rr = r & 15, cc = c & 31, ob = rr * 64 + cc * 2; return st * 1024 + (ob ^ (((ob >> 9) & 1) << 5)); }
__host__ __device__ __forceinline__ void stage_rc(int b, int& R, int& C) { const int st = b / 1024, sb = b % 1024, swz = sb ^ (((sb >> 9) & 1) << 5); R = (st >> 1) * 16 + swz / 64; C = (st & 1) * 32 + (swz % 64) / 2; }
__host__ __device__ __forceinline__ int perm32(int rho) { const int n = rho >> 4, i = rho & 15; return 8 * (i >> 2) + 4 * n + (i & 3); }

struct Unit { const char* A; const char* B; int row0, col0; };

struct DenseOrder {
    const char* A; const char* Bt; size_t tstep; int nM, nN, nwg, G, c;
    __device__ void init(const void* A_, const void* Bt_, int M, int N, int K, int G_, int c_) { A = (const char*)A_; Bt = (const char*)Bt_; tstep = (size_t)BM * K * 2; nM = M / BM; nN = N / BM; nwg = nM * nN; G = G_; c = c_; }
    __device__ bool next(int i, Unit& u) const {
        const long L = (long)i * G + c; if (L >= nwg) return false;
        int wgid = (int)L; { const int q = nwg / NXCD, r = nwg % NXCD, xcd = wgid % NXCD, off = wgid / NXCD; wgid = (xcd < r ? xcd * (q + 1) : r * (q + 1) + (xcd - r) * q) + off; }
        const int nig = WGM * nN, gid = wgid / nig, fm = gid * WGM, gsz = (nM - fm) < WGM ? (nM - fm) : WGM;
        const int pm = fm + ((wgid % nig) % gsz), pn = (wgid % nig) / gsz;
        u.A = A + (size_t)pm * tstep; u.B = Bt + (size_t)pn * tstep; u.row0 = pm * BM; u.col0 = pn * BM; return true;
    }
};
struct MoeOrder {
    const char* A; const char* Bt; size_t rowbytes, ebytes, tstepB; int NT, G, c; const LAS int* pp; const LAS int* sb;
    __device__ bool next(int i, Unit& u) const {
        int pg, pn;
        if ((G & 7) == 0 && ((G >> 3) % NT) == 0) { const int x = c & 7, idx = c >> 3, ppr = (G >> 3) / NT; pn = idx % NT; pg = i * (8 * ppr) + x * ppr + idx / NT; }
        else { const long L = (long)i * G + c; pg = (int)(L / NT); pn = (int)(L % NT); }
        if (pg >= pp[16]) return false;
        int e = 0;
#pragma unroll
        for (int j = 1; j < 16; ++j) e += (pg >= pp[j]) ? 1 : 0;
        e = __builtin_amdgcn_readfirstlane(e);
        const int row0 = __builtin_amdgcn_readfirstlane(sb[e] + (pg - pp[e]) * BM);
        u.A = A + (size_t)row0 * rowbytes; u.B = Bt + (size_t)e * ebytes + (size_t)pn * tstepB; u.row0 = row0; u.col0 = pn * BM; return true;
    }
};

struct EpiBf16 {
    static constexpr bool PERM = true;
    bf16_t* O; int ldc; float sc; unsigned* kmx;
    __device__ __forceinline__ void operator()(const f32x4 (&acc)[2][2][4][2], const Unit& u, int wr, int wc, int fr, int fq) const {
        const int row0 = u.row0 + wr * 64 + fr, col0 = u.col0 + wc * 32 + 8 * fq;
#pragma unroll
        for (int ai = 0; ai < 2; ++ai)
#pragma unroll
            for (int m = 0; m < 4; ++m) { bf16_t* rowp = O + (size_t)(row0 + ai * HALF + m * 16) * ldc + col0;
#pragma unroll
                for (int bj = 0; bj < 2; ++bj) { const f32x4 v0 = acc[ai][bj][m][0] * sc, v1 = acc[ai][bj][m][1] * sc;
                    u32x4 w; w.x = cvt_pk_bf16(v0[0], v0[1]); w.y = cvt_pk_bf16(v0[2], v0[3]); w.z = cvt_pk_bf16(v1[0], v1[1]); w.w = cvt_pk_bf16(v1[2], v1[3]);
                    *(u32x4*)(rowp + bj * HALF) = w; } }
        if (kmx != nullptr && u.col0 >= OFF_K && u.col0 < OFF_K + NHEAD * 128) {
            float mx[2] = {0.f, 0.f};
#pragma unroll
            for (int ai = 0; ai < 2; ++ai)
#pragma unroll
                for (int m = 0; m < 4; ++m)
#pragma unroll
                    for (int bj = 0; bj < 2; ++bj) { const f32x4 a = acc[ai][bj][m][0], c = acc[ai][bj][m][1];
                        float q = (a[0] * a[0] + a[1] * a[1]) + (a[2] * a[2] + a[3] * a[3]) + (c[0] * c[0] + c[1] * c[1]) + (c[2] * c[2] + c[3] * c[3]);
                        q += shxs<16>(q); q = sum32(q);
                        mx[bj] = fmaxf(mx[bj], q); }
#pragma unroll
            for (int bj = 0; bj < 2; ++bj) { float v = mx[bj]; v = fmaxf(v, shx1(v)); v = fmaxf(v, shx2(v)); v = fmaxf(v, shxs<4>(v)); v = fmaxf(v, shxs<8>(v));
                if (fr == 0 && fq == 0) { const int b = u.row0 / SEQ, hh = (u.col0 - OFF_K) / 128 + bj;
                    atomicMax(kmx + ((b * NHEAD + hh) * 2 + (wc >> 1)) * 2 + (wc & 1), __float_as_uint(v * sc * sc)); } }
        }
    }
};
struct EpiY8 {
    static constexpr bool PERM = true;
    unsigned char* O;
    __device__ __forceinline__ void operator()(const f32x4 (&acc)[2][2][4][2], const Unit& u, int wr, int wc, int fr, int fq) const {
        const int row0 = u.row0 + wr * 64 + fr, col0 = u.col0 + wc * 32 + 8 * fq;
#pragma unroll
        for (int ai = 0; ai < 2; ++ai)
#pragma unroll
            for (int m = 0; m < 4; ++m) { unsigned char* rowp = O + (size_t)(row0 + ai * HALF + m * 16) * DM + col0;
#pragma unroll
                for (int bj = 0; bj < 2; ++bj) { const f32x4 v0 = acc[ai][bj][m][0], v1 = acc[ai][bj][m][1];
                    u32x2 w; w.x = cvt4_fp8(v0[0], v0[1], v0[2], v0[3]); w.y = cvt4_fp8(v1[0], v1[1], v1[2], v1[3]); *(u32x2*)(rowp + bj * HALF) = w; } }
    }
};
struct EpiSwiGLU {
    static constexpr bool PERM = true;
    unsigned char* O; const float* rs;
    __device__ __forceinline__ void operator()(const f32x4 (&acc)[2][2][4][2], const Unit& u, int wr, int wc, int fr, int fq) const {
        const int row0 = u.row0 + wr * 64 + fr, hid0 = (u.col0 + wc * 32 + 8 * fq) >> 1;
        float rsq[2][4];
#pragma unroll
        for (int ai = 0; ai < 2; ++ai)
#pragma unroll
            for (int m = 0; m < 4; ++m) rsq[ai][m] = rs[row0 + ai * HALF + m * 16];
        asm volatile("" : "+v"(rsq[0][0]), "+v"(rsq[0][1]), "+v"(rsq[0][2]), "+v"(rsq[0][3]), "+v"(rsq[1][0]), "+v"(rsq[1][1]), "+v"(rsq[1][2]), "+v"(rsq[1][3]));
#pragma unroll
        for (int ai = 0; ai < 2; ++ai)
#pragma unroll
            for (int m = 0; m < 4; ++m) { unsigned char* rowp = O + (size_t)(row0 + ai * HALF + m * 16) * DEXP + hid0; const float rsv = rsq[ai][m] * W8_INV;
#pragma unroll
                for (int bj = 0; bj < 2; ++bj) { const f32x4 g = acc[ai][bj][m][0] * rsv, up = acc[ai][bj][m][1] * (rsv * HE_SCALE); float o[4];
#pragma unroll
                    for (int j = 0; j < 4; ++j) { const float s = g[j] * __builtin_amdgcn_rcpf(1.0f + __builtin_amdgcn_exp2f(-LOG2E * g[j])); o[j] = s * up[j]; }
                    *(unsigned*)(rowp + bj * (HALF / 2)) = cvt4_fp8(o[0], o[1], o[2], o[3]); } }
    }
};
struct EpiResid {
    static constexpr bool PERM = true;
    bf16_t* hb; const float* rms; unsigned char* hb8;
    __device__ __forceinline__ void operator()(const f32x4 (&acc)[2][2][4][2], const Unit& u, int wr, int wc, int fr, int fq) const {
        const int row0 = u.row0 + wr * 64 + fr;
        const size_t off0 = (size_t)row0 * DM + (u.col0 + wc * 32 + 8 * fq);
        u32x4 q[2][4][2]; float sc[2][4];
#pragma unroll
        for (int ai = 0; ai < 2; ++ai)
#pragma unroll
            for (int m = 0; m < 4; ++m) { sc[ai][m] = rms[row0 + ai * HALF + m * 16];
#pragma unroll
                for (int bj = 0; bj < 2; ++bj) q[ai][m][bj] = *(const u32x4*)(hb + off0 + (size_t)(ai * HALF + m * 16) * DM + bj * HALF); }
#pragma unroll
        for (int ai = 0; ai < 2; ++ai)
#pragma unroll
            for (int m = 0; m < 4; ++m)
#pragma unroll
                for (int bj = 0; bj < 2; ++bj) { const u32x4 t = q[ai][m][bj]; const float r = sc[ai][m]; const size_t o = off0 + (size_t)(ai * HALF + m * 16) * DM + bj * HALF;
                    const f32x4 v0 = acc[ai][bj][m][0] + (f32x4){bf_lo(t.x), bf_hi(t.x), bf_lo(t.y), bf_hi(t.y)} * r, v1 = acc[ai][bj][m][1] + (f32x4){bf_lo(t.z), bf_hi(t.z), bf_lo(t.w), bf_hi(t.w)} * r;
                    u32x4 w; w.x = cvt_pk_bf16(v0[0], v0[1]); w.y = cvt_pk_bf16(v0[2], v0[3]); w.z = cvt_pk_bf16(v1[0], v1[1]); w.w = cvt_pk_bf16(v1[2], v1[3]);
                    *(u32x4*)(hb + o) = w;
                    u32x2 w8; w8.x = cvt4_fp8(v0[0], v0[1], v0[2], v0[3]); w8.y = cvt4_fp8(v1[0], v1[1], v1[2], v1[3]); *(u32x2*)(hb8 + o) = w8; }
    }
};

template <class Epi, class Sched, bool ALIGN_EPI = true, bool SP2 = true, bool GATHER = false, bool FP8 = false>
__device__ __forceinline__ void gemm_phase(LAS unsigned char* lds, const int wid, const int Kel, const Sched& S, const Epi& E, const char* Ab = nullptr, const LAS int* idx = nullptr) {
    static_assert(!GATHER || SP2, "gather needs the SP2 loop");
    const int lane = lane_now(), tid = (wid << 6) | lane, wr = wid >> 2, wc = wid & 3, fr = lane & 15, fq = lane >> 4;
    const int K = FP8 ? (Kel >> 1) : Kel;
    int nt = K / BK; asm volatile("" : "+s"(nt));
    unsigned voffA[2], voffB[2];
#pragma unroll
    for (int i = 0; i < 2; ++i) { int R, C; stage_rc(tid * 16 + i * 8192, R, C); const int Rb = Epi::PERM ? ((R & ~31) + perm32(R & 31)) : R;
        voffA[i] = (unsigned)(R * K + C) * 2u; voffB[i] = (unsigned)(Rb * K + C) * 2u; }
    unsigned goff[2][2];
#define PG8_GOFF(dst, unit_i) do { const int tz_ = (wid << 6) | lane_now(); _Pragma("unroll") for (int i_ = 0; i_ < 2; ++i_) { int R_, C_; stage_rc(tz_ * 16 + i_ * 8192, R_, C_); \
        _Pragma("unroll") for (int h_ = 0; h_ < 2; ++h_) dst[h_][i_] = (unsigned)idx[(unit_i) * 256 + 128 * h_ + R_] * (unsigned)(K * 2) + (unsigned)(C_ * 2); } } while (0)
    const size_t kstep = (size_t)(BK * 2);
    const size_t hstep = (size_t)HALF * K * 2;
    const unsigned ldsw = (unsigned)wid * 1024u;
    const int aoff = lds_byte(wr * 64 + fr, fq * 8), boff = lds_byte(wc * 32 + fr, fq * 8);
#define PG8_SA(b, h) (((b) * 2 + (h)) * HTB)
#define PG8_SB(b, h) ((4 + (b) * 2 + (h)) * HTB)
#define PG8_STAGE(bufoff, gbase, voff) do { _Pragma("unroll") for (int _i = 0; _i < 2; ++_i) \
        __builtin_amdgcn_global_load_lds((const unsigned*)((const char*)(gbase) + (voff)[_i]), (LAS unsigned*)(lds + (bufoff) + ldsw + _i * 8192), 16, 0, 0); } while (0)
#define PG8_LDA(dst, b, h) do { _Pragma("unroll") for (int m = 0; m < 4; ++m) _Pragma("unroll") for (int k = 0; k < 2; ++k) dst[m][k] = *(const LAS bf16x8*)(lds + PG8_SA(b, h) + aoff + m * 2048 + k * 1024); } while (0)
#define PG8_LDB(dst, b, h) do { _Pragma("unroll") for (int n = 0; n < 2; ++n) _Pragma("unroll") for (int k = 0; k < 2; ++k) dst[n][k] = *(const LAS bf16x8*)(lds + PG8_SB(b, h) + boff + n * 2048 + k * 1024); } while (0)
#define PG8_CAT(f) __builtin_shufflevector(__builtin_bit_cast(i32x4, f[0]), __builtin_bit_cast(i32x4, f[1]), 0, 1, 2, 3, 4, 5, 6, 7)
#define PG8_MMA(ai, bj, At, Bt) do { __builtin_amdgcn_s_setprio(1); _Pragma("unroll") for (int m = 0; m < 4; ++m) _Pragma("unroll") for (int n = 0; n < 2; ++n) { \
        if constexpr (FP8) acc[ai][bj][m][n] = __builtin_amdgcn_mfma_scale_f32_16x16x128_f8f6f4(PG8_CAT(Bt[n]), PG8_CAT(At[m]), acc[ai][bj][m][n], 0, 0, 0, 0, 0, 0); \
        else { _Pragma("unroll") for (int k = 0; k < 2; ++k) acc[ai][bj][m][n] = __builtin_amdgcn_mfma_f32_16x16x32_bf16(Bt[n][k], At[m][k], acc[ai][bj][m][n], 0, 0, 0); } } \
        __builtin_amdgcn_s_setprio(0); } while (0)
#define PG8_WAIT_V(n) asm volatile("s_waitcnt vmcnt(" #n ")" ::: "memory")
#define PG8_WAIT_L(n) asm volatile("s_waitcnt lgkmcnt(" #n ")" ::: "memory")
#define PG8_BAR __builtin_amdgcn_s_barrier()
#define PG8_SCHED __builtin_amdgcn_sched_barrier(0)
    Unit cur, nxt; int ui = 0;
    if (!S.next(0, cur)) return;
    f32x4 acc[2][2][4][2];
#pragma unroll
    for (int a = 0; a < 2; ++a)
#pragma unroll
        for (int b = 0; b < 2; ++b)
#pragma unroll
            for (int m = 0; m < 4; ++m)
#pragma unroll
                for (int n = 0; n < 2; ++n) acc[a][b][m][n] = (f32x4){0.f, 0.f, 0.f, 0.f};
    bf16x8 At[4][2], B0[2][2], B1[2][2];
    const char* cA = cur.A; const char* cB = cur.B;
    if constexpr (GATHER) {
        PG8_GOFF(goff, 0);
        PG8_STAGE(PG8_SB(0, 0), cB, voffB); PG8_STAGE(PG8_SB(0, 1), cB + hstep, voffB); PG8_STAGE(PG8_SA(0, 0), Ab, goff[0]); PG8_STAGE(PG8_SA(0, 1), Ab, goff[1]);
        if (wr == 1) PG8_BAR;
        PG8_WAIT_V(2); PG8_BAR;
        PG8_STAGE(PG8_SB(1, 0), cB + kstep, voffB); PG8_STAGE(PG8_SA(1, 0), Ab + kstep, goff[0]); PG8_STAGE(PG8_SB(1, 1), cB + hstep + kstep, voffB);
        PG8_WAIT_V(6); PG8_BAR;
    } else if constexpr (SP2) {
        PG8_STAGE(PG8_SB(0, 0), cB, voffB); PG8_STAGE(PG8_SB(0, 1), cB + hstep, voffB); PG8_STAGE(PG8_SA(0, 0), cA, voffA); PG8_STAGE(PG8_SA(0, 1), cA + hstep, voffA);
        if (wr == 1) PG8_BAR;
        PG8_WAIT_V(2); PG8_BAR;
        PG8_STAGE(PG8_SB(1, 0), cB + kstep, voffB); PG8_STAGE(PG8_SA(1, 0), cA + kstep, voffA); PG8_STAGE(PG8_SB(1, 1), cB + hstep + kstep, voffB);
        PG8_WAIT_V(6); PG8_BAR;
    } else {
        PG8_STAGE(PG8_SB(0, 0), cB, voffB); PG8_STAGE(PG8_SA(0, 0), cA, voffA); PG8_STAGE(PG8_SB(0, 1), cB + hstep, voffB); PG8_STAGE(PG8_SA(0, 1), cA + hstep, voffA);
        if (wr == 1) PG8_BAR;
        PG8_WAIT_V(4); PG8_BAR;
        PG8_STAGE(PG8_SB(1, 0), cB + kstep, voffB); PG8_STAGE(PG8_SA(1, 0), cA + kstep, voffA); PG8_STAGE(PG8_SB(1, 1), cB + hstep + kstep, voffB);
        PG8_WAIT_V(6); PG8_BAR;
    }
    for (;;) {
        const bool has_next = S.next(ui + 1, nxt);
        const char* nA = has_next ? nxt.A : cA; const char* nB = has_next ? nxt.B : cB;
#pragma unroll 1
        for (int t = 0; t < nt; t += 2) {
            const bool last = (t == nt - 2);
            asm volatile("" : "+v"(voffA[0]), "+v"(voffA[1]), "+v"(voffB[0]), "+v"(voffB[1]));
            const char* a1 = cA + (size_t)(t + 1) * kstep;
            const char* a2 = last ? nA : cA + (size_t)(t + 2) * kstep; const char* b2 = last ? nB : cB + (size_t)(t + 2) * kstep;
            const char* a3 = a2 + kstep; const char* b3 = b2 + kstep;
            if constexpr (GATHER) {
            const char* g1 = Ab + (size_t)(t + 1) * kstep; const char* g2 = last ? Ab : Ab + (size_t)(t + 2) * kstep; const char* g3 = g2 + kstep;
            PG8_LDB(B0, 0, 0); PG8_LDB(B1, 0, 1); PG8_SCHED; PG8_LDA(At, 0, 0); PG8_STAGE(PG8_SA(1, 1), g1, goff[1]);
            PG8_WAIT_V(8); PG8_WAIT_L(0); PG8_BAR; PG8_MMA(0, 0, At, B0); PG8_MMA(0, 1, At, B1); PG8_BAR; PG8_SCHED;
            if (last && has_next) PG8_GOFF(goff, ui + 1);
            PG8_LDA(At, 0, 1); PG8_STAGE(PG8_SB(0, 0), b2, voffB); PG8_STAGE(PG8_SB(0, 1), b2 + hstep, voffB); PG8_STAGE(PG8_SA(0, 0), g2, goff[0]);
            PG8_WAIT_V(8); PG8_WAIT_L(0); PG8_BAR; PG8_MMA(1, 0, At, B0); PG8_MMA(1, 1, At, B1); PG8_BAR; PG8_SCHED;
            PG8_LDB(B0, 1, 0); PG8_LDB(B1, 1, 1); PG8_SCHED; PG8_LDA(At, 1, 0); PG8_STAGE(PG8_SA(0, 1), g2, goff[1]);
            PG8_WAIT_V(8); PG8_WAIT_L(0); PG8_BAR; PG8_MMA(0, 0, At, B0); PG8_MMA(0, 1, At, B1); PG8_BAR; PG8_SCHED;
            PG8_LDA(At, 1, 1); PG8_STAGE(PG8_SB(1, 0), b3, voffB); PG8_STAGE(PG8_SB(1, 1), b3 + hstep, voffB); PG8_STAGE(PG8_SA(1, 0), g3, goff[0]);
            PG8_WAIT_V(8); PG8_WAIT_L(0); PG8_BAR; PG8_MMA(1, 0, At, B0); PG8_MMA(1, 1, At, B1); PG8_BAR; PG8_SCHED;
            } else if constexpr (SP2) {
            PG8_LDB(B0, 0, 0); PG8_LDB(B1, 0, 1); PG8_SCHED; PG8_LDA(At, 0, 0); PG8_STAGE(PG8_SA(1, 1), a1 + hstep, voffA);
            PG8_WAIT_V(8); PG8_WAIT_L(0); PG8_BAR; PG8_MMA(0, 0, At, B0); PG8_MMA(0, 1, At, B1); PG8_BAR; PG8_SCHED;
            PG8_LDA(At, 0, 1); PG8_STAGE(PG8_SB(0, 0), b2, voffB); PG8_STAGE(PG8_SB(0, 1), b2 + hstep, voffB); PG8_STAGE(PG8_SA(0, 0), a2, voffA);
            PG8_WAIT_V(8); PG8_WAIT_L(0); PG8_BAR; PG8_MMA(1, 0, At, B0); PG8_MMA(1, 1, At, B1); PG8_BAR; PG8_SCHED;
            PG8_LDB(B0, 1, 0); PG8_LDB(B1, 1, 1); PG8_SCHED; PG8_LDA(At, 1, 0); PG8_STAGE(PG8_SA(0, 1), a2 + hstep, voffA);
            PG8_WAIT_V(8); PG8_WAIT_L(0); PG8_BAR; PG8_MMA(0, 0, At, B0); PG8_MMA(0, 1, At, B1); PG8_BAR; PG8_SCHED;
            PG8_LDA(At, 1, 1); PG8_STAGE(PG8_SB(1, 0), b3, voffB); PG8_STAGE(PG8_SB(1, 1), b3 + hstep, voffB); PG8_STAGE(PG8_SA(1, 0), a3, voffA);
            PG8_WAIT_V(8); PG8_WAIT_L(0); PG8_BAR; PG8_MMA(1, 0, At, B0); PG8_MMA(1, 1, At, B1); PG8_BAR; PG8_SCHED;
            } else {
            PG8_LDB(B0, 0, 0); PG8_SCHED; PG8_LDA(At, 0, 0); PG8_STAGE(PG8_SA(1, 1), a1 + hstep, voffA);
            PG8_WAIT_L(8); PG8_BAR; PG8_WAIT_L(0); PG8_MMA(0, 0, At, B0); PG8_BAR; PG8_SCHED;
            PG8_LDB(B1, 0, 1); PG8_STAGE(PG8_SB(0, 0), b2, voffB);
            PG8_BAR; PG8_WAIT_L(0); PG8_MMA(0, 1, At, B1); PG8_BAR;
            PG8_LDA(At, 0, 1); PG8_STAGE(PG8_SA(0, 0), a2, voffA);
            PG8_BAR; PG8_WAIT_L(0); PG8_MMA(1, 0, At, B0); PG8_BAR; PG8_SCHED;
            PG8_STAGE(PG8_SB(0, 1), b2 + hstep, voffB);
            PG8_WAIT_V(6); PG8_BAR; PG8_MMA(1, 1, At, B1); PG8_BAR;
            PG8_LDB(B0, 1, 0); PG8_SCHED; PG8_LDA(At, 1, 0); PG8_STAGE(PG8_SA(0, 1), a2 + hstep, voffA);
            PG8_WAIT_L(8); PG8_BAR; PG8_WAIT_L(0); PG8_MMA(0, 0, At, B0); PG8_BAR; PG8_SCHED;
            PG8_LDB(B1, 1, 1); PG8_STAGE(PG8_SB(1, 0), b3, voffB);
            PG8_BAR; PG8_WAIT_L(0); PG8_MMA(0, 1, At, B1); PG8_BAR;
            PG8_LDA(At, 1, 1); PG8_STAGE(PG8_SA(1, 0), a3, voffA);
            PG8_BAR; PG8_WAIT_L(0); PG8_MMA(1, 0, At, B0); PG8_BAR; PG8_SCHED;
            PG8_STAGE(PG8_SB(1, 1), b3 + hstep, voffB);
            PG8_WAIT_V(6); PG8_BAR; PG8_MMA(1, 1, At, B1); PG8_BAR;
            }
        }
        if constexpr (ALIGN_EPI) { if (wr == 0) PG8_BAR; }
        { const int lz = lane_now(); E(acc, cur, wr, wc, lz & 15, lz >> 4); }
        if (!has_next) break;
#pragma unroll
        for (int a = 0; a < 2; ++a)
#pragma unroll
            for (int b = 0; b < 2; ++b)
#pragma unroll
                for (int m = 0; m < 4; ++m)
#pragma unroll
                    for (int n = 0; n < 2; ++n) acc[a][b][m][n] = (f32x4){0.f, 0.f, 0.f, 0.f};
        cur = nxt; cA = nA; cB = nB; ++ui;
        if constexpr (ALIGN_EPI) { if (wr == 1) PG8_BAR; }
    }
    PG8_WAIT_V(0);
    if constexpr (!ALIGN_EPI) { if (wr == 0) PG8_BAR; }
    PG8_BAR;
#undef PG8_GOFF
#undef PG8_CAT
#undef PG8_SA
#undef PG8_SB
#undef PG8_STAGE
#undef PG8_LDA
#undef PG8_LDB
#undef PG8_MMA
#undef PG8_WAIT_V
#undef PG8_WAIT_L
#undef PG8_BAR
#undef PG8_SCHED
}
}

struct Params {
    const float* in[26];
    float* out;
    unsigned char* ws;
    int ph_lo, ph_hi;
};
struct Frame {
    LAS unsigned char* lds;
    volatile LAS unsigned* LC;
    unsigned* ctl;
    unsigned char* ws;
    int G, bid, wid;
};
#define PHASE_IDS() int wid = F.wid; asm volatile("" : "+s"(wid)); const int lane = lane_now(); const int tid = (wid << 6) | lane; (void)tid

__device__ __forceinline__ void tr_item(const float* W, int K, int N, bf16_t* WT, int item, LAS float* scr, int lane, const float* gk, int qscale, int rowmap) {
    const int nblk = N / 32, kb = item / nblk, nb = item % nblk, k0 = 64 * kb, n0 = 32 * nb;
    float tv[32];
#pragma unroll
    for (int i = 0; i < 32; ++i) { const int kk = 2 * i + (lane >> 5); tv[i] = W[(size_t)(k0 + kk) * N + n0 + (lane & 31)]; }
#pragma unroll
    for (int i = 0; i < 32; ++i) { const int kk = 2 * i + (lane >> 5); const int n = n0 + (lane & 31);
        float v = tv[i];
        if (qscale == 2) { if (k0 + kk >= LRUW) v *= gk[(k0 + kk - LRUW) & 127]; }
        else { if (gk) v *= gk[k0 + kk]; if (qscale && n >= OFF_Q && n < OFF_K) v *= QSCALE; }
        scr[kk * 33 + (lane & 31)] = v; }
    LDS_WAIT(); asm volatile("" ::: "memory");
    const int c = lane & 7;
#pragma unroll
    for (int j = 0; j < 4; ++j) { const int n = (lane >> 3) + 8 * j; const LAS float* s = scr + (8 * c) * 33 + n;
        u32x4 o; o.x = cvt_pk_bf16(s[0 * 33], s[1 * 33]); o.y = cvt_pk_bf16(s[2 * 33], s[3 * 33]); o.z = cvt_pk_bf16(s[4 * 33], s[5 * 33]); o.w = cvt_pk_bf16(s[6 * 33], s[7 * 33]);
        const int ng = n0 + n; const int dr = rowmap == 0 ? ng : (8 * (ng >> 2) + (ng & 3) + (rowmap == 2 ? 4 : 0));
        *(u32x4*)(WT + (size_t)dr * K + k0 + 8 * c) = o; }
    LDS_WAIT(); asm volatile("" ::: "memory");
}
__device__ __forceinline__ void tr_item8(const float* W, int K, int N, unsigned char* WT, int item, LAS float* scr, int lane, const float* gk, int rowmap) {
    const int nblk = N / 32, kb = item / nblk, nb = item % nblk, k0 = 64 * kb, n0 = 32 * nb;
    float tv[32];
#pragma unroll
    for (int i = 0; i < 32; ++i) { const int kk = 2 * i + (lane >> 5); tv[i] = W[(size_t)(k0 + kk) * N + n0 + (lane & 31)]; }
#pragma unroll
    for (int i = 0; i < 32; ++i) { const int kk = 2 * i + (lane >> 5); float v = tv[i] * W8_SCALE; if (gk) v *= gk[k0 + kk]; scr[kk * 33 + (lane & 31)] = v; }
    LDS_WAIT(); asm volatile("" ::: "memory");
    const int c = lane & 3;
#pragma unroll
    for (int j = 0; j < 2; ++j) { const int n = (lane >> 2) + 16 * j; const LAS float* sp = scr + (16 * c) * 33 + n;
        u32x4 o; o.x = cvt4_fp8(sp[0 * 33], sp[1 * 33], sp[2 * 33], sp[3 * 33]); o.y = cvt4_fp8(sp[4 * 33], sp[5 * 33], sp[6 * 33], sp[7 * 33]);
        o.z = cvt4_fp8(sp[8 * 33], sp[9 * 33], sp[10 * 33], sp[11 * 33]); o.w = cvt4_fp8(sp[12 * 33], sp[13 * 33], sp[14 * 33], sp[15 * 33]);
        const int ng = n0 + n; const int dr = rowmap == 0 ? ng : (8 * (ng >> 2) + (ng & 3) + (rowmap == 2 ? 4 : 0));
        *(u32x4*)(WT + (size_t)dr * K + k0 + 16 * c) = o; }
    LDS_WAIT(); asm volatile("" ::: "memory");
}
__device__ __forceinline__ void norm_row_to_bf16(const float* xrow, bf16_t* orow, float* rinv, int lane) {
    const f32x4* xr = (const f32x4*)xrow + lane;
    f32x4 v[8]; float s = 0.f;
#pragma unroll
    for (int j = 0; j < 8; ++j) { v[j] = xr[64 * j]; s += (v[j].x * v[j].x + v[j].y * v[j].y) + (v[j].z * v[j].z + v[j].w * v[j].w); }
    const float rms = sqrtf(wave_sum(s) * (1.f / DM) + RMS_EPS), rstd = 1.0f / rms;
    if (lane == 0) *rinv = rms;
    u32x2* o8 = (u32x2*)orow + lane;
#pragma unroll
    for (int j = 0; j < 8; ++j) { u32x2 w; w.x = cvt_pk_bf16(v[j].x * rstd, v[j].y * rstd); w.y = cvt_pk_bf16(v[j].z * rstd, v[j].w * rstd); o8[64 * j] = w; }
}
__device__ __forceinline__ void norm_rows2_to_bf16(const float* xrow, bf16_t* orow, float* rinv, int lane) {
    const f32x4* xr = (const f32x4*)xrow + lane;
    f32x4 v[16]; float s0 = 0.f, s1 = 0.f;
#pragma unroll
    for (int j = 0; j < 16; ++j) v[j] = xr[64 * j];
#pragma unroll
    for (int j = 0; j < 8; ++j) { s0 += (v[j].x * v[j].x + v[j].y * v[j].y) + (v[j].z * v[j].z + v[j].w * v[j].w); s1 += (v[8 + j].x * v[8 + j].x + v[8 + j].y * v[8 + j].y) + (v[8 + j].z * v[8 + j].z + v[8 + j].w * v[8 + j].w); }
    const float q0 = sqrtf(wave_sum(s0) * (1.f / DM) + RMS_EPS), q1 = sqrtf(wave_sum(s1) * (1.f / DM) + RMS_EPS), r0 = 1.0f / q0, r1 = 1.0f / q1;
    if (lane == 0) { rinv[0] = q0; rinv[1] = q1; }
    u32x2* o8 = (u32x2*)orow + lane;
#pragma unroll
    for (int j = 0; j < 16; ++j) { const float r = j < 8 ? r0 : r1; u32x2 w; w.x = cvt_pk_bf16(v[j].x * r, v[j].y * r); w.y = cvt_pk_bf16(v[j].z * r, v[j].w * r); o8[64 * j] = w; }
}
__device__ __forceinline__ void p0_prologue(Frame& F, const Params& p) {
    PHASE_IDS();
    LAS float* scr = (LAS float*)(F.lds + wid * 16384);
    const int gw = F.bid * 8 + wid, NGW = F.G * 8;
    constexpr int I_IN = 32 * 160, I_OUT = 32 * 64, I_GU = 32 * 16, I_D = 8 * 64, I_G = 2 * 4;
    constexpr int N_IN = 2 * I_IN, N_OUT = 2 * I_OUT, N_GU = 2 * 16 * 2 * I_GU, N_D = 2 * 16 * I_D, N_G = 2 * 2 * 8 * I_G;
    constexpr int NITEMS = N_IN + N_OUT + N_GU + N_D + N_G;
    unsigned char* ws = F.ws;
    for (int it = gw; it < NITEMS; it += NGW) {
        int r = it;
        if (r < N_IN) { const int l = r / I_IN; tr_item(p.in[3] + (size_t)l * DM * NPROJ, DM, NPROJ, (bf16_t*)(ws + WS_WIN) + (size_t)l * NPROJ * DM, r % I_IN, scr, lane, p.in[2] + l * DM, 1, 0); continue; } r -= N_IN;
        if (r < N_OUT) { const int l = r / I_OUT; tr_item(p.in[16] + (size_t)l * DM * DM, DM, DM, (bf16_t*)(ws + WS_WOUT) + (size_t)l * DM * DM, r % I_OUT, scr, lane, p.in[15] + l * 128, 2, 0); continue; } r -= N_OUT;
        if (r < N_GU) { const int le = r / (2 * I_GU), rr = r % (2 * I_GU), which = rr / I_GU; const int l = le >> 4;
            tr_item8(p.in[which ? 23 : 22] + (size_t)le * DM * DEXP, DM, DEXP, (unsigned char*)(ws + WS_WGU) + (size_t)le * 1024 * DM, rr % I_GU, scr, lane, p.in[17] + l * DM, which ? 2 : 1); continue; } r -= N_GU;
        if (r < N_D) { const int le = r / I_D; tr_item8(p.in[24] + (size_t)le * DEXP * DM, DEXP, DM, (unsigned char*)(ws + WS_WD) + (size_t)le * DM * DEXP, r % I_D, scr, lane, nullptr, 0); continue; } r -= N_D;
        { const int mi = r / I_G; const int l = mi >> 4, which = (mi >> 3) & 1, g = mi & 7;
          tr_item(p.in[which ? 8 : 6] + (size_t)(l * 8 + g) * 128 * 128, 128, 128, (bf16_t*)(ws + WS_WGATES) + (size_t)((l * 2 + which) * 8 + g) * 128 * 128, r % I_G, scr, lane, nullptr, 0, 0); }
    }
    bf16_t* wr = (bf16_t*)(ws + WS_WR);
    for (int i = F.bid * 512 + tid; i < 2 * 32 * DM; i += F.G * 512) { const int l = i / (32 * DM), o = (i / DM) % 32, k = i % DM;
        const float w0 = o < 4 ? p.in[18][((size_t)l * DM + k) * 4 + o] : o < 20 ? p.in[20][((size_t)l * DM + k) * 16 + (o - 4)] : 0.f;
        const float w = w0 * p.in[17][l * DM + k];
        const unsigned hb_ = cvt_pk_bf16(w, 0.f) & 0xffffu; const float whi = __uint_as_float(hb_ << 16);
        wr[((size_t)(l * 2 + 0) * 32 + o) * DM + k] = (bf16_t)hb_; wr[((size_t)(l * 2 + 1) * 32 + o) * DM + k] = (bf16_t)(cvt_pk_bf16(w - whi, 0.f) & 0xffffu); }
    { float* pb = (float*)(ws + WS_PB);
      for (int i = F.bid * 512 + tid; i < 2 * PBL + DM; i += F.G * 512) {
          if (i >= 2 * PBL) { pb[i] = p.in[25][i - 2 * PBL]; continue; }
          const int l = i / PBL, o = i % PBL; float v = 0.f;
          if (o < PB_CB) v = p.in[4][l * 4096 + o];
          else if (o < PB_BA) v = p.in[5][l * LRUW + o - PB_CB];
          else if (o < PB_BX) v = p.in[7][l * LRUW + o - PB_BA];
          else if (o < PB_SP8) v = p.in[9][l * LRUW + o - PB_BX];
          else if (o < PB_SUBG) v = -8.0f * log1pf(__expf(-p.in[10][l * LRUW + o - PB_SP8]));
          else if (o < PB_RGB) v = p.in[15][l * 128 + o - PB_SUBG];
          else if (o < PB_REB) v = p.in[19][l * 4 + o - PB_RGB];
          else if (o < PB_REB + 16) v = p.in[21][l * 16 + o - PB_REB];
          else if (o == PB_LAM || o == PB_LAM + 1) continue;
          pb[i] = v; }
      if (F.bid == 0 && wid < DEPTH) {
          const int l = wid; const float s1 = wave_sum(p.in[11][l * 64 + lane] * p.in[12][l * 64 + lane]), s2 = wave_sum(p.in[13][l * 64 + lane] * p.in[14][l * 64 + lane]);
          const float lam_init = 0.8f - 0.6f * expf(-0.3f * (float)l);
          if (lane == 0) { pb[l * PBL + PB_LAM] = expf(s1) - expf(s2) + lam_init; pb[l * PBL + PB_LAM + 1] = lam_init; } } }
    bf16_t* xn = (bf16_t*)(ws + WS_XN);
    for (int m = 2 * gw; m < NREAL; m += 2 * NGW) norm_rows2_to_bf16(p.in[0] + (size_t)m * DM, xn + (size_t)m * DM, (float*)(ws + WS_RINV) + m, lane);
    for (int m = NREAL + gw; m < RPAD; m += NGW) {
        if (m < NTOK) norm_row_to_bf16(p.in[1] + (size_t)((m - NREAL) & 15) * DM, xn + (size_t)m * DM, (float*)(ws + WS_RINV) + m, lane);
        else { u32x4* o = (u32x4*)(xn + (size_t)m * DM) + lane;
#pragma unroll
            for (int j = 0; j < 4; ++j) o[64 * j] = (u32x4){0u, 0u, 0u, 0u}; }
    }
}

__device__ __forceinline__ float sigmoidf_(float x) { return __builtin_amdgcn_rcpf(1.0f + __builtin_amdgcn_exp2f(-LOG2E * x)); }
__device__ __forceinline__ float gelu_tanh(float x) { constexpr float G1 = -2.0f * LOG2E * 0.7978845608028654f, G3 = G1 * 0.044715f;
    return x * __builtin_amdgcn_rcpf(1.0f + __builtin_amdgcn_exp2f(x * __builtin_fmaf(x * x, G3, G1))); }
__device__ __forceinline__ float one_minus_exp(float x) {
    const float ser = -x * (1.0f + x * (0.5f + x * (0.16666667f + x * (0.041666668f + x * 0.0083333338f))));
    const float dir = 1.0f - __builtin_amdgcn_exp2f(LOG2E * x);
    return x > -0.25f ? ser : dir;
}
constexpr int LRU_XCB = 0;
constexpr int LRU_ABP = 272;
constexpr int LRU_AS = 17408;
constexpr int LRU_BS = LRU_AS + 128 * LRU_ABP;
constexpr int LRU_XC = LRU_BS + 128 * LRU_ABP;
constexpr int LRU_SEG = LRU_XC + 32768;
template <int PASS>
__device__ __forceinline__ void lru_unit(Frame& F, const Params& p, int l, int unit) {
    const int b = unit >> 7, g = (unit >> 4) & 7, st = unit & 15;
    PHASE_IDS(); const int hi = lane >> 5, r32 = lane & 31;
    const bf16_t* proj = (const bf16_t*)(F.ws + WS_PROJ);
    bf16_t* mix = (bf16_t*)(F.ws + WS_MIX);
    float* lsum = (float*)(F.ws + WS_LRUSUM);
    LAS unsigned char* L = F.lds;
    const int cc = tid & 63, rg = wid;
    const float* pbl = (const float*)(F.ws + WS_PB) + l * PBL;
    const float* cw = pbl + PB_CW + g * 128 + 2 * cc; const float* cbp = pbl + PB_CB + g * 128 + 2 * cc;
    const f32x2 w0 = *(const f32x2*)(cw), w1 = *(const f32x2*)(cw + LRUW), w2 = *(const f32x2*)(cw + 2 * LRUW), w3 = *(const f32x2*)(cw + 3 * LRUW), cb = *(const f32x2*)cbp;
    const int tm = wid >> 2, tn = wid & 3; const int chl = tn * 32 + r32, chg = g * 128 + chl;
    const bf16_t* wat = (const bf16_t*)(F.ws + WS_WGATES) + (size_t)((l * 2 + 0) * 8 + g) * 128 * 128 + (size_t)chl * 128 + 8 * hi;
    const bf16_t* wxt = (const bf16_t*)(F.ws + WS_WGATES) + (size_t)((l * 2 + 1) * 8 + g) * 128 * 128 + (size_t)chl * 128 + 8 * hi;
    bf16x8 waf[8], wxf[8];
#pragma unroll
    for (int s = 0; s < 8; ++s) { waf[s] = *(const bf16x8*)(wat + 16 * s); wxf[s] = *(const bf16x8*)(wxt + 16 * s); }
    const float ban = -LOG2E * pbl[PB_BA + chg], bxn = -LOG2E * pbl[PB_BX + chg];
    const float sp8l = LOG2E * pbl[PB_SP8 + chg];
    const int sc = tid & 127, sg = tid >> 7; const int scg = g * 128 + sc;
    float hstate = 0.f, pstate = 1.f;
    if (PASS == 2 && st > 0) {
        if (wid == 0 && lane == 0) { unsigned* fw = F.ctl + CW_LRUF + ((l * 2 + b) * 8 + g) * 64; const unsigned need = (1u << st) - 1u;
            XB_SPIN((xb_ld(fw) & need) != need, F.ctl + CW_BAR);
            __builtin_amdgcn_fence(__ATOMIC_ACQUIRE, "agent"); asm volatile("s_waitcnt vmcnt(0)" ::: "memory"); }
        __syncthreads();
    }
    if (PASS == 2) {
#pragma unroll 1
        for (int s0 = 0; s0 < st; s0 += 8) { f32x2 ph[8];
#pragma unroll
            for (int j = 0; j < 8; ++j) ph[j] = *(const f32x2*)(lsum + ((size_t)(b * 16 + (s0 + j < st ? s0 + j : 0)) * LRUW + scg) * 2);
#pragma unroll
            for (int j = 0; j < 8; ++j) asm volatile("" : "+v"(ph[j]));
#pragma unroll
            for (int j = 0; j < 8; ++j) if (s0 + j < st) hstate = ph[j].x * hstate + ph[j].y; } }
    const int ntile = st == 0 ? 17 : 16;
    auto tile_pos0 = [&](int i) { return st == 0 ? (i == 0 ? 0 : NMETA + 64 * (i - 1)) : NMETA + 1024 * st + 64 * i; };
    auto load_u = [&](unsigned (&uu)[11], int i) {
        const int pos0 = tile_pos0(i);
#pragma unroll
        for (int k = 0; k < 11; ++k) { const int pos = pos0 + 8 * rg + k - 3;
            uu[k] = *(const unsigned*)(proj + (size_t)tok_row(b, pos < 0 ? 0 : pos) * NPROJ + OFF_U + g * 128 + 2 * cc); }
    };
    auto mask_u = [&](unsigned (&uu)[11], int i) {
        const int pos0 = tile_pos0(i), nv = (st == 0 && i == 0) ? 16 : 64;
#pragma unroll
        for (int k = 0; k < 11; ++k) { const int rr = 8 * rg + k - 3; if (!(pos0 + rr >= 0 && rr < nv)) uu[k] = 0u; }
    };
    unsigned ucur[11]; load_u(ucur, 0);
#define LT(k) do { } while (0)
    for (int i = 0; i < ntile; ++i) {
        LT(0);
        const int pos0 = tile_pos0(i), nvalid = (st == 0 && i == 0) ? 16 : 64;
        unsigned short ygv[16];
        const int segrow = tok_row(b, pos0 + 16 * sg);
        {
            mask_u(ucur, i);
            f32x2 uv[11];
#pragma unroll
            for (int k = 0; k < 11; ++k) uv[k] = (f32x2){bf_lo(ucur[k]), bf_hi(ucur[k])};
#pragma unroll
            for (int k = 0; k < 8; ++k) { const int rr = 8 * rg + k;
                const f32x2 xv = cb + w0 * uv[k + 3] + w1 * uv[k + 2] + w2 * uv[k + 1] + w3 * uv[k];
                *(LAS unsigned*)(L + LRU_XCB + rr * 272 + 4 * cc) = cvt_pk_bf16(xv.x, xv.y);
                *(LAS f32x2*)(L + LRU_XC + rr * 512 + 8 * cc) = xv; }
        }
        if (PASS == 2) { const bf16_t* ygp = proj + (size_t)segrow * NPROJ + OFF_YG + scg;
#pragma unroll
            for (int k = 0; k < 16; ++k) ygv[k] = ygp[(size_t)k * NPROJ];
        }
        if (i + 1 < ntile) load_u(ucur, i + 1);
        LDS_BARRIER(); LT(1);
        {
            f32x16 aa = {}, ax = {};
#pragma unroll
            for (int s = 0; s < 8; ++s) { const bf16x8 af = *(const LAS bf16x8*)(L + LRU_XCB + (32 * tm + r32) * 272 + 32 * s + 16 * hi);
                aa = __builtin_amdgcn_mfma_f32_32x32x16_bf16(af, waf[s], aa, 0, 0, 0); ax = __builtin_amdgcn_mfma_f32_32x32x16_bf16(af, wxf[s], ax, 0, 0, 0); }
            f32x4 av[4], bv[4];
#pragma unroll
            for (int r = 0; r < 16; ++r) { const int tt = 32 * tm + crow(r, hi);
                const float ra = __builtin_amdgcn_rcpf(1.0f + __builtin_amdgcn_exp2f(__builtin_fmaf(aa[r], -LOG2E, ban))), ix = __builtin_amdgcn_rcpf(1.0f + __builtin_amdgcn_exp2f(__builtin_fmaf(ax[r], -LOG2E, bxn)));
                const float xcv = *(const LAS float*)(L + LRU_XC + tt * 512 + 4 * chl);
                float a = __builtin_amdgcn_exp2f(sp8l * ra);
                float bb = __builtin_amdgcn_sqrtf(__builtin_fmaf(-a, a, 1.0f)) * (ix * xcv);
                if (nvalid < 64 && tt >= nvalid) { a = 1.f; bb = 0.f; }
                av[r >> 2][r & 3] = a; bv[r >> 2][r & 3] = bb; }
#pragma unroll
            for (int k = 0; k < 4; ++k) { const int o = chl * LRU_ABP + (32 * tm + 8 * k + 4 * hi) * 4; *(LAS f32x4*)(L + LRU_AS + o) = av[k]; *(LAS f32x4*)(L + LRU_BS + o) = bv[k]; }
        }
        LDS_BARRIER(); LT(2);
        float H = 0.f, P = 1.f;
        f32x4 a4[4], b4[4];
#pragma unroll
        for (int j = 0; j < 4; ++j) { const int o = sc * LRU_ABP + (16 * sg + 4 * j) * 4; a4[j] = *(const LAS f32x4*)(L + LRU_AS + o); b4[j] = *(const LAS f32x4*)(L + LRU_BS + o); }
#pragma unroll
        for (int k = 0; k < 16; ++k) { const float a = a4[k >> 2][k & 3], bb = b4[k >> 2][k & 3];
            H = a * H + bb; P *= a; }
        *(LAS f32x2*)(L + LRU_SEG + (sg * 128 + sc) * 8) = (f32x2){P, H};
        LDS_BARRIER(); LT(3);
        float cin = hstate;
#pragma unroll
        for (int s2 = 0; s2 < 4; ++s2) { const f32x2 ph = *(const LAS f32x2*)(L + LRU_SEG + (s2 * 128 + sc) * 8);
            if (s2 < sg) cin = ph.x * cin + ph.y;
            hstate = ph.x * hstate + ph.y; pstate *= ph.x; }
        if (PASS == 2 && 16 * sg < nvalid) {
            bf16_t* mp = mix + (size_t)segrow * DM + scg; float gl[16];
#pragma unroll
            for (int k = 0; k < 16; ++k) gl[k] = gelu_tanh(__uint_as_float((unsigned)ygv[k] << 16));
#pragma unroll
            for (int k = 0; k < 16; ++k) { const float a = a4[k >> 2][k & 3], bb = b4[k >> 2][k & 3];
                cin = a * cin + bb;
                mp[(size_t)k * DM] = (bf16_t)(cvt_pk_bf16(cin * gl[k], 0.f) & 0xffffu); }
        }
    }
#undef LT
    if (PASS == 1) {
        if (sg == 0) { const f32x2 ph = (f32x2){pstate, hstate};
            __hip_atomic_store((unsigned long long*)(lsum + ((size_t)(b * 16 + st) * LRUW + scg) * 2), __builtin_bit_cast(unsigned long long, ph), __ATOMIC_RELAXED, __HIP_MEMORY_SCOPE_AGENT); }
        asm volatile("s_waitcnt vmcnt(0)" ::: "memory");
        __syncthreads();
        if (wid == 0 && lane == 0) (void)__hip_atomic_fetch_or(F.ctl + CW_LRUF + ((l * 2 + b) * 8 + g) * 64, 1u << st, __ATOMIC_RELAXED, __HIP_MEMORY_SCOPE_AGENT);
    }
    __syncthreads();
}


constexpr int AT_KSTR = 144, AT_VSTR = 320;
constexpr float ATT_THRESH = 24.0f;
constexpr int AD_K1 = 0, AD_K2 = 8192, AD_V = 16384, AD_SUB = 32768, AD_STAGE = 65536;
constexpr int AT_EX = 0, AT_OS = 65536, AT_OSTR = 272;
static_assert(2 * AD_STAGE <= RING_BYTES && AT_OS + 128 * AT_OSTR <= RING_BYTES, "attention LDS");
__device__ __forceinline__ void lds_dma16(const void* g, const LAS unsigned char* l) {
    const unsigned la = __builtin_amdgcn_readfirstlane((unsigned)(uintptr_t)l);
    asm volatile("s_mov_b32 m0, %1\n\ts_nop 0\n\tglobal_load_lds_dwordx4 %0, off" :: "v"(g), "s"(la) : "memory", "m0");
}
__device__ __forceinline__ s16x4 ds_tr16(const LAS unsigned char* p) { typedef short v4i16_t __attribute__((ext_vector_type(4))); return __builtin_bit_cast(s16x4, __builtin_amdgcn_ds_read_tr16_b64_v4i16((LAS v4i16_t*)p)); }

__device__ __forceinline__ void attn_unit(Frame& F, const Params& p, int l, int b, int h, int qb) {
    PHASE_IDS(); const int hi = lane >> 5, r32 = lane & 31, map = wid >> 2, qs = wid & 3;
    const bf16_t* proj = (const bf16_t*)(F.ws + WS_PROJ);
    bf16_t* mix = (bf16_t*)(F.ws + WS_MIX);
    LAS unsigned char* L = F.lds;
    const float slope2 = exp2f(-(float)(h + 1)) * LOG2E;
    const int qi = qs * 32 + r32;
    int qrow, qpos; if (qb >= 0) { qrow = b * SEQ + 128 * qb + qi; qpos = NMETA + 128 * qb + qi; } else { qrow = NREAL + b * NMETA + (qi & 15); qpos = qi & 15; }
    bf16x8 qf[4]; float qbound;
    const int nreal = qb >= 0 ? 2 * qb + 2 : 0, ntile = nreal + 1;
    volatile LAS unsigned* DW = F.LC + 112;
    if (lane == 0) DW[wid] = 0x7fffffffu;
    bool wdone = false;
    const int dk_row = 8 * wid + (lane >> 3), dk_ch = (lane & 7) ^ ((dk_row >> 1) & 7);
    const int dv_row0 = 4 * wid + (lane >> 4), dv_ch = (lane & 15) ^ (4 * (dv_row0 & 3));
    auto dma_tile = [&](int kt, int boff) {
        const int r0 = kt >= 0 ? b * SEQ + 64 * kt : NREAL + b * NMETA;
        const bf16_t* rk = proj + (size_t)(kt >= 0 ? r0 + dk_row : r0 + (dk_row & 15)) * NPROJ + OFF_K + h * 128 + dk_ch * 8;
        const bf16_t* rv0 = proj + (size_t)(kt >= 0 ? r0 + dv_row0 : r0 + (dv_row0 & 15)) * NPROJ + OFF_V + h * 128 + dv_ch * 8;
        const bf16_t* rv1 = proj + (size_t)(kt >= 0 ? r0 + dv_row0 + 32 : r0 + (dv_row0 & 15)) * NPROJ + OFF_V + h * 128 + dv_ch * 8;
        LAS unsigned char* Bd = L + boff;
        lds_dma16(rk, Bd + AD_K1 + wid * 1024);
        lds_dma16(rk + 64, Bd + AD_K2 + wid * 1024);
        lds_dma16(rv0, Bd + AD_V + wid * 1024);
        lds_dma16(rv1, Bd + AD_V + 8192 + wid * 1024);
    };
    const int npair = qb >= 0 ? qb + 1 : 0, niter = npair + 1;
    auto dma_iter = [&](int it, int stage) { if (it < npair) { dma_tile(2 * (npair - 1 - it) + 1, stage); dma_tile(2 * (npair - 1 - it), stage + AD_SUB); } else dma_tile(-1, stage); };
    float m_run = -1e30f, l_run = 0.f;
    f32x16 O[4]; O[0] = f32x16{}; O[1] = f32x16{}; O[2] = f32x16{}; O[3] = f32x16{};
    f32x16 CB;
#pragma unroll
    for (int r = 0; r < 16; ++r) CB[r] = slope2 * (float)((r & 3) + 8 * (r >> 2));
    const f32x16 Z16 = {};
    const int vq = (lane & 15) >> 2, vp = lane & 3, vblk = (lane >> 4) & 1;
    const int vrow_off = (4 * hi + vq) * 256 + 32 * vblk + 8 * vp;
    const int kswz = (r32 >> 1) & 7;
    const int diag_kt = 2 * qb + (qs >> 1);
    bf16x8 pk[4];
#define AT_VRD2(dst, g_) do { _Pragma("unroll") for (int j_ = 0; j_ < 2; ++j_) { const int c_ = 2 * ((g_) & 1) + j_; \
            const s16x4 t0_ = ds_tr16(Vb_ + (16 * ((g_) >> 1)) * 256 + 64 * (c_ ^ vq)), t1_ = ds_tr16(Vb_ + (16 * ((g_) >> 1) + 8) * 256 + 64 * (c_ ^ vq)); \
            dst[j_] = (bf16x8){t0_[0], t0_[1], t0_[2], t0_[3], t1_[0], t1_[1], t1_[2], t1_[3]}; } } while (0)
#define AT_VMM(src, g_) do { O[2 * ((g_) & 1)] = __builtin_amdgcn_mfma_f32_32x32x16_bf16(src[0], pk[(g_) >> 1], O[2 * ((g_) & 1)], 0, 0, 0); \
            O[2 * ((g_) & 1) + 1] = __builtin_amdgcn_mfma_f32_32x32x16_bf16(src[1], pk[(g_) >> 1], O[2 * ((g_) & 1) + 1], 0, 0, 0); __builtin_amdgcn_sched_barrier(0); } while (0)
#define AT_WAIT_BAR() do { asm volatile("s_waitcnt vmcnt(0) lgkmcnt(0)" ::: "memory"); __builtin_amdgcn_s_barrier(); asm volatile("" ::: "memory"); } while (0)
    auto tile = [&](int kt, int boff) {
        const bool is_meta = kt < 0;
        const bool vis = (is_meta || (kt <= diag_kt)) && !wdone;
        if (vis) {
            const bool general = is_meta || (kt == diag_kt);
            f32x16 S0 = general ? Z16 : CB, S1 = S0;
            { const LAS unsigned char* Kb = L + boff + (map ? AD_K2 : AD_K1) + r32 * 128; bf16x8 ka[2], kb[2];
#define AT_KRD(dst, s_) do { dst[0] = *(const LAS bf16x8*)(Kb + 16 * ((2 * (s_) + hi) ^ kswz)); dst[1] = *(const LAS bf16x8*)(Kb + 32 * 128 + 16 * ((2 * (s_) + hi) ^ kswz)); } while (0)
#define AT_KMM(src, s_) do { S0 = __builtin_amdgcn_mfma_f32_32x32x16_bf16(src[0], qf[s_], S0, 0, 0, 0); S1 = __builtin_amdgcn_mfma_f32_32x32x16_bf16(src[1], qf[s_], S1, 0, 0, 0); __builtin_amdgcn_sched_barrier(0); } while (0)
              AT_KRD(ka, 0); AT_KRD(kb, 1); __builtin_amdgcn_sched_barrier(0);
              AT_KMM(ka, 0); AT_KRD(ka, 2); __builtin_amdgcn_sched_barrier(0);
              AT_KMM(kb, 1); AT_KRD(kb, 3); __builtin_amdgcn_sched_barrier(0);
              AT_KMM(ka, 2); AT_KMM(kb, 3);
#undef AT_KRD
#undef AT_KMM
            }
            float c0, c1;
            if (general) {
                const float kpos0 = is_meta ? 0.f : (float)(NMETA + 64 * kt);
                const float dq = (float)qpos - kpos0 - (float)(4 * hi);
#pragma unroll
                for (int r = 0; r < 16; ++r) { const float kc = (float)((r & 3) + 8 * (r >> 2));
                    S0[r] = S0[r] - slope2 * fabsf(dq - kc); S1[r] = S1[r] - slope2 * fabsf(dq - kc - 32.f);
                    if (is_meta) { if (r >= 8) S0[r] = -1e30f; S1[r] = -1e30f; } }
                c0 = 0.f; c1 = 0.f;
            } else {
                c0 = slope2 * (float)(NMETA + 64 * kt + 4 * hi - qpos); c1 = c0 + 32.f * slope2;
            }
            bool skip = false;
            { float mA, mB;
              asm("v_max3_f32 %0, %1, %2, %3" : "=v"(mA) : "v"(S0[0]), "v"(S0[1]), "v"(S0[2])); asm("v_max3_f32 %0, %1, %2, %3" : "=v"(mB) : "v"(S1[0]), "v"(S1[1]), "v"(S1[2]));
#pragma unroll
              for (int r = 3; r < 15; r += 2) { asm("v_max3_f32 %0, %1, %2, %3" : "=v"(mA) : "v"(mA), "v"(S0[r]), "v"(S0[r + 1])); asm("v_max3_f32 %0, %1, %2, %3" : "=v"(mB) : "v"(mB), "v"(S1[r]), "v"(S1[r + 1])); }
              mA = fmaxf(mA, S0[15]); mB = fmaxf(mB, S1[15]);
              float mt = fmaxf(mA + c0, mB + c1);
              if (!general && __all(mt < m_run - ATT_THRESH)) skip = true;
              else {
                mt = max32(mt);
                if (__any(mt > m_run + 8.0f)) {
                    const float m_new = fmaxf(m_run, mt);
                    const float alpha = __builtin_amdgcn_exp2f(m_run - m_new);
                    m_run = m_new; l_run *= alpha;
#pragma unroll
                    for (int c = 0; c < 4; ++c) O[c] *= alpha;
                }
              } }
            if (!skip) {
            const float e0 = c0 - m_run, e1 = c1 - m_run;
            float ps0 = 0.f, ps1 = 0.f;
#pragma unroll
            for (int r = 0; r < 16; ++r) { S0[r] = __builtin_amdgcn_exp2f(S0[r] + e0); S1[r] = __builtin_amdgcn_exp2f(S1[r] + e1); ps0 += S0[r]; ps1 += S1[r]; }
            l_run += ps0 + ps1;
#pragma unroll
            for (int s2 = 0; s2 < 2; ++s2) {
                u32x4 w0, w1;
                w0.x = cvt_pk_bf16(S0[8 * s2 + 0], S0[8 * s2 + 1]); w0.y = cvt_pk_bf16(S0[8 * s2 + 2], S0[8 * s2 + 3]); w0.z = cvt_pk_bf16(S0[8 * s2 + 4], S0[8 * s2 + 5]); w0.w = cvt_pk_bf16(S0[8 * s2 + 6], S0[8 * s2 + 7]);
                w1.x = cvt_pk_bf16(S1[8 * s2 + 0], S1[8 * s2 + 1]); w1.y = cvt_pk_bf16(S1[8 * s2 + 2], S1[8 * s2 + 3]); w1.z = cvt_pk_bf16(S1[8 * s2 + 4], S1[8 * s2 + 5]); w1.w = cvt_pk_bf16(S1[8 * s2 + 6], S1[8 * s2 + 7]);
                pk[s2] = __builtin_bit_cast(bf16x8, w0); pk[2 + s2] = __builtin_bit_cast(bf16x8, w1);
            }
            __builtin_amdgcn_sched_barrier(0);
            { const LAS unsigned char* Vb_ = L + boff + AD_V + vrow_off; bf16x8 va_[2], vb_[2], vc_[2];
              AT_VRD2(va_, 0); AT_VRD2(vb_, 1); __builtin_amdgcn_sched_barrier(0);
              AT_VRD2(vc_, 2); __builtin_amdgcn_sched_barrier(0); AT_VMM(va_, 0);
              AT_VRD2(va_, 3); __builtin_amdgcn_sched_barrier(0); AT_VMM(vb_, 1);
              AT_VRD2(vb_, 4); __builtin_amdgcn_sched_barrier(0); AT_VMM(vc_, 2);
              AT_VRD2(vc_, 5); __builtin_amdgcn_sched_barrier(0); AT_VMM(va_, 3);
              AT_VRD2(va_, 6); __builtin_amdgcn_sched_barrier(0); AT_VMM(vb_, 4);
              AT_VRD2(vb_, 7); __builtin_amdgcn_sched_barrier(0); AT_VMM(vc_, 5);
              AT_VMM(va_, 6); AT_VMM(vb_, 7); }
            }
        }
        if (!wdone && !is_meta) {
            const float dmin = (float)(qpos - (NMETA + 64 * kt) + 1);
            const bool c = qbound - slope2 * dmin < m_run - ATT_THRESH;
            if (__all(c)) wdone = true;
        }
    };
    dma_iter(0, 0);
    unsigned* kw = F.ctl + CW_KMAX + l * 64 + ((b * NHEAD + h) * 2 + map) * 2;
    const unsigned kw0 = xb_ld(kw), kw1 = xb_ld(kw + 1);
#pragma unroll
    for (int s = 0; s < 4; ++s) qf[s] = *(const bf16x8*)(proj + (size_t)qrow * NPROJ + OFF_Q + h * 128 + map * 64 + 16 * s + 8 * hi);
    { float s = 0.f;
#pragma unroll
      for (int ss = 0; ss < 4; ++ss)
#pragma unroll
          for (int j = 0; j < 8; ++j) { const float v = __uint_as_float(((unsigned)(unsigned short)qf[ss][j]) << 16); s += v * v; }
      s = sum32(s);
      const float kmx = __uint_as_float(kw0) + __uint_as_float(kw1);
      qbound = sqrtf(s * kmx) * 1.0041f + 1e-3f; }
    AT_WAIT_BAR();
    int stage = 0;
    for (int it = 0; it < niter; ++it) {
        if (it + 1 < niter) dma_iter(it + 1, stage ^ AD_STAGE);
        { const int nsub = it < npair ? 2 : 1, kt0 = it < npair ? 2 * (npair - 1 - it) + 1 : -1;
#pragma unroll 1
          for (int sub = 0; sub < nsub; ++sub) { tile(kt0 - sub, stage + sub * AD_SUB); __builtin_amdgcn_sched_barrier(0); } }
        if (wdone && lane == 0 && DW[wid] == 0x7fffffffu) DW[wid] = (unsigned)it;
        stage ^= AD_STAGE;
        AT_WAIT_BAR();
        { const u32x4 d0 = *(const LAS u32x4*)(F.lds + LCTL_OFF + 112 * 4), d1 = *(const LAS u32x4*)(F.lds + LCTL_OFF + 116 * 4);
          const unsigned dm = max(max(max(d0.x, d0.y), max(d0.z, d0.w)), max(max(d1.x, d1.y), max(d1.z, d1.w)));
          if (dm <= (unsigned)it) break; }
    }
#undef AT_VRD2
#undef AT_VMM
#undef AT_WAIT_BAR
    __syncthreads();
    unsigned nxt_unit = 0u;
    if (wid == 0 && lane == 0) nxt_unit = atomicAdd(F.ctl + CW_QUEUE + l * 64, 1u);
    const float lt = sum32(l_run);
    const float inv = 1.0f / lt;
    if (map == 1) {
#pragma unroll
        for (int c = 0; c < 4; ++c)
#pragma unroll
            for (int r = 0; r < 16; ++r) *(LAS float*)(L + AT_EX + ((32 * c + crow(r, hi)) * 128 + qi) * 4) = O[c][r] * inv;
    }
    LDS_BARRIER();
    if (map == 0) {
        const float* pbl = (const float*)(F.ws + WS_PB) + l * PBL;
        const float lam = pbl[PB_LAM], lam_init = pbl[PB_LAM + 1];
        float ss = 0.f;
#pragma unroll
        for (int c = 0; c < 4; ++c)
#pragma unroll
            for (int r = 0; r < 16; ++r) { const float o2 = *(const LAS float*)(L + AT_EX + ((32 * c + crow(r, hi)) * 128 + qi) * 4); const float o = O[c][r] * inv - lam * o2; O[c][r] = o; ss += o * o; }
        ss = sum32(ss);
        const float rn = (1.0f / sqrtf(ss * (1.f / 128.f) + RMS_EPS)) * (1.0f - lam_init);
#pragma unroll
        for (int c = 0; c < 4; ++c)
#pragma unroll
            for (int r = 0; r < 16; r += 2) { const int dv = 32 * c + crow(r, hi);
                *(LAS unsigned*)(L + AT_OS + qi * AT_OSTR + dv * 2) = cvt_pk_bf16(O[c][r] * rn, O[c][r + 1] * rn); }
    }
    LDS_BARRIER();
#pragma unroll
    for (int i = 0; i < 4; ++i) { const int idx = tid + 512 * i, row = idx >> 4, ch = idx & 15;
        const bool ok = qb >= 0 || row < 16;
        if (ok) { const int orow = qb >= 0 ? b * SEQ + 128 * qb + row : NREAL + b * NMETA + row;
            *(u32x4*)(mix + (size_t)orow * DM + LRUW + h * 128 + ch * 8) = *(const LAS u32x4*)(L + AT_OS + row * AT_OSTR + ch * 16); } }
    if (wid == 0 && lane == 0) F.LC[0] = nxt_unit;
    LDS_BARRIER();
}


constexpr int NT32 = (NTOK + 31) / 32;
constexpr int RT_PART = 0;
constexpr int RT_SSQ = 8 * 2 * 32 * 33 * 4;
__device__ __forceinline__ void router_phase(Frame& F, const Params& p, int l) {
    const bool count = true;
    PHASE_IDS(); const int hi = lane >> 5, r32 = lane & 31;
    const int ntile_b = F.bid < NT32 ? (NT32 - F.bid + F.G - 1) / F.G : 0;
    volatile LAS unsigned* hist = F.LC + 16;
    if (tid < 16) hist[tid] = 0u;
    __syncthreads();
    const bf16_t* wrh = (const bf16_t*)(F.ws + WS_WR) + (size_t)(l * 2) * 32 * DM; const bf16_t* wrl = wrh + (size_t)32 * DM;
    const bf16_t* hbp = (const bf16_t*)(F.ws + WS_XN);
    const float* rgb = (const float*)(F.ws + WS_PB) + l * PBL + PB_RGB; const float* reb = (const float*)(F.ws + WS_PB) + l * PBL + PB_REB;
    u32x4* tokinfo = (u32x4*)(F.ws + WS_TOKINFO);
    LAS float* part = (LAS float*)(F.lds + RT_PART); LAS float* ssqp = (LAS float*)(F.lds + RT_SSQ);
    float lbias[20];
#pragma unroll
    for (int o = 0; o < 20; ++o) lbias[o] = o < 4 ? rgb[o] : reb[o - 4];
    asm volatile("" : "+v"(lbias[0]), "+v"(lbias[1]), "+v"(lbias[2]), "+v"(lbias[3]), "+v"(lbias[4]), "+v"(lbias[5]), "+v"(lbias[6]), "+v"(lbias[7]), "+v"(lbias[8]), "+v"(lbias[9]));
    asm volatile("" : "+v"(lbias[10]), "+v"(lbias[11]), "+v"(lbias[12]), "+v"(lbias[13]), "+v"(lbias[14]), "+v"(lbias[15]), "+v"(lbias[16]), "+v"(lbias[17]), "+v"(lbias[18]), "+v"(lbias[19]));
    for (int k0 = 0; k0 < ntile_b; k0 += 4) {
        const int ntr = ntile_b - k0 < 4 ? ntile_b - k0 : 4;
        f32x16 acc[4]; float ssq[4]; const bf16_t* hp[4];
#pragma unroll
        for (int t = 0; t < 4; ++t) { acc[t] = f32x16{}; ssq[t] = 0.f; const int tt = t < ntr ? t : ntr - 1;
            int row = 32 * (F.bid + F.G * (k0 + tt)) + r32; row = row < NTOK ? row : NTOK - 1; hp[t] = hbp + (size_t)row * DM + wid * 256 + 8 * hi; }
        const bf16_t* wph = wrh + (size_t)r32 * DM + wid * 256 + 8 * hi; const bf16_t* wpl = wrl + (size_t)r32 * DM + wid * 256 + 8 * hi;
        if (ntr == 1) {
#pragma unroll 1
            for (int c0 = 0; c0 < 16; c0 += 8) {
                bf16x8 av[8], wh[8], wl[8];
#pragma unroll
                for (int u = 0; u < 8; ++u) { wh[u] = *(const bf16x8*)(wph + 16 * (c0 + u)); wl[u] = *(const bf16x8*)(wpl + 16 * (c0 + u)); av[u] = *(const bf16x8*)(hp[0] + 16 * (c0 + u)); }
                __builtin_amdgcn_sched_barrier(0);
#pragma unroll
                for (int u = 0; u < 8; ++u) {
#pragma unroll
                    for (int j = 0; j < 8; ++j) { const float v = __uint_as_float(((unsigned)(unsigned short)av[u][j]) << 16); ssq[0] += v * v; }
                    acc[0] = __builtin_amdgcn_mfma_f32_32x32x16_bf16(av[u], wh[u], acc[0], 0, 0, 0); acc[0] = __builtin_amdgcn_mfma_f32_32x32x16_bf16(av[u], wl[u], acc[0], 0, 0, 0); }
                __builtin_amdgcn_sched_barrier(0);
            }
        } else
#pragma unroll 1
        for (int c0 = 0; c0 < 16; c0 += 4) {
            bf16x8 av[4][4], wh[4], wl[4];
#pragma unroll
            for (int u = 0; u < 4; ++u) { wh[u] = *(const bf16x8*)(wph + 16 * (c0 + u)); wl[u] = *(const bf16x8*)(wpl + 16 * (c0 + u));
#pragma unroll
                for (int t = 0; t < 4; ++t) av[t][u] = *(const bf16x8*)(hp[t] + 16 * (c0 + u)); }
            __builtin_amdgcn_sched_barrier(0);
#pragma unroll
            for (int u = 0; u < 4; ++u)
#pragma unroll
                for (int t = 0; t < 4; ++t) {
#pragma unroll
                    for (int j = 0; j < 8; ++j) { const float v = __uint_as_float(((unsigned)(unsigned short)av[t][u][j]) << 16); ssq[t] += v * v; }
                    acc[t] = __builtin_amdgcn_mfma_f32_32x32x16_bf16(av[t][u], wh[u], acc[t], 0, 0, 0); acc[t] = __builtin_amdgcn_mfma_f32_32x32x16_bf16(av[t][u], wl[u], acc[t], 0, 0, 0); }
            __builtin_amdgcn_sched_barrier(0);
        }
#pragma unroll
        for (int ps = 0; ps < 2; ++ps) {
            if (2 * ps >= ntr) continue;
#pragma unroll
            for (int tp = 0; tp < 2; ++tp) { const float sq_ = sum32(ssq[2 * ps + tp]);
#pragma unroll
                for (int r = 0; r < 16; ++r) part[((wid * 2 + tp) * 32 + crow(r, hi)) * 33 + r32] = acc[2 * ps + tp][r];
                if (hi == 0) ssqp[(wid * 2 + tp) * 32 + r32] = sq_; }
            __syncthreads();
            if (tid < 64) {
                const int ts2 = tid >> 5, i = tid & 31; const int row = 32 * (F.bid + F.G * (k0 + 2 * ps + ts2)) + i;
                if (2 * ps + ts2 < ntr && row < NTOK) {
                    float sq = 0.f;
#pragma unroll
                    for (int sl = 0; sl < 8; ++sl) sq += ssqp[(sl * 2 + ts2) * 32 + i];
                const float rstd = 1.0f / sqrtf(sq * (1.f / DM) + RMS_EPS);
                float lg[20];
#pragma unroll
                for (int o = 0; o < 20; ++o) { float a = 0.f;
#pragma unroll
                    for (int sl = 0; sl < 8; ++sl) a += part[((sl * 2 + ts2) * 32 + i) * 33 + o]; lg[o] = a * rstd + lbias[o]; }
                int gi = 0; float gm = lg[0];
#pragma unroll
                for (int o = 1; o < 4; ++o) if (lg[o] > gm) { gm = lg[o]; gi = o; }
                float gs = 0.f;
#pragma unroll
                for (int o = 0; o < 4; ++o) gs += __expf(lg[o] - gm);
                const float gprob = 1.0f / gs;
                float li[4];
#pragma unroll
                for (int j = 0; j < 4; ++j) li[j] = gi == 0 ? lg[4 + j] : gi == 1 ? lg[8 + j] : gi == 2 ? lg[12 + j] : lg[16 + j];
                int i1 = 0; float v1 = li[0];
#pragma unroll
                for (int j = 1; j < 4; ++j) if (li[j] > v1) { v1 = li[j]; i1 = j; }
                int i2 = -1; float v2 = -3.0e38f;
#pragma unroll
                for (int j = 0; j < 4; ++j) if (j != i1 && li[j] > v2) { v2 = li[j]; i2 = j; }
                const float e2 = __expf(v2 - v1); const float p1 = 1.0f / (1.0f + e2), p2 = e2 / (1.0f + e2);
                const int ea = gi * 4 + i1, eb = gi * 4 + i2;
                u32x4 ti; ti.x = (unsigned)ea | ((unsigned)eb << 8); ti.y = __float_as_uint(p1 * gprob); ti.z = __float_as_uint(p2 * gprob); ti.w = __float_as_uint(rstd);
                tokinfo[row] = ti;
                if (count) { lds_add((LAS unsigned*)&hist[ea], 1u); lds_add((LAS unsigned*)&hist[eb], 1u); }
                }
            }
            __syncthreads();
        }
    }
    if (tid < 16 && count) { const unsigned hc = hist[tid]; ((unsigned*)(F.ws + WS_HIST))[F.bid * 16 + tid] = hc; if (hc) atomicAdd(F.ctl + CW_CNT + l * 16 + tid, hc); }
    __syncthreads();
}

__device__ __forceinline__ void moe_tables(Frame& F, int l) {
    const int tz = (F.wid << 6) | lane_now();
    if (tz < 64) {
        const int ln = tz & 63; const int c = ln < 16 ? (int)xb_ld(F.ctl + CW_CNT + l * 16 + ln) : 0; const int np = (c + 255) >> 8;
        int inc = np;
#pragma unroll
        for (int o = 1; o < 16; o <<= 1) { const int t = __builtin_amdgcn_ds_bpermute((ln - o) << 2, inc); if (ln >= o) inc += t; }
        if (ln < 16) { F.LC[32 + ln] = (unsigned)(inc - np); F.LC[64 + ln] = (unsigned)((inc - np) * 256); }
        if (ln == 15) { F.LC[48] = (unsigned)inc; F.LC[80] = (unsigned)(inc * 256); } }
    __syncthreads();
}

__device__ __forceinline__ void slots_phase(Frame& F, const Params& p, int l) {
    PHASE_IDS();
    const int ntile_b = F.bid < NT32 ? (NT32 - F.bid + F.G - 1) / F.G : 0;
    moe_tables(F, l);
    volatile LAS unsigned* boff = F.LC + 96;
    if (tid < 16) boff[tid] = 0u;
    __syncthreads();
    { const unsigned* hg = (const unsigned*)(F.ws + WS_HIST); const int e = tid & 15; unsigned sacc = 0;
#pragma unroll 1
      for (int base = 0; base < F.bid; base += 256) { unsigned hv[8];
#pragma unroll
          for (int j = 0; j < 8; ++j) { const int bb = base + (tid >> 4) + 32 * j; hv[j] = hg[(bb < F.bid ? bb : 0) * 16 + e]; }
#pragma unroll
          for (int j = 0; j < 8; ++j) { const int bb = base + (tid >> 4) + 32 * j; sacc += bb < F.bid ? hv[j] : 0u; } }
      if (sacc) lds_add((LAS unsigned*)&boff[e], sacc); }
    __syncthreads();
    const u32x4* tokinfo = (const u32x4*)(F.ws + WS_TOKINFO);
    u32x2* tokslot = (u32x2*)(F.ws + WS_TOKSLOT);
    int* tokmap = (int*)(F.ws + WS_TOKMAP); float* rslot = (float*)(F.ws + WS_RSLOT);
    if (wid == 0) {
        volatile LAS unsigned* run = F.LC + 128;
        if (lane < 16) run[lane] = F.LC[64 + lane] + boff[lane];
        for (int k0 = 0; k0 < ntile_b; k0 += 2) {
            const int kk = k0 + (lane >> 5); const int row = 32 * (F.bid + F.G * kk) + (lane & 31); const bool ok = kk < ntile_b && row < NTOK;
            u32x4 ti = (u32x4){0xffffu, 0u, 0u, 0u}; if (ok) ti = tokinfo[row];
            const unsigned ea = ti.x & 0xffu, eb = (ti.x >> 8) & 0xffu;
            unsigned sa = 0, sb2 = 0;
#pragma unroll 1
            for (int e = 0; e < 16; ++e) {
                const bool hit = ok && (ea == (unsigned)e || eb == (unsigned)e);
                const unsigned long long mk = __ballot(hit);
                const unsigned rank = __popcll(mk & ((1ull << lane) - 1ull));
                const unsigned cur = run[e];
                if (ea == (unsigned)e) sa = cur + rank;
                if (eb == (unsigned)e) sb2 = cur + rank;
                if (lane == 0) run[e] = cur + (unsigned)__popcll(mk);
            }
            if (ok) { tokslot[row] = (u32x2){sa, sb2}; tokmap[sa] = row; tokmap[sb2] = row; const float rs = __uint_as_float(ti.w); rslot[sa] = rs; rslot[sb2] = rs; }
        }
    }
    if (F.bid < 16) {
        const int e = F.bid; const int c = (int)xb_ld(F.ctl + CW_CNT + l * 16 + e), base = (int)F.LC[64 + e], pc = ((c + 255) >> 8) << 8;
        for (int i = c + tid; i < pc; i += 512) { tokmap[base + i] = 0; rslot[base + i] = 0.f; }
    }
    __syncthreads();
}

__device__ __forceinline__ void combine_phase(Frame& F, const Params& p, int l) {
    PHASE_IDS(); const int gw = F.bid * 8 + wid, NGW = F.G * 8;
    const u32x4* tokinfo = (const u32x4*)(F.ws + WS_TOKINFO);
    const u32x2* tokslot = (const u32x2*)(F.ws + WS_TOKSLOT);
    const unsigned char* y = (const unsigned char*)(F.ws + WS_PROJ);
    bf16_t* xn = (bf16_t*)(F.ws + WS_XN);
    const bool lastl = (l == DEPTH - 1);
    const int nrows = lastl ? NREAL : NTOK;
    u32x4 ti_n = (u32x4){0u, 0u, 0u, 0u}; u32x2 ts_n = (u32x2){0u, 0u};
    f32x4 fg0[4], fg1[4];
#pragma unroll
    for (int j = 0; j < 4; ++j) { fg0[j] = (f32x4){0.f, 0.f, 0.f, 0.f}; fg1[j] = fg0[j]; }
    if (lastl) { const float* gp = (const float*)(F.ws + WS_PB) + PB_FING + lane * 8;
#pragma unroll
        for (int j = 0; j < 4; ++j) { fg0[j] = *(const f32x4*)(gp + 512 * j); fg1[j] = *(const f32x4*)(gp + 512 * j + 4); } }
    if (gw < nrows) { ti_n = tokinfo[gw]; ts_n = tokslot[gw]; }
    for (int row = gw; row < nrows; row += NGW) {
        const u32x4 ti = ti_n; const u32x2 ts = ts_n;
        { const int nr = row + NGW < nrows ? row + NGW : row; ti_n = tokinfo[nr]; ts_n = tokslot[nr]; }
        asm volatile("" ::: "memory");
        const float wa = __uint_as_float(ti.y) * Y8_INV, wb = __uint_as_float(ti.z) * Y8_INV;
        const u32x4* hb = (const u32x4*)(xn + (size_t)row * DM) + lane;
        const u32x2* ya = (const u32x2*)(y + (size_t)ts.x * DM) + lane; const u32x2* yb = (const u32x2*)(y + (size_t)ts.y * DM) + lane;
        u32x4 hq[4]; u32x2 aq[4], bq[4];
#pragma unroll
        for (int j = 0; j < 4; ++j) { hq[j] = hb[64 * j]; aq[j] = ya[64 * j]; bq[j] = yb[64 * j]; }
        float v[4][8]; float s = 0.f;
#pragma unroll
        for (int j = 0; j < 4; ++j)
#pragma unroll
            for (int w2 = 0; w2 < 2; ++w2) {
                const auto a0 = __builtin_amdgcn_cvt_pk_f32_fp8((int)aq[j][w2], false), a1 = __builtin_amdgcn_cvt_pk_f32_fp8((int)aq[j][w2], true);
                const auto b0 = __builtin_amdgcn_cvt_pk_f32_fp8((int)bq[j][w2], false), b1 = __builtin_amdgcn_cvt_pk_f32_fp8((int)bq[j][w2], true);
                const unsigned h0 = hq[j][2 * w2], h1 = hq[j][2 * w2 + 1];
                const float v0 = bf_lo(h0) + wa * a0[0] + wb * b0[0], v1 = bf_hi(h0) + wa * a0[1] + wb * b0[1], v2 = bf_lo(h1) + wa * a1[0] + wb * b1[0], v3 = bf_hi(h1) + wa * a1[1] + wb * b1[1];
                v[j][4 * w2] = v0; v[j][4 * w2 + 1] = v1; v[j][4 * w2 + 2] = v2; v[j][4 * w2 + 3] = v3; s += (v0 * v0 + v1 * v1) + (v2 * v2 + v3 * v3); }
        const float rms = sqrtf(wave_sum(s) * (1.f / DM) + RMS_EPS), rstd = 1.0f / rms;
        asm volatile("" : "+v"(ti_n.x), "+v"(ti_n.y), "+v"(ti_n.z), "+v"(ti_n.w), "+v"(ts_n.x), "+v"(ts_n.y));
        if (!lastl) {
            if (lane == 0) ((float*)(F.ws + WS_RINV))[row] = rms;
            u32x4* o8 = (u32x4*)(xn + (size_t)row * DM) + lane;
#pragma unroll
            for (int j = 0; j < 4; ++j) { u32x4 wn;
#pragma unroll
                for (int e = 0; e < 4; ++e) wn[e] = cvt_pk_bf16(v[j][2 * e] * rstd, v[j][2 * e + 1] * rstd);
                o8[64 * j] = wn; }
        } else {
            float* op = p.out + (size_t)row * DM + lane * 8;
#pragma unroll
            for (int j = 0; j < 4; ++j) { const f32x4 g0 = fg0[j], g1 = fg1[j];
                { *(f32x4*)(op + 512 * j) = (f32x4){v[j][0] * rstd * g0.x, v[j][1] * rstd * g0.y, v[j][2] * rstd * g0.z, v[j][3] * rstd * g0.w};
                            *(f32x4*)(op + 512 * j + 4) = (f32x4){v[j][4] * rstd * g1.x, v[j][5] * rstd * g1.y, v[j][6] * rstd * g1.z, v[j][7] * rstd * g1.w}; } }
        }
    }
}

template <class Sink>
__device__ __forceinline__ void meta_gemm_group(LAS unsigned char* lds, int wid, const bf16_t* A, const bf16_t* Bt, int K, const Sink& sink) {
    asm volatile("" : "+s"(wid)); const int lane = lane_now(), tid = (wid << 6) | lane; const int hi = lane >> 5, r32 = lane & 31;
    const int kper = K >> 3;
    const bf16_t* ap = A + (size_t)r32 * K + wid * kper + 8 * hi; const bf16_t* bp = Bt + (size_t)r32 * K + wid * kper + 8 * hi;
    f32x16 acc = {};
#pragma unroll 1
    for (int s0 = 0; s0 < kper / 16; s0 += 8) { bf16x8 av[8], bv[8];
#pragma unroll
        for (int u = 0; u < 8; ++u) { av[u] = *(const bf16x8*)(ap + 16 * (s0 + u)); bv[u] = *(const bf16x8*)(bp + 16 * (s0 + u)); }
        __builtin_amdgcn_sched_barrier(0);
#pragma unroll
        for (int u = 0; u < 8; ++u) acc = __builtin_amdgcn_mfma_f32_32x32x16_bf16(av[u], bv[u], acc, 0, 0, 0);
        __builtin_amdgcn_sched_barrier(0); }
    LAS float* part = (LAS float*)lds;
#pragma unroll
    for (int r = 0; r < 16; ++r) part[(wid * 32 + crow(r, hi)) * 33 + r32] = acc[r];
    __syncthreads();
#pragma unroll
    for (int o = 0; o < 2; ++o) { const int e = tid + 512 * o, row = e >> 5, col = e & 31; float v = 0.f;
#pragma unroll
        for (int w = 0; w < 8; ++w) v += part[(w * 32 + row) * 33 + col];
        sink(row, col, v); }
    __syncthreads();
}

constexpr int PH_PER_LAYER = 9, N_PHASES = 1 + DEPTH * PH_PER_LAYER;
__global__ void __launch_bounds__(512, 2) mega_fwd(Params p) {
    extern __shared__ __attribute__((aligned(16))) unsigned char lds_raw[];
    Frame F;
    F.lds = (LAS unsigned char*)lds_raw; F.LC = (volatile LAS unsigned*)(F.lds + LCTL_OFF);
    F.G = gridDim.x; F.bid = blockIdx.x; F.wid = __builtin_amdgcn_readfirstlane(threadIdx.x >> 6);
    F.ws = p.ws; F.ctl = (unsigned*)(p.ws + WS_CTL);
    for (int u = threadIdx.x; u < (LDS_BYTES - LCTL_OFF) / 4; u += 512) F.LC[u] = 0u;
    __syncthreads();
    XcdBarrier bar; bar.bar = F.ctl + CW_BAR; bar.x = 0; bar.st = nullptr; bar.wid = F.wid;
    const int lo = p.ph_lo, hi = p.ph_hi;
    if (hi - lo > 1) { bar = xcd_barrier_post(F.ctl + CW_BAR, F.LC + 8, F.wid); xcd_barrier_census(bar); }
#define IN(k) (lo <= (k) && (k) < hi)
#define REBASE() do { __attribute__((address_space(1))) unsigned char* g_ = (__attribute__((address_space(1))) unsigned char*)p.ws; asm volatile("" : "+s"(g_));     \
        F.ws = (unsigned char*)g_; F.ctl = (unsigned*)(F.ws + WS_CTL); } while (0)
#define SEAM(k) do { if (IN(k) && IN((k) + 1)) xcd_barrier(bar); } while (0)
    if (IN(0)) p0_prologue(F, p);
    SEAM(0);
    for (int l = 0; l < DEPTH; ++l) {
        const int pb = 1 + l * PH_PER_LAYER;
        if (IN(pb + 0)) { REBASE();
            { bf16_t* projm = (bf16_t*)(F.ws + WS_PROJ) + (size_t)NREAL * NPROJ;
              for (int g = F.bid; g < NPROJ / 32; g += F.G)
                  meta_gemm_group(F.lds, F.wid, (const bf16_t*)(F.ws + WS_XN) + (size_t)NREAL * DM, (const bf16_t*)(F.ws + WS_WIN) + ((size_t)l * NPROJ + 32 * g) * DM, DM,
                                  [&](int row, int col, float v) { projm[(size_t)row * NPROJ + 32 * g + col] = (bf16_t)(cvt_pk_bf16(v, 0.f) & 0xffffu);
                                      if (32 * g >= OFF_K && 32 * g < OFF_K + NHEAD * 128) {
                                          float q = v * v; q += shx1(q); q += shx2(q); q += shxs<4>(q); q += shxs<8>(q); q += shxs<16>(q);
                                          const int cc = 32 * g - OFF_K;
                                          if (col == 0) atomicMax(F.ctl + CW_KMAX + l * 64 + (((row >> 4) * NHEAD + (cc >> 7)) * 2 + ((cc >> 6) & 1)) * 2 + ((cc >> 5) & 1), __float_as_uint(q)); } }); }
            pg8::DenseOrder S; S.init(F.ws + WS_XN, F.ws + WS_WIN + (size_t)l * NPROJ * DM * 2, NREAL, NPROJ, DM, F.G, F.bid);
            pg8::EpiBf16 E{(bf16_t*)(F.ws + WS_PROJ), NPROJ, 1.0f, F.ctl + CW_KMAX + l * 64};
            pg8::gemm_phase<pg8::EpiBf16, pg8::DenseOrder>(F.lds, F.wid, DM, S, E);
        }
        SEAM(pb + 0);
        if (IN(pb + 1)) { REBASE();
            for (int u = F.bid; u < 256; u += F.G) lru_unit<1>(F, p, l, u);
            for (int u = F.bid; u < 256; u += F.G) lru_unit<2>(F, p, l, u);
            }
        if (IN(pb + 2)) { REBASE();
            __syncthreads();
            if (F.wid == 0 && lane_now() == 0) F.LC[0] = atomicAdd(F.ctl + CW_QUEUE + l * 64, 1u);
            __syncthreads();
            for (;;) {
                const int u = (int)F.LC[0];
                if (u >= 16 * 129) break;
                const int qb = 127 - (u >> 4), bh = u & 15;
                attn_unit(F, p, l, bh >> 3, bh & 7, qb);
            }
        }
        SEAM(pb + 2);
        if (IN(pb + 3)) { REBASE();
            { bf16_t* hbm = (bf16_t*)(F.ws + WS_XN) + (size_t)NREAL * DM; unsigned char* hbm8 = (unsigned char*)(F.ws + WS_HB8) + (size_t)NREAL * DM; const float* rmsm = (const float*)(F.ws + WS_RINV) + NREAL;
              for (int g = F.bid; g < DM / 32; g += F.G)
                  meta_gemm_group(F.lds, F.wid, (const bf16_t*)(F.ws + WS_MIX) + (size_t)NREAL * DM, (const bf16_t*)(F.ws + WS_WOUT) + ((size_t)l * DM + 32 * g) * DM, DM,
                                  [&](int row, int col, float v) { const int c = 32 * g + col;
                                      const float bs = __uint_as_float((unsigned)hbm[(size_t)row * DM + c] << 16) * rmsm[row];
                                      hbm[(size_t)row * DM + c] = (bf16_t)(cvt_pk_bf16(bs + v, 0.f) & 0xffffu); hbm8[(size_t)row * DM + c] = (unsigned char)(cvt4_fp8(bs + v, 0.f, 0.f, 0.f) & 0xffu); }); }
            pg8::DenseOrder S; S.init(F.ws + WS_MIX, F.ws + WS_WOUT + (size_t)l * DM * DM * 2, NREAL, DM, DM, F.G, F.bid);
            pg8::EpiResid E{(bf16_t*)(F.ws + WS_XN), (const float*)(F.ws + WS_RINV), (unsigned char*)(F.ws + WS_HB8)};
            pg8::gemm_phase<pg8::EpiResid, pg8::DenseOrder>(F.lds, F.wid, DM, S, E);
        }
        SEAM(pb + 3);
        if (IN(pb + 4)) { REBASE(); router_phase(F, p, l); }
        SEAM(pb + 4);
        if (IN(pb + 5)) { REBASE(); slots_phase(F, p, l); }
        SEAM(pb + 5);
        if (IN(pb + 6)) { REBASE();
            if (hi - lo == 1) moe_tables(F, l);
            pg8::MoeOrder S{(const char*)(F.ws + WS_HB8), (const char*)(F.ws + WS_WGU + (size_t)l * 16 * 1024 * DM), (size_t)0, (size_t)1024 * DM, (size_t)256 * DM, 4, F.G, F.bid,
                            (const LAS int*)(F.lds + LCTL_OFF + 32 * 4), (const LAS int*)(F.lds + LCTL_OFF + 64 * 4)};
            pg8::EpiSwiGLU E{(unsigned char*)(F.ws + WS_HE), (const float*)(F.ws + WS_RSLOT)};
            { LAS int* idxt = (LAS int*)(F.lds + LIDX_OFF); const int* tokmap = (const int*)(F.ws + WS_TOKMAP);
              const int tz = (F.wid << 6) | lane_now();
              int r0u[MAXGU], tvu[MAXGU]; int nu = 0;
#pragma unroll
              for (int i = 0; i < MAXGU; ++i) { pg8::Unit uu; const bool ok = S.next(i, uu); r0u[i] = ok ? uu.row0 : 0; nu += ok ? 1 : 0; }
#pragma unroll
              for (int i = 0; i < MAXGU; ++i) tvu[i] = tokmap[r0u[i] + (tz & 255)];
#pragma unroll
              for (int i = 0; i < MAXGU; ++i) if (i < nu && tz < 256) idxt[i * 256 + tz] = tvu[i];
              __syncthreads(); }
            pg8::gemm_phase<pg8::EpiSwiGLU, pg8::MoeOrder, true, true, true, true>(F.lds, F.wid, DM, S, E, (const char*)(F.ws + WS_HB8), (const LAS int*)(F.lds + LIDX_OFF));
        }
        SEAM(pb + 6);
        if (IN(pb + 7)) { REBASE();
            if (hi - lo == 1) moe_tables(F, l);
            pg8::MoeOrder S{(const char*)(F.ws + WS_HE), (const char*)(F.ws + WS_WD + (size_t)l * 16 * DM * DEXP), (size_t)DEXP, (size_t)DM * DEXP, (size_t)256 * DEXP, 8, F.G, F.bid,
                            (const LAS int*)(F.lds + LCTL_OFF + 32 * 4), (const LAS int*)(F.lds + LCTL_OFF + 64 * 4)};
            pg8::EpiY8 E{(unsigned char*)(F.ws + WS_PROJ)};
            pg8::gemm_phase<pg8::EpiY8, pg8::MoeOrder, true, true, false, true>(F.lds, F.wid, DEXP, S, E);
        }
        SEAM(pb + 7);
        if (IN(pb + 8)) { REBASE(); combine_phase(F, p, l); }
        SEAM(pb + 8);
    }
#undef IN
#undef REBASE
#undef SEAM
}

extern "C" void kernel_launch(void* const* d_in, const int* in_sizes, int n_in, void* d_out, int out_size, void* d_ws, size_t ws_size, hipStream_t stream) {
    static int grid = 0;
    if (grid == 0) {
        if (n_in != 26 || out_size != NREAL * DM || ws_size < WS_END) { fprintf(stderr, "kernel_launch: unexpected shapes (n_in %d out %d ws %zu)\n", n_in, out_size, ws_size); grid = -1; return; }
        int dev = 0, cus = 0, per_cu = 0;
        if (hipGetDevice(&dev) != hipSuccess || hipDeviceGetAttribute(&cus, hipDeviceAttributeMultiprocessorCount, dev) != hipSuccess) { grid = -1; return; }
        if (hipFuncSetAttribute((const void*)mega_fwd, hipFuncAttributeMaxDynamicSharedMemorySize, LDS_BYTES) != hipSuccess) { fprintf(stderr, "kernel_launch: hipFuncSetAttribute failed\n"); grid = -1; return; }
        if (hipOccupancyMaxActiveBlocksPerMultiprocessor(&per_cu, (const void*)mega_fwd, 512, LDS_BYTES) != hipSuccess || per_cu < 1) { fprintf(stderr, "kernel_launch: occupancy query says %d\n", per_cu); (void)hipGetLastError(); }
        grid = cus;
        if (grid > 1024) grid = 1024;
    }
    if (grid < 0) return;
    if (hipMemsetAsync((char*)d_ws + WS_CTL, 0, CTL_BYTES, stream) != hipSuccess) return;
    Params p{};
    for (int i = 0; i < 26; ++i) p.in[i] = (const float*)d_in[i];
    p.out = (float*)d_out; p.ws = (unsigned char*)d_ws;
#if MK_N_LAUNCHES == 1
    p.ph_lo = 0; p.ph_hi = N_PHASES;
    hipLaunchKernelGGL(mega_fwd, dim3(grid), dim3(512), LDS_BYTES, stream, p);
#else
    for (int k = 0; k < N_PHASES; ++k) { p.ph_lo = k; p.ph_hi = k + 1; hipLaunchKernelGGL(mega_fwd, dim3(grid), dim3(512), LDS_BYTES, stream, p); }
#endif
}
```
